# Optimizing an MI355X kernel written in HIP

```python
import math
import jax, jax.numpy as jnp
from jax import lax
import numpy as np

D_MODEL = 2048
BATCH = 16
SEQ = 2048
DEPTH = 1

CHUNK = 64
Q_BLOCK = 128
PLE_DIM = 256
EPS = 1e-6
DN_HEADS = 8
DN_HEAD_DIM = 128
DN_WIDTH = DN_HEADS * DN_HEAD_DIM
CONV_K = 4
MLA_HEADS = 8
MLA_NOPE = 128
MLA_ROPE = 64
MLA_V = 128
KV_RANK = 512
MLA_WIDTH = MLA_HEADS * MLA_V
ROPE_BASE = 10000.0
D_FF = 4 * D_MODEL
IN_SIZES = (DN_WIDTH, DN_WIDTH, DN_WIDTH, DN_WIDTH, DN_HEADS, DN_HEADS,
            MLA_HEADS * (MLA_NOPE + MLA_ROPE), KV_RANK, MLA_ROPE, D_MODEL, D_MODEL)
D_IN = sum(IN_SIZES)

kernel_name = "hybrid_gdn_mla_parallel_block"


def rms_norm(x, g):
    xf = x.astype(jnp.float32)
    y = xf * lax.rsqrt(jnp.mean(xf * xf, axis=-1, keepdims=True) + EPS)
    return (y * g.astype(jnp.float32)).astype(x.dtype)


def l2norm(t):
    t = t.astype(jnp.float32)
    return t * lax.rsqrt(jnp.sum(t * t, axis=-1, keepdims=True) + EPS)


def causal_conv(u, w):
    k, c = w.shape
    return lax.conv_general_dilated(u, w[:, None, :].astype(u.dtype), window_strides=(1,),
                                    padding=[(k - 1, 0)], dimension_numbers=('NWC', 'WIO', 'NWC'),
                                    feature_group_count=c)


def rope(x, pos):
    half = x.shape[-1] // 2
    inv = ROPE_BASE ** (-jnp.arange(half, dtype=jnp.float32) / half)
    ang = pos.astype(jnp.float32)[..., None] * inv
    ang = ang.reshape(ang.shape[:2] + (1,) * (x.ndim - 3) + (half,))
    cos = jnp.cos(ang).astype(x.dtype)
    sin = jnp.sin(ang).astype(x.dtype)
    x1, x2 = x[..., :half], x[..., half:]
    return jnp.concatenate([x1 * cos - x2 * sin, x2 * cos + x1 * sin], axis=-1)


def gated_delta_rule(q, k, v, g, beta):
    b, s, h, dk = q.shape
    dv = v.shape[-1]
    n = s // CHUNK

    def blk(t):
        t = t.reshape((b, n, CHUNK, h) + t.shape[3:])
        return jnp.moveaxis(t, 3, 1)

    q = blk(q) * (dk ** -0.5)
    k, v, g, beta = blk(k), blk(v), blk(g), blk(beta)
    gc = jnp.cumsum(g, axis=-1)
    idx = jnp.arange(CHUNK)
    incl = idx[:, None] >= idx[None, :]
    strict = idx[:, None] > idx[None, :]
    decay = jnp.exp(jnp.where(incl, gc[..., :, None] - gc[..., None, :], -jnp.inf))
    kb = k * beta[..., None]
    vb = v * beta[..., None]
    a = jnp.where(strict, jnp.einsum('bhnid,bhnjd->bhnij', kb, k) * decay, 0.0)
    eye = jnp.eye(CHUNK, dtype=a.dtype)
    t_inv = lax.linalg.triangular_solve(eye + a, jnp.broadcast_to(eye, a.shape),
                                        left_side=True, lower=True)
    w = t_inv @ (kb * jnp.exp(gc)[..., None])
    u = t_inv @ vb
    qk = jnp.einsum('bhnid,bhnjd->bhnij', q, k) * decay
    q_dec = q * jnp.exp(gc)[..., None]
    k_dec = k * jnp.exp(gc[..., -1:] - gc)[..., None]
    g_last = jnp.exp(gc[..., -1])

    def step(state, xs):
        w_n, u_n, q_n, k_n, qk_n, gl_n = xs
        v_new = u_n - w_n @ state
        o = q_n @ state + qk_n @ v_new
        state = state * gl_n[..., None, None] + jnp.einsum('bhcd,bhce->bhde', k_n, v_new)
        return state, o

    xs = tuple(jnp.moveaxis(t_, 2, 0) for t_ in (w, u, q_dec, k_dec, qk, g_last))
    s0 = jnp.zeros((b, h, dk, dv), q.dtype)
    _, o = lax.scan(step, s0, xs)
    return o.transpose(1, 0, 3, 2, 4).reshape(b, s, h, dv)


def mla_attention(qn, qr, kn, kr, v):
    b, s, h, _ = qn.shape
    nb = s // Q_BLOCK
    scale = (MLA_NOPE + MLA_ROPE) ** -0.5
    k_chunk = jnp.arange(s) // CHUNK

    def blocks(t):
        return jnp.moveaxis(t.reshape((b, nb, Q_BLOCK) + t.shape[2:]), 1, 0)

    def one(args):
        qn_b, qr_b, j = args
        sc = (jnp.einsum('bqhd,bkhd->bhqk', qn_b, kn)
              + jnp.einsum('bqhr,bkr->bhqk', qr_b, kr)).astype(jnp.float32) * scale
        q_chunk = (j * Q_BLOCK + jnp.arange(Q_BLOCK)) // CHUNK
        allowed = k_chunk[None, :] <= q_chunk[:, None]
        pr = jax.nn.softmax(jnp.where(allowed, sc, -jnp.inf), axis=-1)
        return jnp.einsum('bhqk,bkhd->bqhd', pr.astype(v.dtype), v)

    o = lax.map(one, (blocks(qn), blocks(qr), jnp.arange(nb)))
    return jnp.moveaxis(o, 0, 1).reshape(b, s, h * v.shape[-1])


def setup_inputs(seed: int = 0) -> dict:
    key = jax.random.key(seed)
    ks = iter(jax.random.split(key, 40))
    f32 = jnp.float32

    def nrm(shape, fan_in):
        return jax.random.normal(next(ks), shape, f32) * (fan_in ** -0.5)

    def gain(n):
        return 1.0 + 0.02 * jax.random.normal(next(ks), (DEPTH, n), f32)

    x = jax.random.normal(next(ks), (BATCH, SEQ, D_MODEL), f32)
    p = jax.random.normal(next(ks), (DEPTH, BATCH, SEQ, PLE_DIM), f32)
    offset = jax.random.randint(next(ks), (BATCH,), 0, 4096, dtype=jnp.int32)
    positions = offset[:, None] + jnp.arange(SEQ, dtype=jnp.int32)[None, :]
    dt = jnp.exp(jax.random.uniform(next(ks), (DEPTH, DN_HEADS), f32,
                                    minval=math.log(1e-3), maxval=math.log(0.1)))
    dt_bias = dt + jnp.log(-jnp.expm1(-dt))
    a_log = jnp.log(jax.random.uniform(next(ks), (DEPTH, DN_HEADS), f32, minval=1.0, maxval=16.0))
    return {
        "x": x,
        "p": p,
        "positions": positions,
        "mix_norm": gain(D_MODEL),
        "w_in": nrm((DEPTH, D_MODEL, D_IN), D_MODEL),
        "conv_w": nrm((DEPTH, CONV_K, 3 * DN_WIDTH), CONV_K),
        "dt_bias": dt_bias,
        "a_log": a_log,
        "dn_out_norm": gain(DN_HEAD_DIM),
        "ckv_norm": gain(KV_RANK),
        "w_kv_up": nrm((DEPTH, KV_RANK, MLA_HEADS * (MLA_NOPE + MLA_V)), KV_RANK),
        "q_nope_norm": gain(MLA_NOPE),
        "q_rope_norm": gain(MLA_ROPE),
        "k_nope_norm": gain(MLA_NOPE),
        "k_rope_norm": gain(MLA_ROPE),
        "w_branch_a": nrm((DEPTH, DN_WIDTH, D_MODEL), DN_WIDTH),
        "w_branch_b": nrm((DEPTH, MLA_WIDTH, D_MODEL), MLA_WIDTH),
        "w_out": nrm((DEPTH, D_MODEL, D_MODEL), D_MODEL),
        "mlp_norm": gain(D_MODEL),
        "w_mlp_up": nrm((DEPTH, D_MODEL, D_FF), D_MODEL),
        "w_mlp_down": nrm((DEPTH, D_FF, D_MODEL), D_FF),
        "ple_norm": gain(D_MODEL),
        "w_ple_gate": nrm((DEPTH, D_MODEL, D_MODEL), D_MODEL),
        "w_ple": nrm((DEPTH, PLE_DIM, D_MODEL), PLE_DIM),
    }


def reference(x, p, positions, mix_norm, w_in, conv_w, dt_bias, a_log, dn_out_norm, ckv_norm,
              w_kv_up, q_nope_norm, q_rope_norm, k_nope_norm, k_rope_norm, w_branch_a,
              w_branch_b, w_out, mlp_norm, w_mlp_up, w_mlp_down, ple_norm, w_ple_gate, w_ple):
    b, s, _ = x.shape
    split_points = [int(c) for c in np.cumsum(IN_SIZES)[:-1]]
    for i in range(DEPTH):
        h = rms_norm(x, mix_norm[i])
        proj = h @ w_in[i]
        (dn_q, dn_k, dn_v, dn_z, dn_b, dn_a, mla_q, mla_ckv, mla_kr,
         gate_a, gate_b) = jnp.split(proj, split_points, axis=-1)

        qkv = jax.nn.silu(causal_conv(jnp.concatenate([dn_q, dn_k, dn_v], axis=-1), conv_w[i]))
        cq, ck, cv = jnp.split(qkv, 3, axis=-1)
        hs = (b, s, DN_HEADS, DN_HEAD_DIM)
        q_a = l2norm(cq.reshape(hs))
        k_a = l2norm(ck.reshape(hs))
        v_a = cv.reshape(hs).astype(jnp.float32)
        beta = jax.nn.sigmoid(dn_b.astype(jnp.float32))
        g = -jnp.exp(a_log[i].astype(jnp.float32)) * jax.nn.softplus(
            dn_a.astype(jnp.float32) + dt_bias[i].astype(jnp.float32))
        o_a = gated_delta_rule(q_a, k_a, v_a, g, beta).astype(x.dtype)
        o_a = (rms_norm(o_a, dn_out_norm[i]) * jax.nn.silu(dn_z.reshape(hs))).reshape(b, s, DN_WIDTH)

        mq = mla_q.reshape(b, s, MLA_HEADS, MLA_NOPE + MLA_ROPE)
        qn = rms_norm(mq[..., :MLA_NOPE], q_nope_norm[i])
        qr = rope(rms_norm(mq[..., MLA_NOPE:], q_rope_norm[i]), positions)
        kv = (rms_norm(mla_ckv, ckv_norm[i]) @ w_kv_up[i]).reshape(b, s, MLA_HEADS, MLA_NOPE + MLA_V)
        kn = rms_norm(kv[..., :MLA_NOPE], k_nope_norm[i])
        v_b = kv[..., MLA_NOPE:]
        kr = rope(rms_norm(mla_kr, k_rope_norm[i]), positions)
        o_b = mla_attention(qn, qr, kn, kr, v_b)

        y = (jax.nn.sigmoid(gate_a) * (o_a @ w_branch_a[i])
             + jax.nn.sigmoid(gate_b) * (o_b @ w_branch_b[i]))
        x = x + y @ w_out[i]

        hm = rms_norm(x, mlp_norm[i])
        x = x + jnp.square(jax.nn.relu(hm @ w_mlp_up[i])) @ w_mlp_down[i]

        ple_gate = jax.nn.sigmoid(rms_norm(x, ple_norm[i]) @ w_ple_gate[i])
        x = x + ple_gate * (p[i] @ w_ple[i])
    return x
```

```cpp
#include <hip/hip_runtime.h>
#include <hip/hip_cooperative_groups.h>
#include <cstdio>
#include <cstdint>
#include <cmath>
namespace cg = cooperative_groups;

#define LAS __attribute__((address_space(3)))
typedef unsigned short bf16_t;
typedef short bf16x8 __attribute__((ext_vector_type(8)));
typedef float f32x4 __attribute__((ext_vector_type(4)));
typedef float f32x2 __attribute__((ext_vector_type(2)));
typedef unsigned u32x4 __attribute__((ext_vector_type(4)));
typedef unsigned u32x2 __attribute__((ext_vector_type(2)));

constexpr int NB = 16, SEQ = 2048, MROWS = NB * SEQ, DM = 2048, LDP = 10496, DFF = 8192, PLE = 256;
constexpr int C_Q = 0, C_K = 1024, C_V = 2048, C_Z = 3072, C_MQ = 4096, C_CKV = 5632, C_GA = 6144, C_GB = 8192, C_KR = 10240, C_BETA = 10304, C_ALPHA = 10312;
constexpr int D_IN = 10320;
constexpr float EPS = 1e-6f;
constexpr float LOG2E = 1.4426950408889634f;
constexpr size_t MiB = 1u << 20;
constexpr size_t WS_WIN = 0, WS_WKV = 41 * MiB, WS_WA = 43 * MiB, WS_WB = 47 * MiB, WS_WOUT = 51 * MiB, WS_WUP = 59 * MiB, WS_WDN = 91 * MiB, WS_WPG = 123 * MiB,
                 WS_WPLE = 131 * MiB, WS_PBF = 132 * MiB, WS_G = 148 * MiB, WS_BETA = 149 * MiB, WS_QKM = 150 * MiB, WS_ACT = 182 * MiB, WS_PROJ = 310 * MiB,
                 WS_GL = 966 * MiB, WS_END = 967 * MiB;
constexpr int LDS_BYTES = 147456;

__device__ __forceinline__ float bf2f(bf16_t v) { return __uint_as_float((unsigned)v << 16); }
__device__ __forceinline__ float bflo(unsigned w) { return __uint_as_float(w << 16); }
__device__ __forceinline__ float bfhi(unsigned w) { return __uint_as_float(w & 0xffff0000u); }
__device__ __forceinline__ unsigned pk2(float lo, float hi) { unsigned r; asm("v_cvt_pk_bf16_f32 %0, %1, %2" : "=v"(r) : "v"(lo), "v"(hi)); return r; }
__device__ __forceinline__ bf16_t f2bf(float f) { return (bf16_t)(pk2(f, 0.f) & 0xffffu); }
__device__ __forceinline__ float wave_sum(float v) {
#pragma unroll
    for (int o = 1; o < 64; o <<= 1) v += __shfl_xor(v, o);
    return v;
}
__device__ __forceinline__ float fast_sigmoid(float x) { return __builtin_amdgcn_rcpf(1.f + __builtin_amdgcn_exp2f(-x * LOG2E)); }
__device__ __forceinline__ float silu_f(float x) { return x * fast_sigmoid(x); }
#define LDS_WAIT() asm volatile("s_waitcnt lgkmcnt(0)" ::: "memory")

namespace pg8 {
constexpr int BM = 256, BK = 64, HALF = 128, HTB = HALF * BK * 2, STAGE_BYTES = 8 * HTB, NXCD = 8, WGM = 8;
__host__ __device__ __forceinline__ int lds_byte(int r, int c) { const int st = (r >> 4) * 2 + (c >> 5), rr = r & 15, cc = c & 31, ob = rr * 64 + cc * 2; return st * 1024 + (ob ^ (((ob >> 9) & 1) << 5)); }
__host__ __device__ __forceinline__ void stage_rc(int b, int& R, int& C) { const int st = b / 1024, sb = b % 1024, swz = sb ^ (((sb >> 9) & 1) << 5); R = (st >> 1) * 16 + swz / 64; C = (st & 1) * 32 + (swz % 64) / 2; }
__host__ __device__ __forceinline__ int perm32(int rho) { const int n = rho >> 4, i = rho & 15; return 8 * (i >> 2) + 4 * n + (i & 3); }
struct Unit { int pm, pn; };
struct Gemm { const bf16_t* A; const bf16_t* Bt; int M, N, K, lda; };
struct StaticOrder {
    int nM, nN, nwg, G, c;
    __device__ void init(int M, int N, int G_, int c_) { nM = M / BM; nN = N / BM; nwg = nM * nN; G = G_; c = c_; }
    __device__ bool next(int i, Unit& u) const {
        const long L = (long)i * G + c; if (L >= nwg) return false;
        int wgid = (int)L; { const int q = nwg / NXCD, r = nwg % NXCD, xcd = wgid % NXCD, off = wgid / NXCD; wgid = (xcd < r ? xcd * (q + 1) : r * (q + 1) + (xcd - r) * q) + off; }
        const int nig = WGM * nN, gid = wgid / nig, fm = gid * WGM, gsz = (nM - fm) < WGM ? (nM - fm) : WGM;
        u.pm = fm + ((wgid % nig) % gsz); u.pn = (wgid % nig) / gsz; return true;
    }
};
template <class Epi>
__device__ __forceinline__ void gemm_phase(LAS unsigned char* lds, const Gemm g, const StaticOrder& S, const Epi& E) {
    int tid = threadIdx.x; asm volatile("" : "+v"(tid));
    const int wid = __builtin_amdgcn_readfirstlane(tid >> 6), lane = tid & 63, wr = wid >> 2, wc = wid & 3, fr = lane & 15, fq = lane >> 4;
    const int K = g.K, nt = K / BK, lda = g.lda;
    unsigned voffA[2], voffB[2];
#pragma unroll
    for (int i = 0; i < 2; ++i) { int R, C; stage_rc(tid * 16 + i * 8192, R, C); const int Rb = ((R & ~31) + perm32(R & 31));
        voffA[i] = (unsigned)(R * lda + C) * 2u; voffB[i] = (unsigned)(Rb * K + C) * 2u; }
    const size_t kstep = (size_t)(BK * 2);
    const size_t hstepA = (size_t)HALF * lda * 2, tstepA = 2 * hstepA, hstepB = (size_t)HALF * K * 2, tstepB = 2 * hstepB;
    const unsigned ldsw = (unsigned)wid * 1024u;
    const int aoff = lds_byte(wr * 64 + fr, fq * 8), boff = lds_byte(wc * 32 + fr, fq * 8);
#define PG8_SA(b, h) (((b) * 2 + (h)) * HTB)
#define PG8_SB(b, h) ((4 + (b) * 2 + (h)) * HTB)
#define PG8_STAGE(bufoff, gbase, voff) do { _Pragma("unroll") for (int _i = 0; _i < 2; ++_i) \
        __builtin_amdgcn_global_load_lds((const unsigned*)((const char*)(gbase) + (voff)[_i]), (LAS unsigned*)(lds + (bufoff) + ldsw + _i * 8192), 16, 0, 0); } while (0)
#define PG8_LDA(dst, b, h) do { _Pragma("unroll") for (int m = 0; m < 4; ++m) _Pragma("unroll") for (int k = 0; k < 2; ++k) dst[m][k] = *(const LAS bf16x8*)(lds + PG8_SA(b, h) + aoff + m * 2048 + k * 1024); } while (0)
#define PG8_LDB(dst, b, h) do { _Pragma("unroll") for (int n = 0; n < 2; ++n) _Pragma("unroll") for (int k = 0; k < 2; ++k) dst[n][k] = *(const LAS bf16x8*)(lds + PG8_SB(b, h) + boff + n * 2048 + k * 1024); } while (0)
#define PG8_MMA(ai, bj, At, Bt) do { __builtin_amdgcn_s_setprio(1); _Pragma("unroll") for (int m = 0; m < 4; ++m) _Pragma("unroll") for (int n = 0; n < 2; ++n) _Pragma("unroll") for (int k = 0; k < 2; ++k) \
        acc[ai][bj][m][n] = __builtin_amdgcn_mfma_f32_16x16x32_bf16(Bt[n][k], At[m][k], acc[ai][bj][m][n], 0, 0, 0); __builtin_amdgcn_s_setprio(0); } while (0)
#define PG8_WAIT_V(n) asm volatile("s_waitcnt vmcnt(" #n ")" ::: "memory")
#define PG8_WAIT_L(n) asm volatile("s_waitcnt lgkmcnt(" #n ")" ::: "memory")
#define PG8_BAR __builtin_amdgcn_s_barrier()
#define PG8_SCHED __builtin_amdgcn_sched_barrier(0)
    Unit cur, nxt; int ui = 0;
    if (!S.next(0, cur)) return;
    f32x4 acc[2][2][4][2];
#pragma unroll
    for (int a = 0; a < 2; ++a)
#pragma unroll
        for (int b = 0; b < 2; ++b)
#pragma unroll
            for (int m = 0; m < 4; ++m)
#pragma unroll
                for (int n = 0; n < 2; ++n) acc[a][b][m][n] = (f32x4){0.f, 0.f, 0.f, 0.f};
    bf16x8 At[4][2], B0[2][2], B1[2][2];
    const char* cA = (const char*)g.A + (size_t)cur.pm * tstepA; const char* cB = (const char*)g.Bt + (size_t)cur.pn * tstepB;
    PG8_STAGE(PG8_SB(0, 0), cB, voffB); PG8_STAGE(PG8_SB(0, 1), cB + hstepB, voffB); PG8_STAGE(PG8_SA(0, 0), cA, voffA); PG8_STAGE(PG8_SA(0, 1), cA + hstepA, voffA);
    if (wr == 1) PG8_BAR;
    PG8_WAIT_V(2); PG8_BAR;
    PG8_STAGE(PG8_SB(1, 0), cB + kstep, voffB); PG8_STAGE(PG8_SA(1, 0), cA + kstep, voffA); PG8_STAGE(PG8_SB(1, 1), cB + hstepB + kstep, voffB);
    PG8_WAIT_V(6); PG8_BAR;
    for (;;) {
        const bool has_next = S.next(ui + 1, nxt);
        const char* nA = has_next ? (const char*)g.A + (size_t)nxt.pm * tstepA : cA; const char* nB = has_next ? (const char*)g.Bt + (size_t)nxt.pn * tstepB : cB;
        for (int t = 0; t < nt; t += 2) {
            const bool last = (t == nt - 2);
            const char* a1 = cA + (size_t)(t + 1) * kstep;
            const char* a2 = last ? nA : cA + (size_t)(t + 2) * kstep; const char* b2 = last ? nB : cB + (size_t)(t + 2) * kstep;
            const char* a3 = a2 + kstep; const char* b3 = b2 + kstep;
            PG8_LDB(B0, 0, 0); PG8_LDB(B1, 0, 1); PG8_SCHED; PG8_LDA(At, 0, 0); PG8_STAGE(PG8_SA(1, 1), a1 + hstepA, voffA);
            PG8_WAIT_V(8); PG8_WAIT_L(0); PG8_BAR; PG8_MMA(0, 0, At, B0); PG8_MMA(0, 1, At, B1); PG8_BAR; PG8_SCHED;
            PG8_LDA(At, 0, 1); PG8_STAGE(PG8_SB(0, 0), b2, voffB); PG8_STAGE(PG8_SB(0, 1), b2 + hstepB, voffB); PG8_STAGE(PG8_SA(0, 0), a2, voffA);
            PG8_WAIT_V(8); PG8_WAIT_L(0); PG8_BAR; PG8_MMA(1, 0, At, B0); PG8_MMA(1, 1, At, B1); PG8_BAR; PG8_SCHED;
            PG8_LDB(B0, 1, 0); PG8_LDB(B1, 1, 1); PG8_SCHED; PG8_LDA(At, 1, 0); PG8_STAGE(PG8_SA(0, 1), a2 + hstepA, voffA);
            PG8_WAIT_V(8); PG8_WAIT_L(0); PG8_BAR; PG8_MMA(0, 0, At, B0); PG8_MMA(0, 1, At, B1); PG8_BAR; PG8_SCHED;
            PG8_LDA(At, 1, 1); PG8_STAGE(PG8_SB(1, 0), b3, voffB); PG8_STAGE(PG8_SB(1, 1), b3 + hstepB, voffB); PG8_STAGE(PG8_SA(1, 0), a3, voffA);
            PG8_WAIT_V(8); PG8_WAIT_L(0); PG8_BAR; PG8_MMA(1, 0, At, B0); PG8_MMA(1, 1, At, B1); PG8_BAR; PG8_SCHED;
        }
        if (wr == 0) PG8_BAR;
        E(acc, cur, wr, wc, fr, fq);
        if (!has_next) break;
#pragma unroll
        for (int a = 0; a < 2; ++a)
#pragma unroll
            for (int b = 0; b < 2; ++b)
#pragma unroll
                for (int m = 0; m < 4; ++m)
#pragma unroll
                    for (int n = 0; n < 2; ++n) acc[a][b][m][n] = (f32x4){0.f, 0.f, 0.f, 0.f};
        cur = nxt; cA = nA; cB = nB; ++ui;
        if (wr == 1) PG8_BAR;
    }
    PG8_WAIT_V(0);
    PG8_BAR;
#undef PG8_SA
#undef PG8_SB
#undef PG8_STAGE
#undef PG8_LDA
#undef PG8_LDB
#undef PG8_MMA
#undef PG8_WAIT_V
#undef PG8_WAIT_L
#undef PG8_BAR
#undef PG8_SCHED
}
}

enum { EP_BF16 = 0, EP_KV, EP_YA, EP_YB, EP_X1, EP_RELU2, EP_ACC, EP_F32, EP_PLE };
__device__ __forceinline__ void store8bf(bf16_t* p, f32x4 a, f32x4 b) { u32x4 w; w.x = pk2(a[0], a[1]); w.y = pk2(a[2], a[3]); w.z = pk2(b[0], b[1]); w.w = pk2(b[2], b[3]); *(u32x4*)p = w; }
__device__ __forceinline__ void load8bf(const bf16_t* p, f32x4& a, f32x4& b) { const u32x4 w = *(const u32x4*)p; a = (f32x4){bflo(w.x), bfhi(w.x), bflo(w.y), bfhi(w.y)}; b = (f32x4){bflo(w.z), bfhi(w.z), bflo(w.w), bfhi(w.w)}; }
__device__ __forceinline__ f32x4 sig4(f32x4 v) { return (f32x4){fast_sigmoid(v[0]), fast_sigmoid(v[1]), fast_sigmoid(v[2]), fast_sigmoid(v[3])}; }
template <int MODE> struct Epi {
    bf16_t* ob; float* of; int ldc; const bf16_t* gate; const float* res; bf16_t* vt;
    __device__ __forceinline__ void operator()(const f32x4 (&acc)[2][2][4][2], const pg8::Unit& u, int wr, int wc, int fr, int fq) const {
#pragma unroll
        for (int ai = 0; ai < 2; ++ai)
#pragma unroll
            for (int m = 0; m < 4; ++m) {
                const int row = u.pm * 256 + ai * 128 + wr * 64 + m * 16 + fr;
#pragma unroll
                for (int bj = 0; bj < 2; ++bj) {
                    const int col = u.pn * 256 + bj * 128 + wc * 32 + 8 * fq;
                    f32x4 v0 = acc[ai][bj][m][0], v1 = acc[ai][bj][m][1];
                    if constexpr (MODE == EP_BF16) { store8bf(ob + (size_t)row * ldc + col, v0, v1); }
                    else if constexpr (MODE == EP_RELU2) {
#pragma unroll
                        for (int e = 0; e < 4; ++e) { const float a = fmaxf(v0[e], 0.f), b = fmaxf(v1[e], 0.f); v0[e] = a * a; v1[e] = b * b; }
                        store8bf(ob + (size_t)row * ldc + col, v0, v1); }
                    else if constexpr (MODE == EP_KV) {
                        if (bj == 0) store8bf(ob + (size_t)row * 1024 + u.pn * 128 + wc * 32 + 8 * fq, v0, v1);
                        else { const int b = row >> 11, s = row & 2047; bf16_t* base = vt + ((size_t)((b * 8 + u.pn) * 128 + wc * 32 + 8 * fq)) * 2048 + s;
#pragma unroll
                            for (int e = 0; e < 4; ++e) { base[(size_t)e * 2048] = f2bf(v0[e]); base[(size_t)(e + 4) * 2048] = f2bf(v1[e]); } } }
                    else if constexpr (MODE == EP_YA) { f32x4 g0, g1; load8bf(gate + (size_t)row * LDP + C_GA + col, g0, g1);
                        float* o = of + (size_t)row * DM + col; *(f32x4*)o = sig4(g0) * v0; *(f32x4*)(o + 4) = sig4(g1) * v1; }
                    else if constexpr (MODE == EP_YB) { f32x4 g0, g1; load8bf(gate + (size_t)row * LDP + C_GB + col, g0, g1);
                        const float* o = of + (size_t)row * DM + col; const f32x4 y0 = *(const f32x4*)o + sig4(g0) * v0, y1 = *(const f32x4*)(o + 4) + sig4(g1) * v1;
                        store8bf(ob + (size_t)row * DM + col, y0, y1); }
                    else if constexpr (MODE == EP_X1) { const float* r = res + (size_t)row * DM + col; float* o = of + (size_t)row * DM + col;
                        *(f32x4*)o = *(const f32x4*)r + v0; *(f32x4*)(o + 4) = *(const f32x4*)(r + 4) + v1; }
                    else if constexpr (MODE == EP_ACC) { float* o = of + (size_t)row * DM + col; *(f32x4*)o = *(const f32x4*)o + v0; *(f32x4*)(o + 4) = *(const f32x4*)(o + 4) + v1; }
                    else if constexpr (MODE == EP_F32) { float* o = of + (size_t)row * DM + col; *(f32x4*)o = v0; *(f32x4*)(o + 4) = v1; }
                    else if constexpr (MODE == EP_PLE) { const float* r = res + (size_t)row * DM + col; float* o = of + (size_t)row * DM + col;
                        *(f32x4*)o = *(const f32x4*)o + sig4(v0) * *(const f32x4*)r; *(f32x4*)(o + 4) = *(const f32x4*)(o + 4) + sig4(v1) * *(const f32x4*)(r + 4); }
                }
                asm volatile("" ::: "memory");
            }
    }
};

struct Params { const void* in[24]; float* out; unsigned char* ws; float ropeinv[32]; };

__device__ __forceinline__ int win_map(int n) {
    if (n < 4096) return n;
    if (n < 5632) return 4112 + (n - 4096);
    if (n < 6144) return 5648 + (n - 5632);
    if (n < 8192) return 6224 + (n - 6144);
    if (n < 10240) return 8272 + (n - 8192);
    if (n < 10304) return 6160 + (n - 10240);
    if (n < 10312) return 4096 + (n - 10304);
    if (n < 10320) return 4104 + (n - 10312);
    return -1;
}
template <bool MAP>
__device__ __forceinline__ void transpose_item(const float* W, int K, int N, int nblk, bf16_t* WT, LAS float* scr, int item, int lane) {
    const int kb = item / nblk, nb = item % nblk, k0 = 64 * kb, n0 = 32 * nb;
    int oc = n0 + (lane & 31); if (MAP) oc = win_map(oc);
#pragma unroll 8
    for (int i = 0; i < 32; ++i) { const int kk = 2 * i + (lane >> 5); scr[kk * 33 + (lane & 31)] = (oc >= 0) ? W[(size_t)(k0 + kk) * N + oc] : 0.f; }
    LDS_WAIT();
    const int c = lane & 7;
#pragma unroll
    for (int j = 0; j < 4; ++j) { const int n = (lane >> 3) + 8 * j; const LAS float* s = scr + (8 * c) * 33 + n;
        u32x4 o; o.x = pk2(s[0 * 33], s[1 * 33]); o.y = pk2(s[2 * 33], s[3 * 33]); o.z = pk2(s[4 * 33], s[5 * 33]); o.w = pk2(s[6 * 33], s[7 * 33]);
        *(u32x4*)(WT + (size_t)(n0 + n) * K + k0 + 8 * c) = o; }
    LDS_WAIT();
}
__device__ __forceinline__ void rmsnorm_row(const float* xrow, const float* gain, bf16_t* orow, int lane) {
    const f32x4* xr = (const f32x4*)xrow + lane; const f32x4* gr = (const f32x4*)gain + lane;
    f32x4 v[8]; float s = 0.f;
#pragma unroll
    for (int j = 0; j < 8; ++j) { v[j] = xr[64 * j]; s += (v[j][0] * v[j][0] + v[j][1] * v[j][1]) + (v[j][2] * v[j][2] + v[j][3] * v[j][3]); }
    const float rstd = rsqrtf(wave_sum(s) * (1.f / 2048.f) + EPS);
    u32x2* o8 = (u32x2*)orow + lane;
#pragma unroll
    for (int j = 0; j < 8; ++j) { const f32x4 g = gr[64 * j]; u32x2 w; w.x = pk2(v[j][0] * rstd * g[0], v[j][1] * rstd * g[1]); w.y = pk2(v[j][2] * rstd * g[2], v[j][3] * rstd * g[3]); o8[64 * j] = w; }
}
__device__ __forceinline__ void rmsnorm_rows_phase(const float* X, const float* gain, bf16_t* O, int gw, int NGW, int lane) {
    for (int m = gw; m < MROWS; m += NGW) rmsnorm_row(X + (size_t)m * DM, gain, O + (size_t)m * DM, lane);
}

__device__ __forceinline__ void p0_prologue(const Params& P, LAS unsigned char* lds, int gw, int NGW, int wave, int lane) {
    unsigned char* ws = P.ws;
    LAS float* scr = (LAS float*)(lds + wave * 16384);
    constexpr int I_IN = 32 * (LDP / 32), I_KV = 8 * 64, I_A = 16 * 64, I_B = 16 * 64, I_OUT = 32 * 64, I_UP = 32 * 256, I_DN = 128 * 64, I_PG = 32 * 64, I_PLE = 4 * 64;
    constexpr int NITEMS = I_IN + I_KV + I_A + I_B + I_OUT + I_UP + I_DN + I_PG + I_PLE;
    for (int it = gw; it < NITEMS; it += NGW) {
        int r = it;
        if (r < I_IN) { transpose_item<true>((const float*)P.in[4], 2048, D_IN, LDP / 32, (bf16_t*)(ws + WS_WIN), scr, r, lane); continue; } r -= I_IN;
        if (r < I_KV) { transpose_item<false>((const float*)P.in[10], 512, 2048, 64, (bf16_t*)(ws + WS_WKV), scr, r, lane); continue; } r -= I_KV;
        if (r < I_A) { transpose_item<false>((const float*)P.in[15], 1024, 2048, 64, (bf16_t*)(ws + WS_WA), scr, r, lane); continue; } r -= I_A;
        if (r < I_B) { transpose_item<false>((const float*)P.in[16], 1024, 2048, 64, (bf16_t*)(ws + WS_WB), scr, r, lane); continue; } r -= I_B;
        if (r < I_OUT) { transpose_item<false>((const float*)P.in[17], 2048, 2048, 64, (bf16_t*)(ws + WS_WOUT), scr, r, lane); continue; } r -= I_OUT;
        if (r < I_UP) { transpose_item<false>((const float*)P.in[19], 2048, 8192, 256, (bf16_t*)(ws + WS_WUP), scr, r, lane); continue; } r -= I_UP;
        if (r < I_DN) { transpose_item<false>((const float*)P.in[20], 8192, 2048, 64, (bf16_t*)(ws + WS_WDN), scr, r, lane); continue; } r -= I_DN;
        if (r < I_PG) { transpose_item<false>((const float*)P.in[22], 2048, 2048, 64, (bf16_t*)(ws + WS_WPG), scr, r, lane); continue; } r -= I_PG;
        transpose_item<false>((const float*)P.in[23], 256, 2048, 64, (bf16_t*)(ws + WS_WPLE), scr, r, lane);
    }
    rmsnorm_rows_phase((const float*)P.in[0], (const float*)P.in[3], (bf16_t*)(ws + WS_ACT), gw, NGW, lane);
    { const f32x4* src = (const f32x4*)P.in[1]; u32x4* dst = (u32x4*)(ws + WS_PBF); const size_t n8 = (size_t)MROWS * PLE / 8;
      for (size_t i = (size_t)gw * 64 + lane; i < n8; i += (size_t)NGW * 64) { const f32x4 a = src[2 * i], b = src[2 * i + 1]; u32x4 w; w.x = pk2(a[0], a[1]); w.y = pk2(a[2], a[3]); w.z = pk2(b[0], b[1]); w.w = pk2(b[2], b[3]); dst[i] = w; } }
}

__device__ __forceinline__ void rope_cs(float pos, float inv, float& c, float& s) {
    const float a = pos * inv;
    double rev = (double)a * 0.15915494309189535; rev -= rint(rev);
    const float r = (float)rev; s = __builtin_amdgcn_sinf(r); c = __builtin_amdgcn_cosf(r);
}
__device__ __forceinline__ void p2_prep(const Params& P, int gw, int NGW, int lane) {
    unsigned char* ws = P.ws;
    bf16_t* proj = (bf16_t*)(ws + WS_PROJ);
    const int* positions = (const int*)P.in[2];
    const float* ckvn = (const float*)P.in[9]; const float* qng = (const float*)P.in[11]; const float* qrg = (const float*)P.in[12]; const float* krg = (const float*)P.in[14];
    const float* dt_bias = (const float*)P.in[6]; const float* a_log = (const float*)P.in[7];
    float* G = (float*)(ws + WS_G); float* BETA = (float*)(ws + WS_BETA);
    const float QSCALE = 0.07216878364870322f * LOG2E;
    const float inv = P.ropeinv[lane & 31];
    const float* kng = (const float*)P.in[13];
    const float qn0 = qng[2 * lane] * kng[2 * lane], qn1 = qng[2 * lane + 1] * kng[2 * lane + 1], qr_g = qrg[lane], kr_g = krg[lane];
    for (int m = gw; m < MROWS; m += NGW) {
        bf16_t* row = proj + (size_t)m * LDP;
        float cs, sn; rope_cs((float)positions[m], inv, cs, sn);
#pragma unroll 2
        for (int h = 0; h < 8; ++h) {
            bf16_t* base = row + C_MQ + h * 192;
            const unsigned w = *(const unsigned*)(base + 2 * lane); float v0 = bflo(w), v1 = bfhi(w);
            const float rstd = rsqrtf(wave_sum(v0 * v0 + v1 * v1) * (1.f / 128.f) + EPS);
            float x = bf2f(base[128 + lane]);
            const float rs2 = rsqrtf(wave_sum(x * x) * (1.f / 64.f) + EPS);
            x = x * rs2 * qr_g;
            const float px = __shfl_xor(x, 32);
            const float xo = (lane < 32) ? (x * cs - px * sn) : (x * cs + px * sn);
            *(unsigned*)(base + 2 * lane) = pk2(v0 * rstd * qn0 * QSCALE, v1 * rstd * qn1 * QSCALE);
            base[128 + lane] = f2bf(xo * QSCALE);
        }
        { bf16_t* base = row + C_CKV + 8 * lane; f32x4 a, b; load8bf(base, a, b);
          const float ss = (a[0] * a[0] + a[1] * a[1]) + (a[2] * a[2] + a[3] * a[3]) + (b[0] * b[0] + b[1] * b[1]) + (b[2] * b[2] + b[3] * b[3]);
          const float rstd = rsqrtf(wave_sum(ss) * (1.f / 512.f) + EPS);
          const f32x4 g0 = *(const f32x4*)(ckvn + 8 * lane), g1 = *(const f32x4*)(ckvn + 8 * lane + 4);
          store8bf(base, a * rstd * g0, b * rstd * g1); }
        { float x = bf2f(row[C_KR + lane]); const float rs2 = rsqrtf(wave_sum(x * x) * (1.f / 64.f) + EPS); x = x * rs2 * kr_g;
          const float px = __shfl_xor(x, 32); const float xo = (lane < 32) ? (x * cs - px * sn) : (x * cs + px * sn); row[C_KR + lane] = f2bf(xo); }
        if (lane < 8) BETA[(size_t)m * 8 + lane] = 1.f / (1.f + expf(-bf2f(row[C_BETA + lane])));
        else if (lane < 16) { const int h = lane - 8; const float z = bf2f(row[C_ALPHA + h]) + dt_bias[h]; const float sp = (z > 20.f) ? z : log1pf(expf(z)); G[(size_t)m * 8 + h] = -expf(a_log[h]) * sp; }
    }
    const float* convw = (const float*)P.in[5];
    bf16_t* QA = (bf16_t*)P.out;
    for (int it = gw; it < (MROWS / 16) * 24; it += NGW) {
        const int run = it / 24, g = it % 24, m0 = run * 16, s0 = m0 & 2047, c = g * 128 + 2 * lane;
        const f32x2 w0 = *(const f32x2*)(convw + 0 * 3072 + c), w1 = *(const f32x2*)(convw + 1 * 3072 + c), w2 = *(const f32x2*)(convw + 2 * 3072 + c), w3 = *(const f32x2*)(convw + 3 * 3072 + c);
        const bf16_t* src = proj + (size_t)m0 * LDP + c;
        f32x2 h1 = {0.f, 0.f}, h2 = {0.f, 0.f}, h3 = {0.f, 0.f};
        if (s0 != 0) { unsigned u; u = *(const unsigned*)(src - (size_t)1 * LDP); h1 = (f32x2){bflo(u), bfhi(u)}; u = *(const unsigned*)(src - (size_t)2 * LDP); h2 = (f32x2){bflo(u), bfhi(u)};
                       u = *(const unsigned*)(src - (size_t)3 * LDP); h3 = (f32x2){bflo(u), bfhi(u)}; }
        bf16_t* dst = QA + (size_t)(g >> 3) * ((size_t)MROWS * 1024) + (size_t)m0 * 1024 + (g & 7) * 128 + 2 * lane;
#pragma unroll 4
        for (int tt = 0; tt < 16; ++tt) {
            const unsigned u = *(const unsigned*)(src + (size_t)tt * LDP); const f32x2 cur = {bflo(u), bfhi(u)};
            f32x2 y = w3 * cur + w2 * h1 + w1 * h2 + w0 * h3;
            y[0] = silu_f(y[0]); y[1] = silu_f(y[1]);
            if (g < 16) { float sc = rsqrtf(wave_sum(y[0] * y[0] + y[1] * y[1]) + EPS); if (g < 8) sc *= 0.08838834764831845f; y = y * sc; }
            *(unsigned*)(dst + (size_t)tt * 1024) = pk2(y[0], y[1]);
            h3 = h2; h2 = h1; h1 = cur;
        }
    }
}

__device__ __forceinline__ void delta_prep(const Params& P, LAS unsigned char* lds) {
    unsigned char* ws = P.ws;
    int tid = threadIdx.x; asm volatile("" : "+v"(tid));
    const int wave = __builtin_amdgcn_readfirstlane(tid >> 6), lane = tid & 63, sub = wave >> 2, tid_s = tid & 255, wv = wave & 3, fr = lane & 15, fq = lane >> 4;
    bf16_t* QA = (bf16_t*)P.out; bf16_t* KA = QA + (size_t)MROWS * 1024; bf16_t* VA = KA + (size_t)MROWS * 1024; bf16_t* WB = VA + (size_t)MROWS * 1024;
    const float* G = (const float*)(ws + WS_G); const float* BETA = (const float*)(ws + WS_BETA); bf16_t* QKM = (bf16_t*)(ws + WS_QKM); float* GL = (float*)(ws + WS_GL);
    LAS unsigned char* base = lds + sub * 53248;
    LAS bf16_t* Ks = (LAS bf16_t*)base; LAS bf16_t* Qs = (LAS bf16_t*)(base + 17408); LAS float* Am = (LAS float*)(base + 34816);
    LAS float* gcs = (LAS float*)(base + 51200); LAS float* betas = (LAS float*)(base + 51456); LAS float* bes = (LAS float*)(base + 51712);
    for (int unit = blockIdx.x; unit < 2048; unit += gridDim.x) {
        const int ch = unit * 2 + sub, n = ch & 31, bh = ch >> 5, h = bh & 7, b = bh >> 3, m0 = b * 2048 + n * 64;
#pragma unroll
        for (int i = 0; i < 4; ++i) { const int p = tid_s + 256 * i, row = p >> 4, c = p & 15; const size_t go = (size_t)(m0 + row) * 1024 + h * 128 + c * 8;
            *(LAS u32x4*)(Ks + row * 136 + c * 8) = *(const u32x4*)(KA + go); *(LAS u32x4*)(Qs + row * 136 + c * 8) = *(const u32x4*)(QA + go); }
        if (wv == 0) { float g = G[(size_t)(m0 + lane) * 8 + h];
#pragma unroll
            for (int o = 1; o < 64; o <<= 1) { const float t = __shfl_up(g, o); if (lane >= o) g += t; }
            const float be = BETA[(size_t)(m0 + lane) * 8 + h];
            gcs[lane] = g; betas[lane] = be; bes[lane] = be * expf(g); if (lane == 63) GL[ch] = expf(g); }
        __syncthreads();
        { const int ti = wv; bf16x8 ak[4], aq[4];
#pragma unroll
          for (int ks = 0; ks < 4; ++ks) { ak[ks] = *(const LAS bf16x8*)(Ks + (16 * ti + fr) * 136 + 32 * ks + fq * 8); aq[ks] = *(const LAS bf16x8*)(Qs + (16 * ti + fr) * 136 + 32 * ks + fq * 8); }
#pragma unroll
          for (int tj = 0; tj < 4; ++tj) {
              f32x4 ck = {0.f, 0.f, 0.f, 0.f}, cq = {0.f, 0.f, 0.f, 0.f};
              if (tj <= ti) {
#pragma unroll
                  for (int ks = 0; ks < 4; ++ks) { const bf16x8 bk = *(const LAS bf16x8*)(Ks + (16 * tj + fr) * 136 + 32 * ks + fq * 8);
                      ck = __builtin_amdgcn_mfma_f32_16x16x32_bf16(ak[ks], bk, ck, 0, 0, 0); cq = __builtin_amdgcn_mfma_f32_16x16x32_bf16(aq[ks], bk, cq, 0, 0, 0); } }
              const int jj = 16 * tj + fr; const float gj = gcs[jj];
#pragma unroll
              for (int j = 0; j < 4; ++j) { const int i = 16 * ti + fq * 4 + j; const float dec = (i >= jj) ? expf(gcs[i] - gj) : 0.f;
                  Am[i * 64 + jj] = (i > jj) ? betas[i] * ck[j] * dec : 0.f;
                  QKM[(size_t)ch * 4096 + i * 64 + jj] = f2bf(cq[j] * dec); }
          } }
        u32x4 vreg[4];
        const float gl = gcs[63];
#pragma unroll
        for (int i = 0; i < 4; ++i) { const int p = tid_s + 256 * i, row = p >> 4, c = p & 15; const size_t go = (size_t)(m0 + row) * 1024 + h * 128 + c * 8;
            vreg[i] = *(const u32x4*)(VA + go);
            const u32x4 q = *(const LAS u32x4*)(Qs + row * 136 + c * 8); const float e = expf(gcs[row]); u32x4 o;
            o.x = pk2(bflo(q.x) * e, bfhi(q.x) * e); o.y = pk2(bflo(q.y) * e, bfhi(q.y) * e); o.z = pk2(bflo(q.z) * e, bfhi(q.z) * e); o.w = pk2(bflo(q.w) * e, bfhi(q.w) * e);
            *(u32x4*)(QA + go) = o; }
#pragma unroll
        for (int i = 0; i < 4; ++i) { const int p = tid_s + 256 * i, dk = p & 127, j0 = (p >> 7) * 8; float v[8];
#pragma unroll
            for (int e = 0; e < 8; ++e) v[e] = bf2f(Ks[(j0 + e) * 136 + dk]) * expf(gl - gcs[j0 + e]);
            u32x4 o; o.x = pk2(v[0], v[1]); o.y = pk2(v[2], v[3]); o.z = pk2(v[4], v[5]); o.w = pk2(v[6], v[7]);
            *(u32x4*)(KA + (size_t)(m0 + (dk >> 1)) * 1024 + h * 128 + (dk & 1) * 64 + j0) = o; }
        __syncthreads();
#pragma unroll
        for (int i = 0; i < 4; ++i) { const int p = tid_s + 256 * i, row = p >> 4, c = p & 15; *(LAS u32x4*)(Qs + row * 136 + c * 8) = vreg[i]; }
        __syncthreads();
        { const int c = tid_s; const LAS bf16_t* rp = Ks + (c >> 7) * 8704 + (c & 127); const LAS float* sp = (c >= 128) ? betas : bes;
          float x[64];
#pragma unroll
          for (int i = 0; i < 64; ++i) { float s = bf2f(rp[i * 136]) * sp[i];
#pragma unroll
              for (int j = 0; j < i; ++j) s -= Am[i * 64 + j] * x[j];
              x[i] = s; }
          bf16_t* dst = ((c >= 128) ? VA : WB) + (size_t)m0 * 1024 + h * 128 + (c & 127);
#pragma unroll
          for (int i = 0; i < 64; ++i) dst[(size_t)i * 1024] = f2bf(x[i]); }
        __syncthreads();
    }
}

__device__ __forceinline__ void delta_scan(const Params& P, LAS unsigned char* lds) {
    unsigned char* ws = P.ws;
    int tid = threadIdx.x; asm volatile("" : "+v"(tid));
    const int wave = __builtin_amdgcn_readfirstlane(tid >> 6), lane = tid & 63, fr = lane & 15, fq = lane >> 4;
    const bf16_t* QA = (const bf16_t*)P.out; const bf16_t* KA = QA + (size_t)MROWS * 1024; const bf16_t* UA = KA + (size_t)MROWS * 1024; const bf16_t* WB = UA + (size_t)MROWS * 1024;
    const bf16_t* QKM = (const bf16_t*)(ws + WS_QKM); const float* GL = (const float*)(ws + WS_GL); bf16_t* proj = (bf16_t*)(ws + WS_PROJ);
    LAS bf16_t* Ws = (LAS bf16_t*)lds; LAS bf16_t* Qs = (LAS bf16_t*)(lds + 17408); LAS bf16_t* Kt = (LAS bf16_t*)(lds + 34816); LAS bf16_t* QKs = (LAS bf16_t*)(lds + 53248);
    LAS bf16_t* Us = (LAS bf16_t*)(lds + 62464); LAS bf16_t* St = (LAS bf16_t*)(lds + 71680); LAS bf16_t* VNt = (LAS bf16_t*)(lds + 89088);
    for (int unit = blockIdx.x; unit < 256; unit += gridDim.x) {
        const int half = unit & 1, bh = unit >> 1, h = bh & 7, b = bh >> 3;
        f32x4 sacc[4];
#pragma unroll
        for (int d = 0; d < 4; ++d) sacc[d] = (f32x4){0.f, 0.f, 0.f, 0.f};
        u32x4 rw[2], rq[2], rk[2], rqk, ru;
        const int it = wave >> 1, dv0 = 2 * (wave & 1);
#define SCAN_LOAD(nn) do { const int m0_ = b * 2048 + (nn) * 64; const size_t ch_ = (size_t)bh * 32 + (nn); \
            _Pragma("unroll") for (int i = 0; i < 2; ++i) { const int p = tid + 512 * i, row = p >> 4, c = p & 15; const size_t go = (size_t)(m0_ + row) * 1024 + h * 128 + c * 8; rw[i] = *(const u32x4*)(WB + go); rq[i] = *(const u32x4*)(QA + go); \
                const int dk = p >> 3, c8 = p & 7; rk[i] = *(const u32x4*)(KA + (size_t)(m0_ + (dk >> 1)) * 1024 + h * 128 + (dk & 1) * 64 + c8 * 8); } \
            { const int row = tid >> 3, c8 = tid & 7; rqk = *(const u32x4*)(QKM + ch_ * 4096 + row * 64 + c8 * 8); ru = *(const u32x4*)(UA + (size_t)(m0_ + row) * 1024 + h * 128 + half * 64 + c8 * 8); } } while (0)
#define SCAN_STORE() do { \
            _Pragma("unroll") for (int i = 0; i < 2; ++i) { const int p = tid + 512 * i, row = p >> 4, c = p & 15; *(LAS u32x4*)(Ws + row * 136 + c * 8) = rw[i]; *(LAS u32x4*)(Qs + row * 136 + c * 8) = rq[i]; \
                const int dk = p >> 3, c8 = p & 7; *(LAS u32x4*)(Kt + dk * 72 + c8 * 8) = rk[i]; } \
            { const int row = tid >> 3, c8 = tid & 7; *(LAS u32x4*)(QKs + row * 72 + c8 * 8) = rqk; *(LAS u32x4*)(Us + row * 72 + c8 * 8) = ru; } } while (0)
        SCAN_LOAD(0);
        for (int n = 0; n < 32; ++n) {
            SCAN_STORE();
#pragma unroll
            for (int d = 0; d < 4; ++d) { u32x2 w; w.x = pk2(sacc[d][0], sacc[d][1]); w.y = pk2(sacc[d][2], sacc[d][3]); *(LAS u32x2*)(St + (16 * d + fr) * 136 + 16 * wave + fq * 4) = w; }
            const float gl = GL[bh * 32 + n];
            __syncthreads();
            if (n + 1 < 32) SCAN_LOAD(n + 1);
            f32x4 a1[2], a2[2];
#pragma unroll
            for (int d = 0; d < 2; ++d) { a1[d] = (f32x4){0.f, 0.f, 0.f, 0.f}; a2[d] = (f32x4){0.f, 0.f, 0.f, 0.f}; }
#pragma unroll
            for (int ks = 0; ks < 4; ++ks) { const bf16x8 wf = *(const LAS bf16x8*)(Ws + (16 * it + fr) * 136 + 32 * ks + fq * 8), qf = *(const LAS bf16x8*)(Qs + (16 * it + fr) * 136 + 32 * ks + fq * 8);
#pragma unroll
                for (int d = 0; d < 2; ++d) { const bf16x8 sf = *(const LAS bf16x8*)(St + (16 * (dv0 + d) + fr) * 136 + 32 * ks + fq * 8);
                    a1[d] = __builtin_amdgcn_mfma_f32_16x16x32_bf16(wf, sf, a1[d], 0, 0, 0); a2[d] = __builtin_amdgcn_mfma_f32_16x16x32_bf16(qf, sf, a2[d], 0, 0, 0); } }
#pragma unroll
            for (int d = 0; d < 2; ++d) { const int dv = 16 * (dv0 + d) + fr; float vn[4];
#pragma unroll
                for (int j = 0; j < 4; ++j) vn[j] = bf2f(Us[(16 * it + fq * 4 + j) * 72 + dv]) - a1[d][j];
                u32x2 w; w.x = pk2(vn[0], vn[1]); w.y = pk2(vn[2], vn[3]); *(LAS u32x2*)(VNt + dv * 72 + 16 * it + fq * 4) = w; }
            __syncthreads();
#pragma unroll
            for (int d = 0; d < 4; ++d) sacc[d] = sacc[d] * gl;
#pragma unroll
            for (int k2 = 0; k2 < 2; ++k2) { const bf16x8 qkf = *(const LAS bf16x8*)(QKs + (16 * it + fr) * 72 + 32 * k2 + fq * 8), kf = *(const LAS bf16x8*)(Kt + (16 * wave + fr) * 72 + 32 * k2 + fq * 8);
#pragma unroll
                for (int d = 0; d < 4; ++d) { const bf16x8 vf = *(const LAS bf16x8*)(VNt + (16 * d + fr) * 72 + 32 * k2 + fq * 8);
                    sacc[d] = __builtin_amdgcn_mfma_f32_16x16x32_bf16(kf, vf, sacc[d], 0, 0, 0);
                    if (d == dv0) a2[0] = __builtin_amdgcn_mfma_f32_16x16x32_bf16(qkf, vf, a2[0], 0, 0, 0);
                    if (d == dv0 + 1) a2[1] = __builtin_amdgcn_mfma_f32_16x16x32_bf16(qkf, vf, a2[1], 0, 0, 0); } }
            { const int m0 = b * 2048 + n * 64;
#pragma unroll
              for (int d = 0; d < 2; ++d)
#pragma unroll
                  for (int j = 0; j < 4; ++j) proj[(size_t)(m0 + 16 * it + fq * 4 + j) * LDP + C_Q + h * 128 + half * 64 + 16 * (dv0 + d) + fr] = f2bf(a2[d][j]); }
            __syncthreads();
        }
#undef SCAN_LOAD
#undef SCAN_STORE
    }
}

__device__ __forceinline__ void mla_attention(const Params& P, LAS unsigned char* lds) {
    unsigned char* ws = P.ws;
    int tid = threadIdx.x; asm volatile("" : "+v"(tid));
    const int wave = __builtin_amdgcn_readfirstlane(tid >> 6), lane = tid & 63, fr = lane & 15, fq = lane >> 4;
    bf16_t* proj = (bf16_t*)(ws + WS_PROJ); const bf16_t* KN = (const bf16_t*)(ws + WS_ACT); const bf16_t* VT = KN + (size_t)MROWS * 1024;
    const int kkey = tid >> 3, kseg = tid & 7, vdv = tid >> 2, vseg = tid & 3;
    for (int L = blockIdx.x; L < 1024; L += gridDim.x) {
        const int r = L >> 8, c = L & 255, bh = c >> 1, pp = c & 1, h = bh & 7, b = bh >> 3;
        const int qi = (pp == 0) ? ((r == 0) ? 7 : (r == 1) ? 0 : (r == 2) ? 5 : 2) : ((r == 0) ? 6 : (r == 1) ? 1 : (r == 2) ? 4 : 3);
        const int q0 = qi * 256, ntiles = 4 * (qi + 1);
        bf16x8 qf[2][6];
#pragma unroll
        for (int m = 0; m < 2; ++m)
#pragma unroll
            for (int ks = 0; ks < 6; ++ks) qf[m][ks] = *(const bf16x8*)(proj + (size_t)(b * 2048 + q0 + 32 * wave + 16 * m + fr) * LDP + C_MQ + h * 192 + 32 * ks + fq * 8);
        f32x4 accO[2][8];
#pragma unroll
        for (int m = 0; m < 2; ++m)
#pragma unroll
            for (int d = 0; d < 8; ++d) accO[m][d] = (f32x4){0.f, 0.f, 0.f, 0.f};
        float mrow[2] = {-INFINITY, -INFINITY}, lsum[2] = {0.f, 0.f};
        u32x4 rk0, rk1, rkr, rv0, rv1;
#define ATT_LOAD(kt) do { const size_t krow = (size_t)(b * 2048 + (kt) * 64 + kkey); const bf16_t* kp = KN + krow * 1024 + h * 128 + 16 * kseg; rk0 = *(const u32x4*)kp; rk1 = *(const u32x4*)(kp + 8); \
            rkr = *(const u32x4*)(proj + krow * LDP + C_KR + 8 * kseg); const bf16_t* vp = VT + ((size_t)bh * 128 + vdv) * 2048 + (kt) * 64 + 16 * vseg; rv0 = *(const u32x4*)vp; rv1 = *(const u32x4*)(vp + 8); } while (0)
#define ATT_STORE(buf) do { LAS bf16_t* Kb = (LAS bf16_t*)(lds + (buf) * 25600); LAS bf16_t* Vb = (LAS bf16_t*)(lds + 51200 + (buf) * 18432); \
            float f[16]; f[0] = bflo(rk0.x); f[1] = bfhi(rk0.x); f[2] = bflo(rk0.y); f[3] = bfhi(rk0.y); f[4] = bflo(rk0.z); f[5] = bfhi(rk0.z); f[6] = bflo(rk0.w); f[7] = bfhi(rk0.w); \
            f[8] = bflo(rk1.x); f[9] = bfhi(rk1.x); f[10] = bflo(rk1.y); f[11] = bfhi(rk1.y); f[12] = bflo(rk1.z); f[13] = bfhi(rk1.z); f[14] = bflo(rk1.w); f[15] = bfhi(rk1.w); \
            float ss = 0.f; _Pragma("unroll") for (int e = 0; e < 16; ++e) ss += f[e] * f[e]; \
            ss += __shfl_xor(ss, 1); ss += __shfl_xor(ss, 2); ss += __shfl_xor(ss, 4); const float rs = rsqrtf(ss * (1.f / 128.f) + EPS); \
            u32x4 o0, o1; o0.x = pk2(f[0] * rs, f[1] * rs); o0.y = pk2(f[2] * rs, f[3] * rs); o0.z = pk2(f[4] * rs, f[5] * rs); o0.w = pk2(f[6] * rs, f[7] * rs); \
            o1.x = pk2(f[8] * rs, f[9] * rs); o1.y = pk2(f[10] * rs, f[11] * rs); o1.z = pk2(f[12] * rs, f[13] * rs); o1.w = pk2(f[14] * rs, f[15] * rs); \
            *(LAS u32x4*)(Kb + kkey * 200 + 16 * kseg) = o0; *(LAS u32x4*)(Kb + kkey * 200 + 16 * kseg + 8) = o1; *(LAS u32x4*)(Kb + kkey * 200 + 128 + 8 * kseg) = rkr; \
            *(LAS u32x4*)(Vb + vdv * 72 + 16 * vseg) = rv0; *(LAS u32x4*)(Vb + vdv * 72 + 16 * vseg + 8) = rv1; } while (0)
        ATT_LOAD(0); ATT_STORE(0);
        __syncthreads();
        for (int kt = 0; kt < ntiles; ++kt) {
            const bool more = (kt + 1 < ntiles);
            if (more) ATT_LOAD(kt + 1);
            const bool active = (kt < 4 * qi) || ((kt - 4 * qi) <= (wave >> 1));
            if (active) {
                const LAS bf16_t* Kb = (const LAS bf16_t*)(lds + (kt & 1) * 25600); const LAS bf16_t* Vb = (const LAS bf16_t*)(lds + 51200 + (kt & 1) * 18432);
                f32x4 accS[2][4];
#pragma unroll
                for (int m = 0; m < 2; ++m)
#pragma unroll
                    for (int n = 0; n < 4; ++n) accS[m][n] = (f32x4){0.f, 0.f, 0.f, 0.f};
#pragma unroll
                for (int ks = 0; ks < 6; ++ks)
#pragma unroll
                    for (int n = 0; n < 4; ++n) { const bf16x8 kf = *(const LAS bf16x8*)(Kb + (16 * n + fr) * 200 + 32 * ks + fq * 8);
                        accS[0][n] = __builtin_amdgcn_mfma_f32_16x16x32_bf16(kf, qf[0][ks], accS[0][n], 0, 0, 0); accS[1][n] = __builtin_amdgcn_mfma_f32_16x16x32_bf16(kf, qf[1][ks], accS[1][n], 0, 0, 0); }
                bf16x8 pf[2][2];
#pragma unroll
                for (int m = 0; m < 2; ++m) {
                    float mx = accS[m][0][0];
#pragma unroll
                    for (int n = 0; n < 4; ++n)
#pragma unroll
                        for (int j = 0; j < 4; ++j) mx = fmaxf(mx, accS[m][n][j]);
                    mx = fmaxf(mx, __shfl_xor(mx, 16)); mx = fmaxf(mx, __shfl_xor(mx, 32));
                    const float mnew = fmaxf(mrow[m], mx), alpha = __builtin_amdgcn_exp2f(mrow[m] - mnew); mrow[m] = mnew;
                    float ps = 0.f; float p[4][4];
#pragma unroll
                    for (int n = 0; n < 4; ++n)
#pragma unroll
                        for (int j = 0; j < 4; ++j) { p[n][j] = __builtin_amdgcn_exp2f(accS[m][n][j] - mnew); ps += p[n][j]; }
                    lsum[m] = lsum[m] * alpha + ps;
#pragma unroll
                    for (int d = 0; d < 8; ++d) accO[m][d] = accO[m][d] * alpha;
#pragma unroll
                    for (int t = 0; t < 2; ++t) { u32x4 w; w.x = pk2(p[2 * t][0], p[2 * t][1]); w.y = pk2(p[2 * t][2], p[2 * t][3]); w.z = pk2(p[2 * t + 1][0], p[2 * t + 1][1]); w.w = pk2(p[2 * t + 1][2], p[2 * t + 1][3]);
                        pf[m][t] = __builtin_bit_cast(bf16x8, w); }
                }
#pragma unroll
                for (int d = 0; d < 8; ++d)
#pragma unroll
                    for (int t = 0; t < 2; ++t) { const LAS bf16_t* vp = Vb + (16 * d + fr) * 72 + 32 * t + fq * 4; u32x4 w; const u32x2 lo = *(const LAS u32x2*)vp, hi = *(const LAS u32x2*)(vp + 16);
                        w.x = lo.x; w.y = lo.y; w.z = hi.x; w.w = hi.y; const bf16x8 vf = __builtin_bit_cast(bf16x8, w);
                        accO[0][d] = __builtin_amdgcn_mfma_f32_16x16x32_bf16(vf, pf[0][t], accO[0][d], 0, 0, 0); accO[1][d] = __builtin_amdgcn_mfma_f32_16x16x32_bf16(vf, pf[1][t], accO[1][d], 0, 0, 0); }
            }
            if (more) ATT_STORE((kt + 1) & 1);
            __syncthreads();
        }
#undef ATT_LOAD
#undef ATT_STORE
#pragma unroll
        for (int m = 0; m < 2; ++m) { float l = lsum[m]; l += __shfl_xor(l, 16); l += __shfl_xor(l, 32); const float il = 1.f / l;
            bf16_t* op = proj + (size_t)(b * 2048 + q0 + 32 * wave + 16 * m + fr) * LDP + C_K + h * 128 + fq * 4;
#pragma unroll
            for (int d = 0; d < 8; ++d) { u32x2 w; w.x = pk2(accO[m][d][0] * il, accO[m][d][1] * il); w.y = pk2(accO[m][d][2] * il, accO[m][d][3] * il); *(u32x2*)(op + 16 * d) = w; } }
    }
}

__device__ __forceinline__ void oa_finalize(const Params& P, int gw, int NGW, int lane) {
    bf16_t* proj = (bf16_t*)(P.ws + WS_PROJ); const float* gain = (const float*)P.in[8];
    const float g0 = gain[2 * lane], g1 = gain[2 * lane + 1];
    for (int m = gw; m < MROWS; m += NGW) { bf16_t* row = proj + (size_t)m * LDP;
#pragma unroll 4
        for (int h = 0; h < 8; ++h) { const unsigned w = *(const unsigned*)(row + C_Q + h * 128 + 2 * lane), z = *(const unsigned*)(row + C_Z + h * 128 + 2 * lane);
            const float v0 = bflo(w), v1 = bfhi(w); const float rstd = rsqrtf(wave_sum(v0 * v0 + v1 * v1) * (1.f / 128.f) + EPS);
            *(unsigned*)(row + C_Q + h * 128 + 2 * lane) = pk2(v0 * rstd * g0 * silu_f(bflo(z)), v1 * rstd * g1 * silu_f(bfhi(z))); } }
}

__global__ void __launch_bounds__(512) fwd_megakernel(Params P) {
    extern __shared__ __attribute__((aligned(16))) unsigned char lds_raw[];
    LAS unsigned char* lds = (LAS unsigned char*)lds_raw;
    cg::grid_group grid = cg::this_grid();
    const int G = gridDim.x, NGW = G * 8;
#define PHASE_IDS() int tid_ = threadIdx.x; asm volatile("" : "+v"(tid_)); const int lane = tid_ & 63, wave = __builtin_amdgcn_readfirstlane(tid_ >> 6), gw = blockIdx.x * 8 + wave
    unsigned char* ws = P.ws;
    bf16_t* ACT = (bf16_t*)(ws + WS_ACT); bf16_t* PROJ = (bf16_t*)(ws + WS_PROJ);
    pg8::StaticOrder S;

    { PHASE_IDS(); p0_prologue(P, lds, gw, NGW, wave, lane); }
    grid.sync();
    { pg8::Gemm g{ACT, (const bf16_t*)(ws + WS_WIN), MROWS, LDP, 2048, 2048}; S.init(MROWS, LDP, G, blockIdx.x);
      Epi<EP_BF16> E{PROJ, nullptr, LDP, nullptr, nullptr, nullptr}; pg8::gemm_phase(lds, g, S, E); }
    grid.sync();
    { PHASE_IDS(); p2_prep(P, gw, NGW, lane); }
    grid.sync();
    { pg8::Gemm g{PROJ + C_CKV, (const bf16_t*)(ws + WS_WKV), MROWS, 2048, 512, LDP}; S.init(MROWS, 2048, G, blockIdx.x);
      Epi<EP_KV> E{ACT, nullptr, 1024, nullptr, nullptr, ACT + (size_t)MROWS * 1024}; pg8::gemm_phase(lds, g, S, E); }
    __syncthreads();
    delta_prep(P, lds);
    grid.sync();
    delta_scan(P, lds);
    __syncthreads();
    mla_attention(P, lds);
    grid.sync();
    { PHASE_IDS(); oa_finalize(P, gw, NGW, lane); }
    grid.sync();
    { pg8::Gemm g{PROJ + C_Q, (const bf16_t*)(ws + WS_WA), MROWS, 2048, 1024, LDP}; S.init(MROWS, 2048, G, blockIdx.x);
      Epi<EP_YA> E{nullptr, P.out, DM, PROJ, nullptr, nullptr}; pg8::gemm_phase(lds, g, S, E); }
    { pg8::Gemm g{PROJ + C_K, (const bf16_t*)(ws + WS_WB), MROWS, 2048, 1024, LDP}; S.init(MROWS, 2048, G, blockIdx.x);
      Epi<EP_YB> E{ACT, P.out, DM, PROJ, nullptr, nullptr}; pg8::gemm_phase(lds, g, S, E); }
    grid.sync();
    { pg8::Gemm g{ACT, (const bf16_t*)(ws + WS_WOUT), MROWS, 2048, 2048, 2048}; S.init(MROWS, 2048, G, blockIdx.x);
      Epi<EP_X1> E{nullptr, P.out, DM, nullptr, (const float*)P.in[0], nullptr}; pg8::gemm_phase(lds, g, S, E); }
    grid.sync();
    { PHASE_IDS(); rmsnorm_rows_phase(P.out, (const float*)P.in[18], ACT, gw, NGW, lane); }
    grid.sync();
    { pg8::Gemm g{ACT, (const bf16_t*)(ws + WS_WUP), MROWS, DFF, 2048, 2048}; S.init(MROWS, DFF, G, blockIdx.x);
      Epi<EP_RELU2> E{PROJ, nullptr, DFF, nullptr, nullptr, nullptr}; pg8::gemm_phase(lds, g, S, E); }
    grid.sync();
    { pg8::Gemm g{PROJ, (const bf16_t*)(ws + WS_WDN), MROWS, 2048, DFF, DFF}; S.init(MROWS, 2048, G, blockIdx.x);
      Epi<EP_ACC> E{nullptr, P.out, DM, nullptr, nullptr, nullptr}; pg8::gemm_phase(lds, g, S, E); }
    grid.sync();
    { PHASE_IDS(); rmsnorm_rows_phase(P.out, (const float*)P.in[21], ACT, gw, NGW, lane); }
    { pg8::Gemm g{(const bf16_t*)(ws + WS_PBF), (const bf16_t*)(ws + WS_WPLE), MROWS, 2048, 256, 256}; S.init(MROWS, 2048, G, blockIdx.x);
      Epi<EP_F32> E{nullptr, (float*)(ws + WS_PROJ), DM, nullptr, nullptr, nullptr}; pg8::gemm_phase(lds, g, S, E); }
    grid.sync();
    { pg8::Gemm g{ACT, (const bf16_t*)(ws + WS_WPG), MROWS, 2048, 2048, 2048}; S.init(MROWS, 2048, G, blockIdx.x);
      Epi<EP_PLE> E{nullptr, P.out, DM, nullptr, (const float*)(ws + WS_PROJ), nullptr}; pg8::gemm_phase(lds, g, S, E); }
}

extern "C" void kernel_launch(void* const* d_in, const int* in_sizes, int n_in, void* d_out, int out_size, void* d_ws, size_t ws_size, hipStream_t stream) {
    static int grid = 0;
    if (grid == 0) {
        if (n_in != 24 || out_size != MROWS * DM || ws_size < WS_END) { fprintf(stderr, "kernel_launch: unexpected shapes: n_in %d out %d ws %zu (need %zu)\n", n_in, out_size, ws_size, (size_t)WS_END); grid = -1; return; }
        int dev = 0, cus = 0, per_cu = 0;
        if (hipGetDevice(&dev) != hipSuccess || hipDeviceGetAttribute(&cus, hipDeviceAttributeMultiprocessorCount, dev) != hipSuccess) { grid = -1; return; }
        if (hipFuncSetAttribute((const void*)fwd_megakernel, hipFuncAttributeMaxDynamicSharedMemorySize, LDS_BYTES) != hipSuccess) { fprintf(stderr, "kernel_launch: hipFuncSetAttribute failed\n"); grid = -1; return; }
        if (hipOccupancyMaxActiveBlocksPerMultiprocessor(&per_cu, (const void*)fwd_megakernel, 512, LDS_BYTES) != hipSuccess || per_cu < 1) { fprintf(stderr, "kernel_launch: occupancy query gave %d\n", per_cu); per_cu = 1; }
        (void)hipGetLastError();
        grid = cus * per_cu;
        fprintf(stderr, "kernel_launch: grid %d (cus %d x %d), ws %zu\n", grid, cus, per_cu, ws_size);
    }
    if (grid < 0) return;
    Params p{};
    for (int i = 0; i < 24; ++i) p.in[i] = d_in[i];
    p.out = (float*)d_out; p.ws = (unsigned char*)d_ws;
    for (int i = 0; i < 32; ++i) p.ropeinv[i] = (float)pow(10000.0, -(double)i / 32.0);
    void* args[] = {&p};
    hipError_t e = hipLaunchCooperativeKernel((const void*)fwd_megakernel, dim3(grid), dim3(512), args, LDS_BYTES, stream);
    if (e != hipSuccess) fprintf(stderr, "kernel_launch: cooperative launch failed: %s (grid %d)\n", hipGetErrorString(e), grid);
}
```

```cpp
#include <hip/hip_runtime.h>
#include <hip/hip_cooperative_groups.h>
#include <cstdio>
#include <cstdint>
#include <cmath>
namespace cg = cooperative_groups;
#ifndef PROBE_MASK
#define PROBE_MASK 0u
#endif
#define PROBE_MULT 3
#define PT_B(bit) do { if ((PROBE_MASK >> (bit)) & 1u) { __builtin_amdgcn_s_waitcnt(0); pt_last = __builtin_amdgcn_s_memrealtime(); } } while (0)
#define PT_E(bit) do { if ((PROBE_MASK >> (bit)) & 1u) { __builtin_amdgcn_s_waitcnt(0); pt_acc += __builtin_amdgcn_s_memrealtime() - pt_last; } } while (0)

#define LAS __attribute__((address_space(3)))
typedef unsigned short bf16_t;
typedef short bf16x8 __attribute__((ext_vector_type(8)));
typedef float f32x4 __attribute__((ext_vector_type(4)));
typedef float f32x2 __attribute__((ext_vector_type(2)));
typedef unsigned u32x4 __attribute__((ext_vector_type(4)));
typedef unsigned u32x2 __attribute__((ext_vector_type(2)));

constexpr int NB = 16, SEQ = 2048, MROWS = NB * SEQ, DM = 2048, LDP = 10496, DFF = 8192, PLE = 256;
constexpr int C_Q = 0, C_K = 1024, C_V = 2048, C_Z = 3072, C_MQ = 4096, C_CKV = 5632, C_GA = 6144, C_GB = 8192, C_KR = 10240, C_BETA = 10304, C_ALPHA = 10312;
constexpr int D_IN = 10320;
constexpr float EPS = 1e-6f;
constexpr float LOG2E = 1.4426950408889634f;
constexpr size_t MiB = 1u << 20;
constexpr size_t WS_WIN = 0, WS_WKV = 41 * MiB, WS_WA = 43 * MiB, WS_WB = 47 * MiB, WS_WOUT = 51 * MiB, WS_WUP = 59 * MiB, WS_WDN = 91 * MiB, WS_WPG = 123 * MiB,
                 WS_WPLE = 131 * MiB, WS_PBF = 132 * MiB, WS_G = 148 * MiB, WS_BETA = 149 * MiB, WS_QKM = 150 * MiB, WS_ACT = 182 * MiB, WS_PROJ = 310 * MiB,
                 WS_GL = 966 * MiB, WS_CTL = 967 * MiB, WS_END = 968 * MiB;
constexpr size_t CTL_BYTES = 1 * MiB;
constexpr size_t WS_SSQ1 = WS_CTL + 256 * 1024, WS_SSQ2 = WS_CTL + 512 * 1024;
constexpr size_t WS_XB = WS_PROJ + 512 * MiB;
constexpr int LDS_BYTES = 147456;

__device__ __forceinline__ float bf2f(bf16_t v) { return __uint_as_float((unsigned)v << 16); }
__device__ __forceinline__ float bflo(unsigned w) { return __uint_as_float(w << 16); }
__device__ __forceinline__ float bfhi(unsigned w) { return __uint_as_float(w & 0xffff0000u); }
__device__ __forceinline__ unsigned pk2(float lo, float hi) { unsigned r; asm("v_cvt_pk_bf16_f32 %0, %1, %2" : "=v"(r) : "v"(lo), "v"(hi)); return r; }
__device__ __forceinline__ bf16_t f2bf(float f) { return (bf16_t)(pk2(f, 0.f) & 0xffffu); }
__device__ __forceinline__ float wave_sum(float v) {
#pragma unroll
    for (int o = 1; o < 64; o <<= 1) v += __shfl_xor(v, o);
    return v;
}
__device__ __forceinline__ float fast_sigmoid(float x) { return __builtin_amdgcn_rcpf(1.f + __builtin_amdgcn_exp2f(-x * LOG2E)); }
__device__ __forceinline__ float silu_f(float x) { return x * fast_sigmoid(x); }
#define LDS_WAIT() asm volatile("s_waitcnt lgkmcnt(0)" ::: "memory")

namespace pg8 {
constexpr int BM = 256, BK = 64, HALF = 128, HTB = HALF * BK * 2, STAGE_BYTES = 8 * HTB, NXCD = 8, WGM = 8;
__host__ __device__ __forceinline__ int lds_byte(int r, int c) { const int st = (r >> 4) * 2 + (c >> 5), rr = r & 15, cc = c & 31, ob = rr * 64 + cc * 2; return st * 1024 + (ob ^ (((ob >> 9) & 1) << 5)); }
__host__ __device__ __forceinline__ void stage_rc(int b, int& R, int& C) { const int st = b / 1024, sb = b % 1024, swz = sb ^ (((sb >> 9) & 1) << 5); R = (st >> 1) * 16 + swz / 64; C = (st & 1) * 32 + (swz % 64) / 2; }
__host__ __device__ __forceinline__ int perm32(int rho) { const int n = rho >> 4, i = rho & 15; return 8 * (i >> 2) + 4 * n + (i & 3); }
struct Unit { int pm, pn; };
struct Gemm { const bf16_t* A; const bf16_t* Bt; int M, N, K, lda; };
struct StaticOrder {
    int nM, nN, nwg, G, c;
    __device__ void init(int M, int N, int G_, int c_) { nM = M / BM; nN = N / BM; nwg = nM * nN; G = G_; c = c_; }
    __device__ bool next(int i, Unit& u) const {
        const long L = (long)i * G + c; if (L >= nwg) return false;
        int wgid = (int)L; { const int q = nwg / NXCD, r = nwg % NXCD, xcd = wgid % NXCD, off = wgid / NXCD; wgid = (xcd < r ? xcd * (q + 1) : r * (q + 1) + (xcd - r) * q) + off; }
        const int nig = WGM * nN, gid = wgid / nig, fm = gid * WGM, gsz = (nM - fm) < WGM ? (nM - fm) : WGM;
        u.pm = fm + ((wgid % nig) % gsz); u.pn = (wgid % nig) / gsz; return true;
    }
};
template <class Epi>
__device__ __forceinline__ void gemm_phase(LAS unsigned char* lds, const Gemm g, const StaticOrder& S, const Epi& E) {
    int tid = threadIdx.x; asm volatile("" : "+v"(tid));
    const int wid = __builtin_amdgcn_readfirstlane(tid >> 6), lane = tid & 63, wr = wid >> 2, wc = wid & 3, fr = lane & 15, fq = lane >> 4;
    const int K = g.K, nt = K / BK, lda = g.lda;
    unsigned voffA[2], voffB[2];
#pragma unroll
    for (int i = 0; i < 2; ++i) { int R, C; stage_rc(tid * 16 + i * 8192, R, C); const int Rb = ((R & ~31) + perm32(R & 31));
        voffA[i] = (unsigned)(R * lda + C) * 2u; voffB[i] = (unsigned)(Rb * K + C) * 2u; }
    const size_t kstep = (size_t)(BK * 2);
    const size_t hstepA = (size_t)HALF * lda * 2, tstepA = 2 * hstepA, hstepB = (size_t)HALF * K * 2, tstepB = 2 * hstepB;
    const unsigned ldsw = (unsigned)wid * 1024u;
    const int aoff = lds_byte(wr * 64 + fr, fq * 8), boff = lds_byte(wc * 32 + fr, fq * 8);
#define PG8_SA(b, h) (((b) * 2 + (h)) * HTB)
#define PG8_SB(b, h) ((4 + (b) * 2 + (h)) * HTB)
#define PG8_STAGE(bufoff, gbase, voff) do { _Pragma("unroll") for (int _i = 0; _i < 2; ++_i) \
        __builtin_amdgcn_global_load_lds((const unsigned*)((const char*)(gbase) + (voff)[_i]), (LAS unsigned*)(lds + (bufoff) + ldsw + _i * 8192), 16, 0, 0); } while (0)
#define PG8_LDA(dst, b, h) do { _Pragma("unroll") for (int m = 0; m < 4; ++m) _Pragma("unroll") for (int k = 0; k < 2; ++k) dst[m][k] = *(const LAS bf16x8*)(lds + PG8_SA(b, h) + aoff + m * 2048 + k * 1024); } while (0)
#define PG8_LDB(dst, b, h) do { _Pragma("unroll") for (int n = 0; n < 2; ++n) _Pragma("unroll") for (int k = 0; k < 2; ++k) dst[n][k] = *(const LAS bf16x8*)(lds + PG8_SB(b, h) + boff + n * 2048 + k * 1024); } while (0)
#define PG8_MMA(ai, bj, At, Bt) do { __builtin_amdgcn_s_setprio(1); _Pragma("unroll") for (int m = 0; m < 4; ++m) _Pragma("unroll") for (int n = 0; n < 2; ++n) _Pragma("unroll") for (int k = 0; k < 2; ++k) { \
        if constexpr (Epi::SWAP1 && (bj) == 1) acc[ai][bj][m][n] = __builtin_amdgcn_mfma_f32_16x16x32_bf16(At[m][k], Bt[n][k], acc[ai][bj][m][n], 0, 0, 0); \
        else acc[ai][bj][m][n] = __builtin_amdgcn_mfma_f32_16x16x32_bf16(Bt[n][k], At[m][k], acc[ai][bj][m][n], 0, 0, 0); } __builtin_amdgcn_s_setprio(0); } while (0)
#define PG8_WAIT_V(n) asm volatile("s_waitcnt vmcnt(" #n ")" ::: "memory")
#define PG8_WAIT_L(n) asm volatile("s_waitcnt lgkmcnt(" #n ")" ::: "memory")
#define PG8_BAR __builtin_amdgcn_s_barrier()
#define PG8_SCHED __builtin_amdgcn_sched_barrier(0)
    Unit cur, nxt; int ui = 0;
    if (!S.next(0, cur)) return;
    f32x4 acc[2][2][4][2];
#pragma unroll
    for (int a = 0; a < 2; ++a)
#pragma unroll
        for (int b = 0; b < 2; ++b)
#pragma unroll
            for (int m = 0; m < 4; ++m)
#pragma unroll
                for (int n = 0; n < 2; ++n) acc[a][b][m][n] = (f32x4){0.f, 0.f, 0.f, 0.f};
    bf16x8 At[4][2], B0[2][2], B1[2][2];
    const char* cA = (const char*)g.A + (size_t)cur.pm * tstepA; const char* cB = (const char*)g.Bt + (size_t)cur.pn * tstepB;
    PG8_STAGE(PG8_SB(0, 0), cB, voffB); PG8_STAGE(PG8_SB(0, 1), cB + hstepB, voffB); PG8_STAGE(PG8_SA(0, 0), cA, voffA); PG8_STAGE(PG8_SA(0, 1), cA + hstepA, voffA);
    if (wr == 1) PG8_BAR;
    PG8_WAIT_V(2); PG8_BAR;
    PG8_STAGE(PG8_SB(1, 0), cB + kstep, voffB); PG8_STAGE(PG8_SA(1, 0), cA + kstep, voffA); PG8_STAGE(PG8_SB(1, 1), cB + hstepB + kstep, voffB);
    PG8_WAIT_V(6); PG8_BAR;
    for (;;) {
        const bool has_next = S.next(ui + 1, nxt);
        const char* nA = has_next ? (const char*)g.A + (size_t)nxt.pm * tstepA : cA; const char* nB = has_next ? (const char*)g.Bt + (size_t)nxt.pn * tstepB : cB;
        for (int t = 0; t < nt; t += 2) {
            const bool last = (t == nt - 2);
            const char* a1 = cA + (size_t)(t + 1) * kstep;
            const char* a2 = last ? nA : cA + (size_t)(t + 2) * kstep; const char* b2 = last ? nB : cB + (size_t)(t + 2) * kstep;
            const char* a3 = a2 + kstep; const char* b3 = b2 + kstep;
            PG8_LDB(B0, 0, 0); PG8_LDB(B1, 0, 1); PG8_SCHED; PG8_LDA(At, 0, 0); PG8_STAGE(PG8_SA(1, 1), a1 + hstepA, voffA);
            PG8_WAIT_V(8); PG8_WAIT_L(0); PG8_BAR; PG8_MMA(0, 0, At, B0); PG8_MMA(0, 1, At, B1); PG8_BAR; PG8_SCHED;
            PG8_LDA(At, 0, 1); PG8_STAGE(PG8_SB(0, 0), b2, voffB); PG8_STAGE(PG8_SB(0, 1), b2 + hstepB, voffB); PG8_STAGE(PG8_SA(0, 0), a2, voffA);
            PG8_WAIT_V(8); PG8_WAIT_L(0); PG8_BAR; PG8_MMA(1, 0, At, B0); PG8_MMA(1, 1, At, B1); PG8_BAR; PG8_SCHED;
            PG8_LDB(B0, 1, 0); PG8_LDB(B1, 1, 1); PG8_SCHED; PG8_LDA(At, 1, 0); PG8_STAGE(PG8_SA(0, 1), a2 + hstepA, voffA);
            PG8_WAIT_V(8); PG8_WAIT_L(0); PG8_BAR; PG8_MMA(0, 0, At, B0); PG8_MMA(0, 1, At, B1); PG8_BAR; PG8_SCHED;
            PG8_LDA(At, 1, 1); PG8_STAGE(PG8_SB(1, 0), b3, voffB); PG8_STAGE(PG8_SB(1, 1), b3 + hstepB, voffB); PG8_STAGE(PG8_SA(1, 0), a3, voffA);
            PG8_WAIT_V(8); PG8_WAIT_L(0); PG8_BAR; PG8_MMA(1, 0, At, B0); PG8_MMA(1, 1, At, B1); PG8_BAR; PG8_SCHED;
        }
        if (wr == 0) PG8_BAR;
        E(acc, cur, wr, wc, fr, fq);
        if (!has_next) break;
#pragma unroll
        for (int a = 0; a < 2; ++a)
#pragma unroll
            for (int b = 0; b < 2; ++b)
#pragma unroll
                for (int m = 0; m < 4; ++m)
#pragma unroll
                    for (int n = 0; n < 2; ++n) acc[a][b][m][n] = (f32x4){0.f, 0.f, 0.f, 0.f};
        cur = nxt; cA = nA; cB = nB; ++ui;
        if (wr == 1) PG8_BAR;
    }
    PG8_WAIT_V(0);
    PG8_BAR;
#undef PG8_SA
#undef PG8_SB
#undef PG8_STAGE
#undef PG8_LDA
#undef PG8_LDB
#undef PG8_MMA
#undef PG8_WAIT_V
#undef PG8_WAIT_L
#undef PG8_BAR
#undef PG8_SCHED
}
}

enum { EP_BF16 = 0, EP_KV, EP_YA, EP_YB, EP_X1, EP_RELU2, EP_ACC, EP_F32, EP_PLE };
__device__ __forceinline__ void store8bf(bf16_t* p, f32x4 a, f32x4 b) { u32x4 w; w.x = pk2(a[0], a[1]); w.y = pk2(a[2], a[3]); w.z = pk2(b[0], b[1]); w.w = pk2(b[2], b[3]); *(u32x4*)p = w; }
__device__ __forceinline__ void load8bf(const bf16_t* p, f32x4& a, f32x4& b) { const u32x4 w = *(const u32x4*)p; a = (f32x4){bflo(w.x), bfhi(w.x), bflo(w.y), bfhi(w.y)}; b = (f32x4){bflo(w.z), bfhi(w.z), bflo(w.w), bfhi(w.w)}; }
__device__ __forceinline__ f32x4 sig4(f32x4 v) { return (f32x4){fast_sigmoid(v[0]), fast_sigmoid(v[1]), fast_sigmoid(v[2]), fast_sigmoid(v[3])}; }
__device__ __forceinline__ void nt_store8bf(bf16_t* p, f32x4 a, f32x4 b) { u32x4 w; w.x = pk2(a[0], a[1]); w.y = pk2(a[2], a[3]); w.z = pk2(b[0], b[1]); w.w = pk2(b[2], b[3]); __builtin_nontemporal_store(w, (u32x4*)p); }
__device__ __forceinline__ u32x4 nt_load16(const bf16_t* p) { return __builtin_nontemporal_load((const u32x4*)p); }
__device__ __forceinline__ f32x4 nt_loadf4(const float* p) { return __builtin_nontemporal_load((const f32x4*)p); }
template <int MODE> struct Epi {
    static constexpr bool SWAP1 = (MODE == EP_KV);
    bf16_t* ob; float* of; int ldc; const bf16_t* gate; const float* res; bf16_t* vt; float* ssq;
    struct Pre { f32x4 f[2][2]; u32x4 g[2]; u32x4 y[2]; };
    __device__ __forceinline__ void preload(Pre& p, int row, int col0) const {
#pragma unroll
        for (int bj = 0; bj < 2; ++bj) { const int col = col0 + bj * 128;
            if constexpr (MODE == EP_YA) p.g[bj] = nt_load16(gate + (size_t)row * LDP + C_GA + col);
            else if constexpr (MODE == EP_YB) { p.g[bj] = nt_load16(gate + (size_t)row * LDP + C_GB + col); p.y[bj] = nt_load16(ob + (size_t)row * DM + col); }
            else if constexpr (MODE == EP_X1) { const float* r = res + (size_t)row * DM + col; p.f[bj][0] = nt_loadf4(r); p.f[bj][1] = nt_loadf4(r + 4); }
            else if constexpr (MODE == EP_ACC) p.y[bj] = nt_load16(ob + (size_t)row * DM + col);
            else if constexpr (MODE == EP_PLE) { p.y[bj] = nt_load16(vt + (size_t)row * DM + col); p.g[bj] = nt_load16(gate + (size_t)row * DM + col); }
        }
    }
    static __device__ __forceinline__ void up8(const u32x4 w, f32x4& a, f32x4& b) { a = (f32x4){bflo(w.x), bfhi(w.x), bflo(w.y), bfhi(w.y)}; b = (f32x4){bflo(w.z), bfhi(w.z), bflo(w.w), bfhi(w.w)}; }
    __device__ __forceinline__ void operator()(const f32x4 (&acc)[2][2][4][2], const pg8::Unit& u, int wr, int wc, int fr, int fq) const {
        const int rowb = u.pm * 256 + wr * 64 + fr, col0 = u.pn * 256 + wc * 32 + 8 * fq;
        float rs[8];
        if constexpr (MODE == EP_RELU2 || MODE == EP_PLE) {
#pragma unroll
            for (int it = 0; it < 8; ++it) rs[it] = ssq[rowb + (it >> 2) * 128 + (it & 3) * 16];
#pragma unroll
            for (int it = 0; it < 8; ++it) rs[it] = rsqrtf(rs[it] * (1.f / 2048.f) + EPS);
        }
        Pre pre[2];
        preload(pre[0], rowb, col0);
#pragma unroll
        for (int it = 0; it < 8; ++it) {
            const int ai = it >> 2, m = it & 3, row = rowb + ai * 128 + m * 16;
            if (it + 1 < 8) preload(pre[(it + 1) & 1], rowb + ((it + 1) >> 2) * 128 + ((it + 1) & 3) * 16, col0);
            const Pre& pp = pre[it & 1];
            float rsum = 0.f; const float rstd = (MODE == EP_RELU2 || MODE == EP_PLE) ? rs[it] : 1.f;
#pragma unroll
            for (int bj = 0; bj < 2; ++bj) {
                const int col = col0 + bj * 128;
                f32x4 v0 = acc[ai][bj][m][0], v1 = acc[ai][bj][m][1];
                if constexpr (MODE == EP_BF16) { nt_store8bf(ob + (size_t)row * ldc + col, v0, v1); }
                else if constexpr (MODE == EP_RELU2) {
#pragma unroll
                    for (int e = 0; e < 4; ++e) { const float a = fmaxf(v0[e] * rstd, 0.f), b = fmaxf(v1[e] * rstd, 0.f); v0[e] = a * a; v1[e] = b * b; }
                    nt_store8bf(ob + (size_t)row * ldc + col, v0, v1); }
                else if constexpr (MODE == EP_KV) {
                    if (bj == 0) store8bf(ob + (size_t)row * 1024 + u.pn * 128 + wc * 32 + 8 * fq, v0, v1);
                    else {
                        const int r0 = u.pm * 256 + ai * 128 + wr * 64 + m * 16 + 4 * fq, b = r0 >> 11, s = r0 & 2047;
                        bf16_t* base = vt + ((size_t)((b * 8 + u.pn) * 128 + wc * 32)) * 2048 + s;
                        u32x2 w0, w1; w0.x = pk2(v0[0], v0[1]); w0.y = pk2(v0[2], v0[3]); w1.x = pk2(v1[0], v1[1]); w1.y = pk2(v1[2], v1[3]);
                        *(u32x2*)(base + (size_t)pg8::perm32(fr) * 2048) = w0; *(u32x2*)(base + (size_t)pg8::perm32(16 + fr) * 2048) = w1; } }
                else if constexpr (MODE == EP_YA) { f32x4 g0, g1; up8(pp.g[bj], g0, g1); nt_store8bf(ob + (size_t)row * DM + col, sig4(g0) * v0, sig4(g1) * v1); }
                else if constexpr (MODE == EP_YB) { f32x4 g0, g1, a0, a1; up8(pp.g[bj], g0, g1); up8(pp.y[bj], a0, a1); nt_store8bf(ob + (size_t)row * DM + col, a0 + sig4(g0) * v0, a1 + sig4(g1) * v1); }
                else if constexpr (MODE == EP_X1 || MODE == EP_ACC) { f32x4 r0, r1;
                    if constexpr (MODE == EP_X1) { r0 = pp.f[bj][0]; r1 = pp.f[bj][1]; } else up8(pp.y[bj], r0, r1);
                    const f32x4 x0 = r0 + v0, x1 = r1 + v1;
                    nt_store8bf(ob + (size_t)row * DM + col, x0, x1);
                    rsum += (x0[0] * x0[0] + x0[1] * x0[1]) + (x0[2] * x0[2] + x0[3] * x0[3]) + (x1[0] * x1[0] + x1[1] * x1[1]) + (x1[2] * x1[2] + x1[3] * x1[3]); }
                else if constexpr (MODE == EP_F32) { float* o = of + (size_t)row * DM + col; *(f32x4*)o = v0; *(f32x4*)(o + 4) = v1; }
                else if constexpr (MODE == EP_PLE) { f32x4 p0, p1, x0, x1; up8(pp.g[bj], p0, p1); up8(pp.y[bj], x0, x1); float* o = of + (size_t)row * DM + col;
                    __builtin_nontemporal_store(x0 + sig4(v0 * rstd) * p0, (f32x4*)o); __builtin_nontemporal_store(x1 + sig4(v1 * rstd) * p1, (f32x4*)(o + 4)); }
            }
            if constexpr (MODE == EP_X1 || MODE == EP_ACC) { rsum += __shfl_xor(rsum, 16); rsum += __shfl_xor(rsum, 32);
                if (fq == 0) __hip_atomic_fetch_add(ssq + row, rsum, __ATOMIC_RELAXED, __HIP_MEMORY_SCOPE_AGENT); }
            asm volatile("" ::: "memory");
        }
    }
};

struct Params { const void* in[24]; float* out; unsigned char* ws; float ropeinv[32]; };

__device__ __forceinline__ int win_map(int n) {
    if (n < 4096) return n;
    if (n < 5632) return 4112 + (n - 4096);
    if (n < 6144) return 5648 + (n - 5632);
    if (n < 8192) return 6224 + (n - 6144);
    if (n < 10240) return 8272 + (n - 8192);
    if (n < 10304) return 6160 + (n - 10240);
    if (n < 10312) return 4096 + (n - 10304);
    if (n < 10320) return 4104 + (n - 10312);
    return -1;
}
struct TrJob { int widx, K, N, nblk, item; };
__device__ __forceinline__ const float* opq(const void* p) { unsigned long long v = (unsigned long long)p; asm volatile("" : "+s"(v)); return (const float*)v; }
__device__ __forceinline__ const float* tr_src(const Params& P, int w) {
    const float* a0 = opq(P.in[4]); const float* a1 = opq(P.in[10]); const float* a2 = opq(P.in[15]); const float* a3 = opq(P.in[16]); const float* a4 = opq(P.in[17]);
    const float* a5 = opq(P.in[19]); const float* a6 = opq(P.in[20]); const float* a7 = opq(P.in[22]); const float* a8 = opq(P.in[23]);
    return w == 0 ? a0 : w == 1 ? a1 : w == 2 ? a2 : w == 3 ? a3 : w == 4 ? a4 : w == 5 ? a5 : w == 6 ? a6 : w == 7 ? a7 : a8; }
__device__ __forceinline__ size_t tr_dst_off(int w) { return w == 0 ? WS_WIN : w == 1 ? WS_WKV : w == 2 ? WS_WA : w == 3 ? WS_WB : w == 4 ? WS_WOUT : w == 5 ? WS_WUP : w == 6 ? WS_WDN : w == 7 ? WS_WPG : WS_WPLE; }
__device__ __forceinline__ void tr_load(const Params& P, const TrJob& J, int lane, f32x4 (&v)[8]) {
    const int kb = J.item / J.nblk, nb = J.item % J.nblk, k0 = 64 * kb, n0 = 32 * nb, q4 = lane & 7, kr = lane >> 3;
    int oc = n0 + 4 * q4; if (J.widx == 0) oc = win_map(oc);
    const float* W = tr_src(P, J.widx);
#pragma unroll
    for (int i = 0; i < 8; ++i) v[i] = (oc >= 0) ? *(const f32x4*)(W + (size_t)(k0 + 8 * i + kr) * J.N + oc) : (f32x4){0.f, 0.f, 0.f, 0.f};
}
__device__ __forceinline__ void tr_finish(const Params& P, const TrJob& J, int lane, const f32x4 (&v)[8], LAS float* scr) {
    const int kb = J.item / J.nblk, nb = J.item % J.nblk, k0 = 64 * kb, n0 = 32 * nb, q4 = lane & 7, kr = lane >> 3;
    const float* kg5 = opq(P.in[18]); const float* kg7 = opq(P.in[21]); const float* kgain = (J.widx == 5) ? kg5 : (J.widx == 7) ? kg7 : nullptr;
    bf16_t* WT = (bf16_t*)(P.ws + tr_dst_off(J.widx));
#pragma unroll
    for (int i = 0; i < 8; ++i) { LAS float* d = scr + (8 * i + kr) * 33 + 4 * q4; const float kg = kgain ? kgain[k0 + 8 * i + kr] : 1.f; d[0] = v[i][0] * kg; d[1] = v[i][1] * kg; d[2] = v[i][2] * kg; d[3] = v[i][3] * kg; }
    LDS_WAIT();
    const int c = lane & 7;
#pragma unroll
    for (int j = 0; j < 4; ++j) { const int n = (lane >> 3) + 8 * j; const LAS float* sp = scr + (8 * c) * 33 + n;
        u32x4 o; o.x = pk2(sp[0 * 33], sp[1 * 33]); o.y = pk2(sp[2 * 33], sp[3 * 33]); o.z = pk2(sp[4 * 33], sp[5 * 33]); o.w = pk2(sp[6 * 33], sp[7 * 33]);
        *(u32x4*)(WT + (size_t)(n0 + n) * J.K + k0 + 8 * c) = o; }
    LDS_WAIT();
}
__device__ __forceinline__ void rmsnorm_row(const float* xrow, const float* gain, bf16_t* orow, int lane) {
    const f32x4* xr = (const f32x4*)xrow + lane; const f32x4* gr = (const f32x4*)gain + lane;
    f32x4 v[8]; float s = 0.f;
#pragma unroll
    for (int j = 0; j < 8; ++j) { v[j] = xr[64 * j]; s += (v[j][0] * v[j][0] + v[j][1] * v[j][1]) + (v[j][2] * v[j][2] + v[j][3] * v[j][3]); }
    const float rstd = rsqrtf(wave_sum(s) * (1.f / 2048.f) + EPS);
    u32x2* o8 = (u32x2*)orow + lane;
#pragma unroll
    for (int j = 0; j < 8; ++j) { const f32x4 g = gr[64 * j]; u32x2 w; w.x = pk2(v[j][0] * rstd * g[0], v[j][1] * rstd * g[1]); w.y = pk2(v[j][2] * rstd * g[2], v[j][3] * rstd * g[3]); o8[64 * j] = w; }
}
__device__ __forceinline__ void rmsnorm_rows_phase(const float* X, const float* gain, bf16_t* O, int gw, int NGW, int lane) {
    for (int m = gw; m < MROWS / 2; m += NGW) {
        const f32x4* x0 = (const f32x4*)(X + (size_t)m * DM) + lane; const f32x4* x1 = (const f32x4*)(X + (size_t)(m + MROWS / 2) * DM) + lane; const f32x4* gr = (const f32x4*)gain + lane;
        f32x4 a[8], b[8]; float sa = 0.f, sb = 0.f;
#pragma unroll
        for (int j = 0; j < 8; ++j) { a[j] = x0[64 * j]; b[j] = x1[64 * j]; }
#pragma unroll
        for (int j = 0; j < 8; ++j) { sa += (a[j][0] * a[j][0] + a[j][1] * a[j][1]) + (a[j][2] * a[j][2] + a[j][3] * a[j][3]); sb += (b[j][0] * b[j][0] + b[j][1] * b[j][1]) + (b[j][2] * b[j][2] + b[j][3] * b[j][3]); }
        const float ra = rsqrtf(wave_sum(sa) * (1.f / 2048.f) + EPS), rb = rsqrtf(wave_sum(sb) * (1.f / 2048.f) + EPS);
        u32x2* oa = (u32x2*)(O + (size_t)m * DM) + lane; u32x2* ob = (u32x2*)(O + (size_t)(m + MROWS / 2) * DM) + lane;
#pragma unroll
        for (int j = 0; j < 8; ++j) { const f32x4 g = gr[64 * j]; u32x2 w; w.x = pk2(a[j][0] * ra * g[0], a[j][1] * ra * g[1]); w.y = pk2(a[j][2] * ra * g[2], a[j][3] * ra * g[3]); oa[64 * j] = w;
            w.x = pk2(b[j][0] * rb * g[0], b[j][1] * rb * g[1]); w.y = pk2(b[j][2] * rb * g[2], b[j][3] * rb * g[3]); ob[64 * j] = w; }
    }
}

__device__ __forceinline__ TrJob tr_job(int it) {
    constexpr int I_IN = 32 * (LDP / 32), I_KV = 8 * 64, I_A = 16 * 64, I_B = 16 * 64, I_OUT = 32 * 64, I_UP = 32 * 256, I_DN = 128 * 64, I_PG = 32 * 64;
    int r = it;
    if (r < I_IN) return TrJob{0, 2048, D_IN, LDP / 32, r}; r -= I_IN;
    if (r < I_KV) return TrJob{1, 512, 2048, 64, r}; r -= I_KV;
    if (r < I_A) return TrJob{2, 1024, 2048, 64, r}; r -= I_A;
    if (r < I_B) return TrJob{3, 1024, 2048, 64, r}; r -= I_B;
    if (r < I_OUT) return TrJob{4, 2048, 2048, 64, r}; r -= I_OUT;
    if (r < I_UP) return TrJob{5, 2048, 8192, 256, r}; r -= I_UP;
    if (r < I_DN) return TrJob{6, 8192, 2048, 64, r}; r -= I_DN;
    if (r < I_PG) return TrJob{7, 2048, 2048, 64, r}; r -= I_PG;
    return TrJob{8, 256, 2048, 64, r};
}
constexpr int TR_IN_ITEMS = 32 * (LDP / 32);
constexpr int TR_ALL_ITEMS = 32 * (LDP / 32) + 8 * 64 + 16 * 64 + 16 * 64 + 32 * 64 + 32 * 256 + 128 * 64 + 32 * 64 + 4 * 64;
__device__ __forceinline__ void transpose_range(const Params& P, LAS float* scr, int lo, int hi, int gw, int NGW, int lane) {
    for (int it = lo + gw; it < hi; it += 2 * NGW) {
        const TrJob J0 = tr_job(it); f32x4 v0[8], v1[8]; tr_load(P, J0, lane, v0);
        const bool two = (it + NGW < hi);
        const TrJob J1 = tr_job(two ? it + NGW : it);
        if (two) tr_load(P, J1, lane, v1);
        tr_finish(P, J0, lane, v0, scr);
        if (two) tr_finish(P, J1, lane, v1, scr);
    }
}
__device__ __forceinline__ void p0_prologue(const Params& P, LAS unsigned char* lds, int gw, int NGW, int wave, int lane) {
    unsigned char* ws = P.ws;
    LAS float* scr = (LAS float*)(lds + wave * 16384);
    transpose_range(P, scr, 0, TR_IN_ITEMS, gw, NGW, lane);
    rmsnorm_rows_phase((const float*)P.in[0], (const float*)P.in[3], (bf16_t*)(ws + WS_ACT), gw, NGW, lane);
    { const f32x4* src = (const f32x4*)P.in[1]; u32x4* dst = (u32x4*)(ws + WS_PBF); const size_t n8 = (size_t)MROWS * PLE / 8;
      for (size_t i = (size_t)gw * 64 + lane; i < n8; i += (size_t)NGW * 64) { const f32x4 a = src[2 * i], b = src[2 * i + 1]; u32x4 w; w.x = pk2(a[0], a[1]); w.y = pk2(a[2], a[3]); w.z = pk2(b[0], b[1]); w.w = pk2(b[2], b[3]); dst[i] = w; } }
}

__device__ __forceinline__ void rope_cs(float pos, float inv, float& c, float& s) {
    const float a = pos * inv;
    double rev = (double)a * 0.15915494309189535; rev -= rint(rev);
    const float r = (float)rev; s = __builtin_amdgcn_sinf(r); c = __builtin_amdgcn_cosf(r);
}
__device__ __forceinline__ void unpack8(const u32x4 w, float (&f)[8]) { f[0] = bflo(w.x); f[1] = bfhi(w.x); f[2] = bflo(w.y); f[3] = bfhi(w.y); f[4] = bflo(w.z); f[5] = bfhi(w.z); f[6] = bflo(w.w); f[7] = bfhi(w.w); }
__device__ __forceinline__ u32x4 pack8(const float (&f)[8]) { u32x4 w; w.x = pk2(f[0], f[1]); w.y = pk2(f[2], f[3]); w.z = pk2(f[4], f[5]); w.w = pk2(f[6], f[7]); return w; }
__device__ __forceinline__ void p2_prep(const Params& P, int gw, int NGW, int lane) {
    unsigned char* ws = P.ws;
    bf16_t* proj = (bf16_t*)(ws + WS_PROJ);
    const int* positions = (const int*)P.in[2];
    const float* ckvn = (const float*)P.in[9]; const float* qng = (const float*)P.in[11]; const float* qrg = (const float*)P.in[12]; const float* kng = (const float*)P.in[13]; const float* krg = (const float*)P.in[14];
    const float* dt_bias = (const float*)P.in[6]; const float* a_log = (const float*)P.in[7];
    float* G = (float*)(ws + WS_G); float* BETA = (float*)(ws + WS_BETA);
    const float QSCALE = 0.07216878364870322f * LOG2E;
    {
        const int h = lane >> 3, seg = lane & 7;
        float gn[16], gr[8], inv8[8], gc8[8];
#pragma unroll
        for (int e = 0; e < 16; ++e) gn[e] = qng[16 * seg + e] * kng[16 * seg + e] * QSCALE;
#pragma unroll
        for (int e = 0; e < 8; ++e) { gr[e] = qrg[8 * seg + e]; inv8[e] = P.ropeinv[8 * (seg & 3) + e]; gc8[e] = ckvn[8 * lane + e]; }
        const float inv1 = P.ropeinv[lane & 31], kr_g = krg[lane];
        for (int m = gw; m < MROWS; m += NGW) {
            bf16_t* row = proj + (size_t)m * LDP;
            bf16_t* np = row + C_MQ + h * 192 + 16 * seg; bf16_t* rp = row + C_MQ + h * 192 + 128 + 8 * seg; bf16_t* cp = row + C_CKV + 8 * lane;
            const u32x4 wn0 = *(const u32x4*)np, wn1 = *(const u32x4*)(np + 8), wr = *(const u32x4*)rp, wc = *(const u32x4*)cp;
            const bf16_t wk = row[C_KR + lane]; const bf16_t wba = (lane < 16) ? row[C_BETA + lane] : (bf16_t)0;
            const float pos = (float)positions[m];
            float a[8], b[8]; unpack8(wn0, a); unpack8(wn1, b);
            float ss = 0.f;
#pragma unroll
            for (int e = 0; e < 8; ++e) ss += a[e] * a[e] + b[e] * b[e];
            ss += __shfl_xor(ss, 1); ss += __shfl_xor(ss, 2); ss += __shfl_xor(ss, 4);
            const float rstd = rsqrtf(ss * (1.f / 128.f) + EPS);
#pragma unroll
            for (int e = 0; e < 8; ++e) { a[e] = a[e] * rstd * gn[e]; b[e] = b[e] * rstd * gn[8 + e]; }
            *(u32x4*)np = pack8(a); *(u32x4*)(np + 8) = pack8(b);
            float x[8]; unpack8(wr, x);
            float s2 = 0.f;
#pragma unroll
            for (int e = 0; e < 8; ++e) s2 += x[e] * x[e];
            s2 += __shfl_xor(s2, 1); s2 += __shfl_xor(s2, 2); s2 += __shfl_xor(s2, 4);
            const float rs2 = rsqrtf(s2 * (1.f / 64.f) + EPS);
#pragma unroll
            for (int e = 0; e < 8; ++e) { const float xn = x[e] * rs2 * gr[e]; const float px = __shfl_xor(xn, 4); float cs, sn; rope_cs(pos, inv8[e], cs, sn);
                x[e] = ((seg < 4) ? (xn * cs - px * sn) : (xn * cs + px * sn)) * QSCALE; }
            *(u32x4*)rp = pack8(x);
            float cv[8]; unpack8(wc, cv);
            float s3 = 0.f;
#pragma unroll
            for (int e = 0; e < 8; ++e) s3 += cv[e] * cv[e];
            const float rs3 = rsqrtf(wave_sum(s3) * (1.f / 512.f) + EPS);
#pragma unroll
            for (int e = 0; e < 8; ++e) cv[e] = cv[e] * rs3 * gc8[e];
            *(u32x4*)cp = pack8(cv);
            { float xk = bf2f(wk); const float rs4 = rsqrtf(wave_sum(xk * xk) * (1.f / 64.f) + EPS); xk = xk * rs4 * kr_g;
              float cs, sn; rope_cs(pos, inv1, cs, sn);
              const float px = __shfl_xor(xk, 32); row[C_KR + lane] = f2bf((lane < 32) ? (xk * cs - px * sn) : (xk * cs + px * sn)); }
            if (lane < 8) BETA[(size_t)m * 8 + lane] = 1.f / (1.f + expf(-bf2f(wba)));
            else if (lane < 16) { const int hh = lane - 8; const float z = bf2f(wba) + dt_bias[hh]; const float sp = (z > 20.f) ? z : log1pf(expf(z)); G[(size_t)m * 8 + hh] = -expf(a_log[hh]) * sp; }
        }
    }
    const float* convw = (const float*)P.in[5];
    bf16_t* QA = (bf16_t*)P.out;
    for (int it = gw; it < (MROWS / 16) * 6; it += NGW) {
        const int run = it / 6, gg = it % 6, m0 = run * 16, s0 = m0 & 2047, c = gg * 512 + 8 * lane;
        float w0[8], w1[8], w2[8], w3[8];
#pragma unroll
        for (int e = 0; e < 8; e += 4) { *(f32x4*)(w0 + e) = *(const f32x4*)(convw + 0 * 3072 + c + e); *(f32x4*)(w1 + e) = *(const f32x4*)(convw + 1 * 3072 + c + e);
                                         *(f32x4*)(w2 + e) = *(const f32x4*)(convw + 2 * 3072 + c + e); *(f32x4*)(w3 + e) = *(const f32x4*)(convw + 3 * 3072 + c + e); }
        const bf16_t* src = proj + (size_t)m0 * LDP + c;
        float h1[8], h2[8], h3[8];
        if (s0 != 0) { unpack8(*(const u32x4*)(src - (size_t)1 * LDP), h1); unpack8(*(const u32x4*)(src - (size_t)2 * LDP), h2); unpack8(*(const u32x4*)(src - (size_t)3 * LDP), h3); }
        else {
#pragma unroll
            for (int e = 0; e < 8; ++e) { h1[e] = 0.f; h2[e] = 0.f; h3[e] = 0.f; } }
        bf16_t* dst = QA + (size_t)(gg >> 1) * ((size_t)MROWS * 1024) + (size_t)m0 * 1024 + (gg & 1) * 512 + 8 * lane;
        const float post = (gg < 2) ? 0.08838834764831845f : 1.f;
#pragma unroll
        for (int tb = 0; tb < 2; ++tb) {
            u32x4 raw[8];
#pragma unroll
            for (int q = 0; q < 8; ++q) raw[q] = *(const u32x4*)(src + (size_t)(8 * tb + q) * LDP);
#pragma unroll
            for (int q = 0; q < 8; ++q) {
                float cur[8], y[8]; unpack8(raw[q], cur);
                float ss = 0.f;
#pragma unroll
                for (int e = 0; e < 8; ++e) { y[e] = silu_f(w3[e] * cur[e] + w2[e] * h1[e] + w1[e] * h2[e] + w0[e] * h3[e]); ss += y[e] * y[e]; }
                if (gg < 4) { ss += __shfl_xor(ss, 1); ss += __shfl_xor(ss, 2); ss += __shfl_xor(ss, 4); ss += __shfl_xor(ss, 8); const float sc = rsqrtf(ss + EPS) * post;
#pragma unroll
                    for (int e = 0; e < 8; ++e) y[e] *= sc; }
                *(u32x4*)(dst + (size_t)(8 * tb + q) * 1024) = pack8(y);
#pragma unroll
                for (int e = 0; e < 8; ++e) { h3[e] = h2[e]; h2[e] = h1[e]; h1[e] = cur[e]; }
            }
        }
    }
}

constexpr int SOLVE_NOPS = 528, SOLVE_R = 8, SOLVE_D = 6;
struct SolveOps { unsigned char j[SOLVE_NOPS + SOLVE_R], q[SOLVE_NOPS + SOLVE_R]; };
constexpr SolveOps make_solve_ops() { SolveOps o{}; int t = 0; for (int j = 0; j < 63; ++j) for (int q = (j + 1) >> 2; q < 16; ++q) { o.j[t] = (unsigned char)j; o.q[t] = (unsigned char)q; ++t; } return o; }
constexpr SolveOps SOPS = make_solve_ops();
template <int T, int END> struct SolveStep {
    static __device__ __forceinline__ void run(f32x2 (&r)[32], f32x4 (&buf)[SOLVE_R], const LAS f32x4* Atv) {
        constexpr int TL = T + SOLVE_D;
        if constexpr (TL < END) buf[TL % SOLVE_R] = Atv[SOPS.j[TL] * 16 + SOPS.q[TL]];
        __builtin_amdgcn_sched_barrier(0);
        constexpr int j = SOPS.j[T], q = SOPS.q[T];
        const float xj = r[j >> 1][j & 1]; const f32x2 x2 = {xj, xj}; const f32x4 a = buf[T % SOLVE_R];
        r[2 * q] = r[2 * q] - (f32x2){a[0], a[1]} * x2; r[2 * q + 1] = r[2 * q + 1] - (f32x2){a[2], a[3]} * x2;
        __builtin_amdgcn_sched_barrier(0);
        SolveStep<T + 1, END>::run(r, buf, Atv);
    }
};
template <int END> struct SolveStep<END, END> { static __device__ __forceinline__ void run(f32x2 (&)[32], f32x4 (&)[SOLVE_R], const LAS f32x4*) {} };

__device__ __forceinline__ void delta_prep(const Params& P, LAS unsigned char* lds) {
    unsigned char* ws = P.ws;
    int tid = threadIdx.x; asm volatile("" : "+v"(tid));
    const int wave = __builtin_amdgcn_readfirstlane(tid >> 6), lane = tid & 63, sub = wave >> 2, tid_s = tid & 255, wv = wave & 3, fr = lane & 15, fq = lane >> 4;
    bf16_t* QA = (bf16_t*)P.out; bf16_t* KA = QA + (size_t)MROWS * 1024; bf16_t* VA = KA + (size_t)MROWS * 1024; bf16_t* WB = VA + (size_t)MROWS * 1024;
    const float* G = (const float*)(ws + WS_G); const float* BETA = (const float*)(ws + WS_BETA); bf16_t* QKM = (bf16_t*)(ws + WS_QKM); float* GL = (float*)(ws + WS_GL);
    LAS unsigned char* base = lds + sub * 61440;
    LAS bf16_t* Ks = (LAS bf16_t*)base; LAS bf16_t* Qs = (LAS bf16_t*)(base + 17408); LAS float* At = (LAS float*)(base + 34816);
    LAS float* gcs = (LAS float*)(base + 51200); LAS float* betas = (LAS float*)(base + 51456); LAS float* bes = (LAS float*)(base + 51712);
    LAS bf16_t* QKs = (LAS bf16_t*)(base + 51968);
    for (int unit = blockIdx.x; unit < 2048; unit += gridDim.x) {
        const int ch = unit * 2 + sub, n = ch & 31, bh = ch >> 5, h = bh & 7, b = bh >> 3, m0 = b * 2048 + n * 64;
#pragma unroll
        for (int i = 0; i < 4; ++i) { const int p = tid_s + 256 * i, row = p >> 4, c = p & 15; const size_t go = (size_t)(m0 + row) * 1024 + h * 128 + c * 8;
            *(LAS u32x4*)(Ks + row * 136 + c * 8) = *(const u32x4*)(KA + go); *(LAS u32x4*)(Qs + row * 136 + c * 8) = *(const u32x4*)(QA + go); }
        if (wv == 0) { float g = G[(size_t)(m0 + lane) * 8 + h] * LOG2E;
#pragma unroll
            for (int o = 1; o < 64; o <<= 1) { const float t = __shfl_up(g, o); if (lane >= o) g += t; }
            const float be = BETA[(size_t)(m0 + lane) * 8 + h];
            gcs[lane] = g; betas[lane] = be; bes[lane] = be * __builtin_amdgcn_exp2f(g); if (lane == 63) GL[ch] = __builtin_amdgcn_exp2f(g); }
        __syncthreads();
        { const int ti = wv; bf16x8 ak[4], aq[4];
#pragma unroll
          for (int ks = 0; ks < 4; ++ks) { ak[ks] = *(const LAS bf16x8*)(Ks + (16 * ti + fr) * 136 + 32 * ks + fq * 8); aq[ks] = *(const LAS bf16x8*)(Qs + (16 * ti + fr) * 136 + 32 * ks + fq * 8); }
          f32x4 gi, bi;
#pragma unroll
          for (int j = 0; j < 4; ++j) { gi[j] = gcs[16 * ti + fq * 4 + j]; bi[j] = betas[16 * ti + fq * 4 + j]; }
#pragma unroll
          for (int tj = 0; tj < 4; ++tj) {
              f32x4 ck = {0.f, 0.f, 0.f, 0.f}, cq = {0.f, 0.f, 0.f, 0.f};
              if (tj <= ti) {
#pragma unroll
                  for (int ks = 0; ks < 4; ++ks) { const bf16x8 bk = *(const LAS bf16x8*)(Ks + (16 * tj + fr) * 136 + 32 * ks + fq * 8);
                      ck = __builtin_amdgcn_mfma_f32_16x16x32_bf16(ak[ks], bk, ck, 0, 0, 0); cq = __builtin_amdgcn_mfma_f32_16x16x32_bf16(aq[ks], bk, cq, 0, 0, 0); } }
              const int jj = 16 * tj + fr; const float gj = gcs[jj]; f32x4 av; float qv[4];
#pragma unroll
              for (int j = 0; j < 4; ++j) { const int i = 16 * ti + fq * 4 + j; const float dec = (i >= jj) ? __builtin_amdgcn_exp2f(gi[j] - gj) : 0.f;
                  av[j] = (i > jj) ? bi[j] * ck[j] * dec : 0.f; qv[j] = cq[j] * dec; }
              *(LAS f32x4*)(At + jj * 64 + 16 * ti + fq * 4) = av;
#pragma unroll
              for (int j = 0; j < 4; ++j) QKs[(16 * ti + fq * 4 + j) * 72 + jj] = f2bf(qv[j]);
          } }
        u32x4 vreg[4];
        const float gl = gcs[63];
#pragma unroll
        for (int i = 0; i < 4; ++i) { const int p = tid_s + 256 * i, row = p >> 4, c = p & 15; const size_t go = (size_t)(m0 + row) * 1024 + h * 128 + c * 8;
            vreg[i] = *(const u32x4*)(VA + go);
            const u32x4 q = *(const LAS u32x4*)(Qs + row * 136 + c * 8); const float e = __builtin_amdgcn_exp2f(gcs[row]); u32x4 o;
            o.x = pk2(bflo(q.x) * e, bfhi(q.x) * e); o.y = pk2(bflo(q.y) * e, bfhi(q.y) * e); o.z = pk2(bflo(q.z) * e, bfhi(q.z) * e); o.w = pk2(bflo(q.w) * e, bfhi(q.w) * e);
            *(u32x4*)(QA + go) = o; }
#pragma unroll
        for (int i = 0; i < 4; ++i) { const int p = tid_s + 256 * i, dk = p & 127, j0 = (p >> 7) * 8; float v[8];
#pragma unroll
            for (int e = 0; e < 8; ++e) v[e] = bf2f(Ks[(j0 + e) * 136 + dk]) * __builtin_amdgcn_exp2f(gl - gcs[j0 + e]);
            u32x4 o; o.x = pk2(v[0], v[1]); o.y = pk2(v[2], v[3]); o.z = pk2(v[4], v[5]); o.w = pk2(v[6], v[7]);
            *(u32x4*)(KA + (size_t)(m0 + (dk >> 1)) * 1024 + h * 128 + (dk & 1) * 64 + j0) = o; }
        __syncthreads();
#pragma unroll
        for (int i = 0; i < 4; ++i) { const int p = tid_s + 256 * i, row = p >> 4, c = p & 15; *(LAS u32x4*)(Qs + row * 136 + c * 8) = vreg[i]; }
#pragma unroll
        for (int i = 0; i < 2; ++i) { const int p = tid_s + 256 * i, row = p >> 3, c8 = p & 7; *(u32x4*)(QKM + (size_t)ch * 4096 + row * 64 + c8 * 8) = *(const LAS u32x4*)(QKs + row * 72 + c8 * 8); }
        __syncthreads();
        { const int c = tid_s; LAS bf16_t* rp = Ks + (c >> 7) * 8704 + (c & 127); const LAS float* sp = (c >= 128) ? betas : bes;
          int zv = 0; asm volatile("" : "+v"(zv)); const LAS f32x4* Atv = (const LAS f32x4*)At + zv;
          f32x2 r[32];
#pragma unroll
          for (int i = 0; i < 64; ++i) r[i >> 1][i & 1] = bf2f(rp[i * 136]) * sp[i];
          f32x4 buf[SOLVE_R];
#pragma unroll
          for (int t = 0; t < SOLVE_D; ++t) buf[t] = Atv[SOPS.j[t] * 16 + SOPS.q[t]];
          SolveStep<0, SOLVE_NOPS>::run(r, buf, Atv);
#pragma unroll
          for (int i = 0; i < 64; ++i) rp[i * 136] = f2bf(r[i >> 1][i & 1]); }
        __syncthreads();
#pragma unroll
        for (int i = 0; i < 4; ++i) { const int p = tid_s + 256 * i, row = p >> 4, c = p & 15; const size_t go = (size_t)(m0 + row) * 1024 + h * 128 + c * 8;
            *(u32x4*)(WB + go) = *(const LAS u32x4*)(Ks + row * 136 + c * 8); *(u32x4*)(VA + go) = *(const LAS u32x4*)(Qs + row * 136 + c * 8); }
        __syncthreads();
    }
}

__device__ __forceinline__ void delta_scan(const Params& P, LAS unsigned char* lds) {
    unsigned char* ws = P.ws;
    int tid = threadIdx.x; asm volatile("" : "+v"(tid));
    const int wave = __builtin_amdgcn_readfirstlane(tid >> 6), lane = tid & 63, fr = lane & 15, fq = lane >> 4;
    const bf16_t* QA = (const bf16_t*)P.out; const bf16_t* KA = QA + (size_t)MROWS * 1024; const bf16_t* UA = KA + (size_t)MROWS * 1024; const bf16_t* WB = UA + (size_t)MROWS * 1024;
    const bf16_t* QKM = (const bf16_t*)(ws + WS_QKM); const float* GL = (const float*)(ws + WS_GL); bf16_t* proj = (bf16_t*)(ws + WS_PROJ);
    const float* ogain = (const float*)P.in[8];
    LAS bf16_t* Ws = (LAS bf16_t*)lds; LAS bf16_t* Qs = (LAS bf16_t*)(lds + 17408); LAS bf16_t* Kt = (LAS bf16_t*)(lds + 34816); LAS bf16_t* QKs = (LAS bf16_t*)(lds + 53248);
    LAS bf16_t* Us = (LAS bf16_t*)(lds + 62464); LAS bf16_t* St = (LAS bf16_t*)(lds + 79872); LAS bf16_t* VNt = (LAS bf16_t*)(lds + 114688); LAS float* SSQ = (LAS float*)(lds + 133120);
    const int it = wave >> 1, dvq = wave & 1;
    for (int unit = blockIdx.x; unit < 128; unit += gridDim.x) {
        const int bh = unit, h = bh & 7, b = bh >> 3;
        f32x4 sacc[8];
#pragma unroll
        for (int d = 0; d < 8; ++d) sacc[d] = (f32x4){0.f, 0.f, 0.f, 0.f};
        float og[4];
#pragma unroll
        for (int d = 0; d < 4; ++d) og[d] = ogain[16 * (4 * dvq + d) + fr];
        u32x4 rw[2], rq[2], rk[2], ru[2], rqk;
#define SCAN_LOAD(nn) do { const int m0_ = b * 2048 + (nn) * 64; const size_t ch_ = (size_t)bh * 32 + (nn); \
            _Pragma("unroll") for (int i = 0; i < 2; ++i) { const int p = tid + 512 * i, row = p >> 4, c = p & 15; const size_t go = (size_t)(m0_ + row) * 1024 + h * 128 + c * 8; rw[i] = *(const u32x4*)(WB + go); rq[i] = *(const u32x4*)(QA + go); ru[i] = *(const u32x4*)(UA + go); \
                const int dk = p >> 3, c8 = p & 7; rk[i] = *(const u32x4*)(KA + (size_t)(m0_ + (dk >> 1)) * 1024 + h * 128 + (dk & 1) * 64 + c8 * 8); } \
            { const int row = tid >> 3, c8 = tid & 7; rqk = *(const u32x4*)(QKM + ch_ * 4096 + row * 64 + c8 * 8); } } while (0)
#define SCAN_STORE() do { \
            _Pragma("unroll") for (int i = 0; i < 2; ++i) { const int p = tid + 512 * i, row = p >> 4, c = p & 15; *(LAS u32x4*)(Ws + row * 136 + c * 8) = rw[i]; *(LAS u32x4*)(Qs + row * 136 + c * 8) = rq[i]; *(LAS u32x4*)(Us + row * 136 + c * 8) = ru[i]; \
                const int dk = p >> 3, c8 = p & 7; *(LAS u32x4*)(Kt + dk * 72 + c8 * 8) = rk[i]; } \
            { const int row = tid >> 3, c8 = tid & 7; *(LAS u32x4*)(QKs + row * 72 + c8 * 8) = rqk; } } while (0)
        SCAN_LOAD(0);
        for (int n = 0; n < 32; ++n) {
            const int m0 = b * 2048 + n * 64;
            SCAN_STORE();
#pragma unroll
            for (int d = 0; d < 8; ++d) { u32x2 w; w.x = pk2(sacc[d][0], sacc[d][1]); w.y = pk2(sacc[d][2], sacc[d][3]); *(LAS u32x2*)(St + (16 * d + fr) * 136 + 16 * wave + fq * 4) = w; }
            const float gl = GL[bh * 32 + n];
            __syncthreads();
            if (n + 1 < 32) SCAN_LOAD(n + 1);
            bf16_t zr[4][4];
#pragma unroll
            for (int d = 0; d < 4; ++d)
#pragma unroll
                for (int j = 0; j < 4; ++j) zr[d][j] = proj[(size_t)(m0 + 16 * it + fq * 4 + j) * LDP + C_Z + h * 128 + 16 * (4 * dvq + d) + fr];
            f32x4 a1[4], a2[4];
#pragma unroll
            for (int d = 0; d < 4; ++d) { a1[d] = (f32x4){0.f, 0.f, 0.f, 0.f}; a2[d] = (f32x4){0.f, 0.f, 0.f, 0.f}; }
#pragma unroll
            for (int ks = 0; ks < 4; ++ks) { const bf16x8 wf = *(const LAS bf16x8*)(Ws + (16 * it + fr) * 136 + 32 * ks + fq * 8), qf = *(const LAS bf16x8*)(Qs + (16 * it + fr) * 136 + 32 * ks + fq * 8);
#pragma unroll
                for (int d = 0; d < 4; ++d) { const bf16x8 sf = *(const LAS bf16x8*)(St + (16 * (4 * dvq + d) + fr) * 136 + 32 * ks + fq * 8);
                    a1[d] = __builtin_amdgcn_mfma_f32_16x16x32_bf16(wf, sf, a1[d], 0, 0, 0); a2[d] = __builtin_amdgcn_mfma_f32_16x16x32_bf16(qf, sf, a2[d], 0, 0, 0); } }
#pragma unroll
            for (int d = 0; d < 4; ++d) { const int dv = 16 * (4 * dvq + d) + fr; float vn[4];
#pragma unroll
                for (int j = 0; j < 4; ++j) vn[j] = bf2f(Us[(16 * it + fq * 4 + j) * 136 + dv]) - a1[d][j];
                u32x2 w; w.x = pk2(vn[0], vn[1]); w.y = pk2(vn[2], vn[3]); *(LAS u32x2*)(VNt + dv * 72 + 16 * it + fq * 4) = w; }
            __syncthreads();
#pragma unroll
            for (int d = 0; d < 8; ++d) sacc[d] = sacc[d] * gl;
#pragma unroll
            for (int k2 = 0; k2 < 2; ++k2) { const bf16x8 qkf = *(const LAS bf16x8*)(QKs + (16 * it + fr) * 72 + 32 * k2 + fq * 8), kf = *(const LAS bf16x8*)(Kt + (16 * wave + fr) * 72 + 32 * k2 + fq * 8);
#pragma unroll
                for (int d = 0; d < 8; ++d) { const bf16x8 vf = *(const LAS bf16x8*)(VNt + (16 * d + fr) * 72 + 32 * k2 + fq * 8);
                    sacc[d] = __builtin_amdgcn_mfma_f32_16x16x32_bf16(kf, vf, sacc[d], 0, 0, 0);
                    if ((d >> 2) == dvq) a2[d & 3] = __builtin_amdgcn_mfma_f32_16x16x32_bf16(qkf, vf, a2[d & 3], 0, 0, 0); } }
            float ssq[4];
#pragma unroll
            for (int j = 0; j < 4; ++j) { float t = 0.f;
#pragma unroll
                for (int d = 0; d < 4; ++d) t += a2[d][j] * a2[d][j];
                t += __shfl_xor(t, 1); t += __shfl_xor(t, 2); t += __shfl_xor(t, 4); t += __shfl_xor(t, 8); ssq[j] = t; }
            if (fr == 0) {
#pragma unroll
                for (int j = 0; j < 4; ++j) SSQ[(16 * it + fq * 4 + j) * 2 + dvq] = ssq[j]; }
            __syncthreads();
#pragma unroll
            for (int j = 0; j < 4; ++j) { const int row = 16 * it + fq * 4 + j; const float rstd = rsqrtf((SSQ[row * 2] + SSQ[row * 2 + 1]) * (1.f / 128.f) + EPS);
#pragma unroll
                for (int d = 0; d < 4; ++d) proj[(size_t)(m0 + row) * LDP + C_Q + h * 128 + 16 * (4 * dvq + d) + fr] = f2bf(a2[d][j] * rstd * og[d] * silu_f(bf2f(zr[d][j]))); }
        }
        __syncthreads();
#undef SCAN_LOAD
#undef SCAN_STORE
    }
}

__device__ __forceinline__ void mla_attention(const Params& P, LAS unsigned char* lds) {
    unsigned char* ws = P.ws;
    int tid = threadIdx.x; asm volatile("" : "+v"(tid));
    const int wave = __builtin_amdgcn_readfirstlane(tid >> 6), lane = tid & 63, fr = lane & 15, fq = lane >> 4;
    bf16_t* proj = (bf16_t*)(ws + WS_PROJ); const bf16_t* KN = (const bf16_t*)(ws + WS_ACT); const bf16_t* VT = KN + (size_t)MROWS * 1024;
    const int kkey = tid >> 3, kseg = tid & 7, vdv = tid >> 2, vseg = tid & 3;
    unsigned* qctr = (unsigned*)(ws + WS_CTL + 128 * 1024);
    volatile LAS unsigned* qslot = (volatile LAS unsigned*)(lds + 139264);
    const bool stat = (gridDim.x == 256);
    for (int iter = 0;; ++iter) {
        int qi, bh;
        if (stat) { const bool sc = (int)blockIdx.x < 128; if (iter >= (sc ? 2 : 6)) break; bh = (int)blockIdx.x & 127;
            qi = sc ? (iter == 0 ? 7 : 4) : (iter == 0 ? 6 : iter == 1 ? 5 : iter == 2 ? 3 : iter == 3 ? 2 : iter == 4 ? 1 : 0); }
        else {
            if (tid == 0) qslot[0] = __hip_atomic_fetch_add(qctr, 1u, __ATOMIC_RELAXED, __HIP_MEMORY_SCOPE_AGENT);
            __syncthreads();
            const int L = (int)qslot[0];
            if (L >= 1024) break;
            qi = 7 - (L >> 7); bh = L & 127; }
        const int h = bh & 7, b = bh >> 3;
        const int q0 = qi * 256, ntiles = 4 * (qi + 1);
        bf16x8 qf[2][6];
#pragma unroll
        for (int m = 0; m < 2; ++m)
#pragma unroll
            for (int ks = 0; ks < 6; ++ks) qf[m][ks] = *(const bf16x8*)(proj + (size_t)(b * 2048 + q0 + 32 * wave + 16 * m + fr) * LDP + C_MQ + h * 192 + 32 * ks + fq * 8);
        f32x4 accO[2][8];
#pragma unroll
        for (int m = 0; m < 2; ++m)
#pragma unroll
            for (int d = 0; d < 8; ++d) accO[m][d] = (f32x4){0.f, 0.f, 0.f, 0.f};
        float mrow[2] = {-INFINITY, -INFINITY}, lsum[2] = {0.f, 0.f};
        u32x4 rk0, rk1, rkr, rv0, rv1;
#define ATT_LOAD(kt) do { const size_t krow = (size_t)(b * 2048 + (kt) * 64 + kkey); const bf16_t* kp = KN + krow * 1024 + h * 128 + 16 * kseg; rk0 = *(const u32x4*)kp; rk1 = *(const u32x4*)(kp + 8); \
            rkr = *(const u32x4*)(proj + krow * LDP + C_KR + 8 * kseg); const bf16_t* vp = VT + ((size_t)bh * 128 + vdv) * 2048 + (kt) * 64 + 16 * vseg; rv0 = *(const u32x4*)vp; rv1 = *(const u32x4*)(vp + 8); } while (0)
#define ATT_STORE(buf) do { LAS bf16_t* Kb = (LAS bf16_t*)(lds + (buf) * 25600); LAS bf16_t* Vb = (LAS bf16_t*)(lds + 51200 + (buf) * 18432); \
            float f[16]; f[0] = bflo(rk0.x); f[1] = bfhi(rk0.x); f[2] = bflo(rk0.y); f[3] = bfhi(rk0.y); f[4] = bflo(rk0.z); f[5] = bfhi(rk0.z); f[6] = bflo(rk0.w); f[7] = bfhi(rk0.w); \
            f[8] = bflo(rk1.x); f[9] = bfhi(rk1.x); f[10] = bflo(rk1.y); f[11] = bfhi(rk1.y); f[12] = bflo(rk1.z); f[13] = bfhi(rk1.z); f[14] = bflo(rk1.w); f[15] = bfhi(rk1.w); \
            float ss = 0.f; _Pragma("unroll") for (int e = 0; e < 16; ++e) ss += f[e] * f[e]; \
            ss += __shfl_xor(ss, 1); ss += __shfl_xor(ss, 2); ss += __shfl_xor(ss, 4); const float rs = rsqrtf(ss * (1.f / 128.f) + EPS); \
            u32x4 o0, o1; o0.x = pk2(f[0] * rs, f[1] * rs); o0.y = pk2(f[2] * rs, f[3] * rs); o0.z = pk2(f[4] * rs, f[5] * rs); o0.w = pk2(f[6] * rs, f[7] * rs); \
            o1.x = pk2(f[8] * rs, f[9] * rs); o1.y = pk2(f[10] * rs, f[11] * rs); o1.z = pk2(f[12] * rs, f[13] * rs); o1.w = pk2(f[14] * rs, f[15] * rs); \
            *(LAS u32x4*)(Kb + kkey * 200 + 16 * kseg) = o0; *(LAS u32x4*)(Kb + kkey * 200 + 16 * kseg + 8) = o1; *(LAS u32x4*)(Kb + kkey * 200 + 128 + 8 * kseg) = rkr; \
            *(LAS u32x4*)(Vb + vdv * 72 + 16 * vseg) = rv0; *(LAS u32x4*)(Vb + vdv * 72 + 16 * vseg + 8) = rv1; } while (0)
        ATT_LOAD(0); ATT_STORE(0);
        __syncthreads();
        for (int kt = 0; kt < ntiles; ++kt) {
            const bool more = (kt + 1 < ntiles);
            if (more) ATT_LOAD(kt + 1);
            const bool active = (kt < 4 * qi) || ((kt - 4 * qi) <= (wave >> 1));
            if (active) {
                const LAS bf16_t* Kb = (const LAS bf16_t*)(lds + (kt & 1) * 25600); const LAS bf16_t* Vb = (const LAS bf16_t*)(lds + 51200 + (kt & 1) * 18432);
                f32x4 accS[2][4];
#pragma unroll
                for (int m = 0; m < 2; ++m)
#pragma unroll
                    for (int n = 0; n < 4; ++n) accS[m][n] = (f32x4){0.f, 0.f, 0.f, 0.f};
#pragma unroll
                for (int ks = 0; ks < 6; ++ks)
#pragma unroll
                    for (int n = 0; n < 4; ++n) { const bf16x8 kf = *(const LAS bf16x8*)(Kb + (16 * n + fr) * 200 + 32 * ks + fq * 8);
                        accS[0][n] = __builtin_amdgcn_mfma_f32_16x16x32_bf16(kf, qf[0][ks], accS[0][n], 0, 0, 0); accS[1][n] = __builtin_amdgcn_mfma_f32_16x16x32_bf16(kf, qf[1][ks], accS[1][n], 0, 0, 0); }
                bf16x8 pf[2][2];
#pragma unroll
                for (int m = 0; m < 2; ++m) {
                    float mx = accS[m][0][0];
#pragma unroll
                    for (int n = 0; n < 4; ++n)
#pragma unroll
                        for (int j = 0; j < 4; ++j) mx = fmaxf(mx, accS[m][n][j]);
                    mx = fmaxf(mx, __shfl_xor(mx, 16)); mx = fmaxf(mx, __shfl_xor(mx, 32));
                    const float mnew = fmaxf(mrow[m], mx), alpha = __builtin_amdgcn_exp2f(mrow[m] - mnew); mrow[m] = mnew;
                    float ps = 0.f; float p[4][4];
#pragma unroll
                    for (int n = 0; n < 4; ++n)
#pragma unroll
                        for (int j = 0; j < 4; ++j) { p[n][j] = __builtin_amdgcn_exp2f(accS[m][n][j] - mnew); ps += p[n][j]; }
                    lsum[m] = lsum[m] * alpha + ps;
                    if (__any(alpha != 1.f)) {
#pragma unroll
                        for (int d = 0; d < 8; ++d) accO[m][d] = accO[m][d] * alpha; }
#pragma unroll
                    for (int t = 0; t < 2; ++t) { u32x4 w; w.x = pk2(p[2 * t][0], p[2 * t][1]); w.y = pk2(p[2 * t][2], p[2 * t][3]); w.z = pk2(p[2 * t + 1][0], p[2 * t + 1][1]); w.w = pk2(p[2 * t + 1][2], p[2 * t + 1][3]);
                        pf[m][t] = __builtin_bit_cast(bf16x8, w); }
                }
#pragma unroll
                for (int d = 0; d < 8; ++d)
#pragma unroll
                    for (int t = 0; t < 2; ++t) { const LAS bf16_t* vp = Vb + (16 * d + fr) * 72 + 32 * t + fq * 4; u32x4 w; const u32x2 lo = *(const LAS u32x2*)vp, hi = *(const LAS u32x2*)(vp + 16);
                        w.x = lo.x; w.y = lo.y; w.z = hi.x; w.w = hi.y; const bf16x8 vf = __builtin_bit_cast(bf16x8, w);
                        accO[0][d] = __builtin_amdgcn_mfma_f32_16x16x32_bf16(vf, pf[0][t], accO[0][d], 0, 0, 0); accO[1][d] = __builtin_amdgcn_mfma_f32_16x16x32_bf16(vf, pf[1][t], accO[1][d], 0, 0, 0); }
            }
            if (more) ATT_STORE((kt + 1) & 1);
            __syncthreads();
        }
#undef ATT_LOAD
#undef ATT_STORE
#pragma unroll
        for (int m = 0; m < 2; ++m) { float l = lsum[m]; l += __shfl_xor(l, 16); l += __shfl_xor(l, 32); const float il = 1.f / l;
            bf16_t* op = proj + (size_t)(b * 2048 + q0 + 32 * wave + 16 * m + fr) * LDP + C_K + h * 128 + fq * 4;
#pragma unroll
            for (int d = 0; d < 8; ++d) { u32x2 w; w.x = pk2(accO[m][d][0] * il, accO[m][d][1] * il); w.y = pk2(accO[m][d][2] * il, accO[m][d][3] * il); *(u32x2*)(op + 16 * d) = w; } }
    }
}

__device__ __forceinline__ void oa_finalize(const Params& P, int gw, int NGW, int lane) {
    bf16_t* proj = (bf16_t*)(P.ws + WS_PROJ); const float* gain = (const float*)P.in[8];
    const int h = lane >> 3, seg = lane & 7;
    float g[16];
#pragma unroll
    for (int e = 0; e < 16; ++e) g[e] = gain[16 * seg + e];
    for (int m = gw; m < MROWS; m += NGW) { bf16_t* op = proj + (size_t)m * LDP + C_Q + h * 128 + 16 * seg; const bf16_t* zp = proj + (size_t)m * LDP + C_Z + h * 128 + 16 * seg;
        const u32x4 o0 = *(const u32x4*)op, o1 = *(const u32x4*)(op + 8), z0 = *(const u32x4*)zp, z1 = *(const u32x4*)(zp + 8);
        float a[8], b[8], za[8], zb[8]; unpack8(o0, a); unpack8(o1, b); unpack8(z0, za); unpack8(z1, zb);
        float ss = 0.f;
#pragma unroll
        for (int e = 0; e < 8; ++e) ss += a[e] * a[e] + b[e] * b[e];
        ss += __shfl_xor(ss, 1); ss += __shfl_xor(ss, 2); ss += __shfl_xor(ss, 4);
        const float rstd = rsqrtf(ss * (1.f / 128.f) + EPS);
#pragma unroll
        for (int e = 0; e < 8; ++e) { a[e] = a[e] * rstd * g[e] * silu_f(za[e]); b[e] = b[e] * rstd * g[8 + e] * silu_f(zb[e]); }
        *(u32x4*)op = pack8(a); *(u32x4*)(op + 8) = pack8(b); }
}


#define XB_TMO      128
#define XB_XCNT(j)  (256  + 64 * (j))
#define XB_XSUB(j)  (1280 + 64 * (j))
#define XB_XGEN(j)  (2304 + 64 * (j))
#define XB_TOP      3328
#define XB_TOPGEN   3392
#define XCD_BAR_WORDS 3456
#define XB_SPIN_CAP (1u << 18)
__device__ __forceinline__ unsigned xb_ld(unsigned* p)              { return __hip_atomic_load(p, __ATOMIC_RELAXED, __HIP_MEMORY_SCOPE_AGENT); }
__device__ __forceinline__ unsigned xb_add(unsigned* p, unsigned v) { return __hip_atomic_fetch_add(p, v, __ATOMIC_RELAXED, __HIP_MEMORY_SCOPE_AGENT); }
__device__ __forceinline__ unsigned xb_xcc_id() { return (unsigned)__builtin_amdgcn_s_getreg((3 << 11) | 20) & 0xFu; }
#define XB_SPIN(cond, bar) do { unsigned _sp = 0; while (cond) { __builtin_amdgcn_s_sleep(1); \
    if ((++_sp & 255u) == 0u) { if (xb_ld(&(bar)[XB_TMO])) break; if (_sp > XB_SPIN_CAP) { atomicAdd(&(bar)[XB_TMO], 1u); break; } } } } while (0)
struct XcdBarrier { unsigned* bar; unsigned x; volatile LAS unsigned* st; };
__device__ __forceinline__ XcdBarrier xcd_barrier_post(unsigned* bar, volatile LAS unsigned* st) {
    XcdBarrier b; b.bar = bar; b.x = xb_xcc_id(); b.st = st;
    if (threadIdx.x == 0) (void)xb_add(&bar[XB_XCNT(b.x)], 1u);
    return b;
}
__device__ __forceinline__ void xcd_barrier_complete(unsigned* bar, unsigned x, unsigned& nloc, unsigned& nx) {
    const unsigned G = gridDim.x * gridDim.y * gridDim.z;
    unsigned sum, cnt, mine, sp = 0u;
    for (;;) {
        sum = 0u; cnt = 0u; mine = 0u;
#pragma unroll
        for (unsigned j = 0; j < 16; ++j) { const unsigned c = xb_ld(&bar[XB_XCNT(j)]); sum += c; cnt += (c > 0u) ? 1u : 0u; mine = (j == x) ? c : mine; }
        if (sum == G) break;
        __builtin_amdgcn_s_sleep(1);
        if ((++sp & 255u) == 0u) { if (xb_ld(&bar[XB_TMO])) break; if (sp > XB_SPIN_CAP) { atomicAdd(&bar[XB_TMO], 1u); break; } }
    }
    nloc = mine > 0u ? mine : 1u; nx = cnt > 0u ? cnt : 1u;
}
__device__ __forceinline__ void xcd_barrier(const XcdBarrier& b) {
    asm volatile("s_waitcnt vmcnt(0)" ::: "memory");
    __syncthreads();
    if (threadIdx.x == 0) {
        unsigned* bar = b.bar;
        __builtin_amdgcn_s_waitcnt(0);
        unsigned nloc = b.st[0], nx = b.st[1];
        if (nloc == 0u) { xcd_barrier_complete(bar, b.x, nloc, nx); b.st[0] = nloc; b.st[1] = nx; }
        const unsigned old = xb_add(&bar[XB_XSUB(b.x)], 1u);
        const unsigned gen = old / nloc;
        if (old + 1u == (gen + 1u) * nloc) {
            __builtin_amdgcn_fence(__ATOMIC_RELEASE, "agent");
            asm volatile("s_waitcnt vmcnt(0)" ::: "memory");
            const unsigned og = xb_add(&bar[XB_TOP], 1u);
            const unsigned tg = og / nx;
            if (og + 1u == (tg + 1u) * nx) xb_add(&bar[XB_TOPGEN], 1u);
            else XB_SPIN(xb_ld(&bar[XB_TOPGEN]) == tg, bar);
            __builtin_amdgcn_fence(__ATOMIC_ACQUIRE, "agent");
            xb_add(&bar[XB_XGEN(b.x)], 1u);
            asm volatile("s_waitcnt vmcnt(0)" ::: "memory");
        } else {
            XB_SPIN(xb_ld(&bar[XB_XGEN(b.x)]) == gen, bar);
            __builtin_amdgcn_fence(__ATOMIC_ACQUIRE, "agent");
            asm volatile("s_waitcnt vmcnt(0)" ::: "memory");
        }
    }
    __syncthreads();
}

__global__ void __launch_bounds__(512) fwd_megakernel(Params P) {
    extern __shared__ __attribute__((aligned(16))) unsigned char lds_raw[];
    LAS unsigned char* lds = (LAS unsigned char*)lds_raw;
    cg::grid_group grid = cg::this_grid();
    const int G = gridDim.x, NGW = G * 8;
#define PHASE_IDS() int tid_ = threadIdx.x; asm volatile("" : "+v"(tid_)); const int lane = tid_ & 63, wave = __builtin_amdgcn_readfirstlane(tid_ >> 6), gw = blockIdx.x * 8 + wave
    unsigned char* ws = P.ws;
    bf16_t* ACT = (bf16_t*)(ws + WS_ACT); bf16_t* PROJ = (bf16_t*)(ws + WS_PROJ);
    pg8::StaticOrder S;
    unsigned long long pt_acc = 0, pt_last = 0;
    volatile LAS unsigned* MISC = (volatile LAS unsigned*)(lds + 139264);
    if (threadIdx.x < 16) MISC[threadIdx.x] = 0u;
    __syncthreads();
    const XcdBarrier xbar = xcd_barrier_post((unsigned*)(ws + WS_CTL), MISC + 8);
#define GRID_BAR() xcd_barrier(xbar)

    PT_B(0);
    { PHASE_IDS(); p0_prologue(P, lds, gw, NGW, wave, lane); }
    if (P.ws == nullptr) grid.sync();
    GRID_BAR();
    PT_E(0);
    PT_B(1);
    { pg8::Gemm g{ACT, (const bf16_t*)(ws + WS_WIN), MROWS, LDP, 2048, 2048}; S.init(MROWS, LDP, G, blockIdx.x);
      Epi<EP_BF16> E{PROJ, nullptr, LDP, nullptr, nullptr, nullptr, nullptr}; pg8::gemm_phase(lds, g, S, E); }
    {
      const int nwg = (MROWS / 256) * (LDP / 256), rem = nwg % G; const bool is_short = (rem == 0) || ((int)blockIdx.x >= rem);
      const int nshort = (rem == 0) ? G : G - rem, sidx = (rem == 0) ? (int)blockIdx.x : (int)blockIdx.x - rem;
      if (is_short) { PHASE_IDS(); (void)gw; transpose_range(P, (LAS float*)(lds + wave * 16384), TR_IN_ITEMS, TR_ALL_ITEMS, sidx * 8 + wave, nshort * 8, lane); } }
    GRID_BAR();
    PT_E(1);
    PT_B(2);
    { PHASE_IDS(); p2_prep(P, gw, NGW, lane); }
    GRID_BAR();
    PT_E(2);
    PT_B(3);
    { pg8::Gemm g{PROJ + C_CKV, (const bf16_t*)(ws + WS_WKV), MROWS, 2048, 512, LDP}; S.init(MROWS, 2048, G, blockIdx.x);
      Epi<EP_KV> E{ACT, nullptr, 1024, nullptr, nullptr, ACT + (size_t)MROWS * 1024, nullptr}; pg8::gemm_phase(lds, g, S, E); }
    __syncthreads();
    PT_E(3);
    PT_B(4);
    delta_prep(P, lds);
    GRID_BAR();
    PT_E(4);
    PT_B(5);
    delta_scan(P, lds);
    __syncthreads();
    PT_E(5);
    PT_B(6);
    mla_attention(P, lds);
    GRID_BAR();
    PT_E(6);
    PT_B(8);
    { pg8::Gemm g{PROJ + C_Q, (const bf16_t*)(ws + WS_WA), MROWS, 2048, 1024, LDP}; S.init(MROWS, 2048, G, blockIdx.x);
      Epi<EP_YA> E{ACT, nullptr, DM, PROJ, nullptr, nullptr, nullptr}; pg8::gemm_phase(lds, g, S, E); }
    { pg8::Gemm g{PROJ + C_K, (const bf16_t*)(ws + WS_WB), MROWS, 2048, 1024, LDP}; S.init(MROWS, 2048, G, blockIdx.x);
      Epi<EP_YB> E{ACT, nullptr, DM, PROJ, nullptr, nullptr, nullptr}; pg8::gemm_phase(lds, g, S, E); }
    GRID_BAR();
    PT_E(8);
    PT_B(9);
    { pg8::Gemm g{ACT, (const bf16_t*)(ws + WS_WOUT), MROWS, 2048, 2048, 2048}; S.init(MROWS, 2048, G, blockIdx.x);
      Epi<EP_X1> E{(bf16_t*)(ws + WS_XB), nullptr, DM, nullptr, (const float*)P.in[0], nullptr, (float*)(ws + WS_SSQ1)}; pg8::gemm_phase(lds, g, S, E); }
    GRID_BAR();
    PT_E(9);
    PT_B(11);
    { pg8::Gemm g{(const bf16_t*)(ws + WS_XB), (const bf16_t*)(ws + WS_WUP), MROWS, DFF, 2048, 2048}; S.init(MROWS, DFF, G, blockIdx.x);
      Epi<EP_RELU2> E{PROJ, nullptr, DFF, nullptr, nullptr, nullptr, (float*)(ws + WS_SSQ1)}; pg8::gemm_phase(lds, g, S, E); }
    { pg8::Gemm g{(const bf16_t*)(ws + WS_PBF), (const bf16_t*)(ws + WS_WPLE), MROWS, 2048, 256, 256}; S.init(MROWS, 2048, G, blockIdx.x);
      Epi<EP_BF16> E{ACT, nullptr, DM, nullptr, nullptr, nullptr, nullptr}; pg8::gemm_phase(lds, g, S, E); }
    GRID_BAR();
    PT_E(11);
    PT_B(12);
    { pg8::Gemm g{PROJ, (const bf16_t*)(ws + WS_WDN), MROWS, 2048, DFF, DFF}; S.init(MROWS, 2048, G, blockIdx.x);
      Epi<EP_ACC> E{(bf16_t*)(ws + WS_XB), nullptr, DM, nullptr, nullptr, nullptr, (float*)(ws + WS_SSQ2)}; pg8::gemm_phase(lds, g, S, E); }
    GRID_BAR();
    PT_E(12);
    PT_B(14);
    { pg8::Gemm g{(const bf16_t*)(ws + WS_XB), (const bf16_t*)(ws + WS_WPG), MROWS, 2048, 2048, 2048}; S.init(MROWS, 2048, G, blockIdx.x);
      Epi<EP_PLE> E{nullptr, P.out, DM, ACT, nullptr, (bf16_t*)(ws + WS_XB), (float*)(ws + WS_SSQ2)}; pg8::gemm_phase(lds, g, S, E); }
    PT_E(14);
    if (PROBE_MASK != 0u && blockIdx.x == 0) { const unsigned long long t_end = __builtin_amdgcn_s_memrealtime() + (unsigned long long)PROBE_MULT * pt_acc;
        while (__builtin_amdgcn_s_memrealtime() < t_end) __builtin_amdgcn_s_sleep(8); }
}

extern "C" void kernel_launch(void* const* d_in, const int* in_sizes, int n_in, void* d_out, int out_size, void* d_ws, size_t ws_size, hipStream_t stream) {
    static int grid = 0;
    if (grid == 0) {
        if (n_in != 24 || out_size != MROWS * DM || ws_size < WS_END) { fprintf(stderr, "kernel_launch: unexpected shapes: n_in %d out %d ws %zu (need %zu)\n", n_in, out_size, ws_size, (size_t)WS_END); grid = -1; return; }
        int dev = 0, cus = 0, per_cu = 0;
        if (hipGetDevice(&dev) != hipSuccess || hipDeviceGetAttribute(&cus, hipDeviceAttributeMultiprocessorCount, dev) != hipSuccess) { grid = -1; return; }
        if (hipFuncSetAttribute((const void*)fwd_megakernel, hipFuncAttributeMaxDynamicSharedMemorySize, LDS_BYTES) != hipSuccess) { fprintf(stderr, "kernel_launch: hipFuncSetAttribute failed\n"); grid = -1; return; }
        if (hipOccupancyMaxActiveBlocksPerMultiprocessor(&per_cu, (const void*)fwd_megakernel, 512, LDS_BYTES) != hipSuccess || per_cu < 1) { fprintf(stderr, "kernel_launch: occupancy query gave %d\n", per_cu); per_cu = 1; }
        (void)hipGetLastError();
        grid = cus * per_cu;
        fprintf(stderr, "kernel_launch: grid %d (cus %d x %d), ws %zu\n", grid, cus, per_cu, ws_size);
    }
    if (grid < 0) return;
    Params p{};
    for (int i = 0; i < 24; ++i) p.in[i] = d_in[i];
    p.out = (float*)d_out; p.ws = (unsigned char*)d_ws;
    for (int i = 0; i < 32; ++i) p.ropeinv[i] = (float)pow(10000.0, -(double)i / 32.0);
    if (hipMemsetAsync((char*)d_ws + WS_CTL, 0, CTL_BYTES, stream) != hipSuccess) { fprintf(stderr, "kernel_launch: hipMemsetAsync failed\n"); return; }
    void* args[] = {&p};
    hipError_t e = hipLaunchCooperativeKernel((const void*)fwd_megakernel, dim3(grid), dim3(512), args, LDS_BYTES, stream);
    if (e != hipSuccess) fprintf(stderr, "kernel_launch: cooperative launch failed: %s (grid %d)\n", hipGetErrorString(e), grid);
}
```

```cpp
#include <hip/hip_runtime.h>
#include <hip/hip_cooperative_groups.h>
#include <cstdio>
#include <cstdint>
#include <cmath>
namespace cg = cooperative_groups;
#ifndef PROBE_MASK
#define PROBE_MASK 0u
#endif
#define PROBE_MULT 3
#define PT_B(bit) do { if ((PROBE_MASK >> (bit)) & 1u) { __builtin_amdgcn_s_waitcnt(0); pt_last = __builtin_amdgcn_s_memrealtime(); } } while (0)
#define PT_E(bit) do { if ((PROBE_MASK >> (bit)) & 1u) { __builtin_amdgcn_s_waitcnt(0); pt_acc += __builtin_amdgcn_s_memrealtime() - pt_last; } } while (0)

#define LAS __attribute__((address_space(3)))
typedef unsigned short bf16_t;
typedef short bf16x8 __attribute__((ext_vector_type(8)));
typedef float f32x4 __attribute__((ext_vector_type(4)));
typedef float f32x2 __attribute__((ext_vector_type(2)));
typedef unsigned u32x4 __attribute__((ext_vector_type(4)));
typedef unsigned u32x2 __attribute__((ext_vector_type(2)));

constexpr int NB = 16, SEQ = 2048, MROWS = NB * SEQ, DM = 2048, LDP = 10496, DFF = 8192, PLE = 256;
constexpr int C_Q = 0, C_K = 1024, C_V = 2048, C_Z = 3072, C_MQ = 4096, C_CKV = 5632, C_GA = 6144, C_GB = 8192, C_KR = 10240, C_BETA = 10304, C_ALPHA = 10312;
constexpr int D_IN = 10320;
constexpr float EPS = 1e-6f;
constexpr float LOG2E = 1.4426950408889634f;
constexpr size_t MiB = 1u << 20;
constexpr size_t WS_WIN = 0, WS_WKV = 41 * MiB, WS_WA = 43 * MiB, WS_WB = 47 * MiB, WS_WOUT = 51 * MiB, WS_WUP = 59 * MiB, WS_WDN = 91 * MiB, WS_WPG = 123 * MiB,
                 WS_WPLE = 131 * MiB, WS_PBF = 132 * MiB, WS_G = 148 * MiB, WS_BETA = 149 * MiB, WS_QKM = 150 * MiB, WS_ACT = 182 * MiB, WS_PROJ = 310 * MiB,
                 WS_GL = 966 * MiB, WS_CTL = 967 * MiB, WS_END = 968 * MiB;
constexpr size_t CTL_BYTES = 1 * MiB;
constexpr size_t WS_SSQ1 = WS_CTL + 256 * 1024, WS_SSQ2 = WS_CTL + 512 * 1024;
constexpr size_t WS_XB = WS_PROJ + 512 * MiB;
constexpr int LDS_BYTES = 147456;

__device__ __forceinline__ float bf2f(bf16_t v) { return __uint_as_float((unsigned)v << 16); }
__device__ __forceinline__ float bflo(unsigned w) { return __uint_as_float(w << 16); }
__device__ __forceinline__ float bfhi(unsigned w) { return __uint_as_float(w & 0xffff0000u); }
__device__ __forceinline__ unsigned pk2(float lo, float hi) { unsigned r; asm("v_cvt_pk_bf16_f32 %0, %1, %2" : "=v"(r) : "v"(lo), "v"(hi)); return r; }
__device__ __forceinline__ bf16_t f2bf(float f) { return (bf16_t)(pk2(f, 0.f) & 0xffffu); }
__device__ __forceinline__ float wave_sum(float v) {
#pragma unroll
    for (int o = 1; o < 64; o <<= 1) v += __shfl_xor(v, o);
    return v;
}
__device__ __forceinline__ float fast_sigmoid(float x) { return __builtin_amdgcn_rcpf(1.f + __builtin_amdgcn_exp2f(-x * LOG2E)); }
__device__ __forceinline__ float silu_f(float x) { return x * fast_sigmoid(x); }
#define LDS_WAIT() asm volatile("s_waitcnt lgkmcnt(0)" ::: "memory")

namespace pg8 {
constexpr int BM = 256, BK = 64, HALF = 128, HTB = HALF * BK * 2, STAGE_BYTES = 8 * HTB, NXCD = 8, WGM = 8;
__host__ __device__ __forceinline__ int lds_byte(int r, int c) { const int st = (r >> 4) * 2 + (c >> 5), rr = r & 15, cc = c & 31, ob = rr * 64 + cc * 2; return st * 1024 + (ob ^ (((ob >> 9) & 1) << 5)); }
__host__ __device__ __forceinline__ void stage_rc(int b, int& R, int& C) { const int st = b / 1024, sb = b % 1024, swz = sb ^ (((sb >> 9) & 1) << 5); R = (st >> 1) * 16 + swz / 64; C = (st & 1) * 32 + (swz % 64) / 2; }
__host__ __device__ __forceinline__ int perm32(int rho) { const int n = rho >> 4, i = rho & 15; return 8 * (i >> 2) + 4 * n + (i & 3); }
struct Unit { int pm, pn; };
struct Gemm { const bf16_t* A; const bf16_t* Bt; int M, N, K, lda; };
struct StaticOrder {
    int nM, nN, nwg, G, c;
    __device__ void init(int M, int N, int G_, int c_) { nM = M / BM; nN = N / BM; nwg = nM * nN; G = G_; c = c_; }
    __device__ bool next(int i, Unit& u) const {
        const long L = (long)i * G + c; if (L >= nwg) return false;
        int wgid = (int)L; { const int q = nwg / NXCD, r = nwg % NXCD, xcd = wgid % NXCD, off = wgid / NXCD; wgid = (xcd < r ? xcd * (q + 1) : r * (q + 1) + (xcd - r) * q) + off; }
        const int nig = WGM * nN, gid = wgid / nig, fm = gid * WGM, gsz = (nM - fm) < WGM ? (nM - fm) : WGM;
        u.pm = fm + ((wgid % nig) % gsz); u.pn = (wgid % nig) / gsz; return true;
    }
};
template <class Epi>
__device__ __forceinline__ void gemm_phase(LAS unsigned char* lds, const Gemm g, const StaticOrder& S, const Epi& E) {
    int tid = threadIdx.x; asm volatile("" : "+v"(tid));
    const int wid = __builtin_amdgcn_readfirstlane(tid >> 6), lane = tid & 63, wr = wid >> 2, wc = wid & 3, fr = lane & 15, fq = lane >> 4;
    const int K = g.K, nt = K / BK, lda = g.lda;
    unsigned voffA[2], voffB[2];
#pragma unroll
    for (int i = 0; i < 2; ++i) { int R, C; stage_rc(tid * 16 + i * 8192, R, C); const int Rb = ((R & ~31) + perm32(R & 31));
        voffA[i] = (unsigned)(R * lda + C) * 2u; voffB[i] = (unsigned)(Rb * K + C) * 2u; }
    const size_t kstep = (size_t)(BK * 2);
    const size_t hstepA = (size_t)HALF * lda * 2, tstepA = 2 * hstepA, hstepB = (size_t)HALF * K * 2, tstepB = 2 * hstepB;
    const unsigned ldsw = (unsigned)wid * 1024u;
    const int aoff = lds_byte(wr * 64 + fr, fq * 8), boff = lds_byte(wc * 32 + fr, fq * 8);
#define PG8_SA(b, h) (((b) * 2 + (h)) * HTB)
#define PG8_SB(b, h) ((4 + (b) * 2 + (h)) * HTB)
#define PG8_STAGE(bufoff, gbase, voff) do { _Pragma("unroll") for (int _i = 0; _i < 2; ++_i) \
        __builtin_amdgcn_global_load_lds((const unsigned*)((const char*)(gbase) + (voff)[_i]), (LAS unsigned*)(lds + (bufoff) + ldsw + _i * 8192), 16, 0, 0); } while (0)
#define PG8_LDA(dst, b, h) do { _Pragma("unroll") for (int m = 0; m < 4; ++m) _Pragma("unroll") for (int k = 0; k < 2; ++k) dst[m][k] = *(const LAS bf16x8*)(lds + PG8_SA(b, h) + aoff + m * 2048 + k * 1024); } while (0)
#define PG8_LDB(dst, b, h) do { _Pragma("unroll") for (int n = 0; n < 2; ++n) _Pragma("unroll") for (int k = 0; k < 2; ++k) dst[n][k] = *(const LAS bf16x8*)(lds + PG8_SB(b, h) + boff + n * 2048 + k * 1024); } while (0)
#define PG8_MMA(ai, bj, At, Bt) do { __builtin_amdgcn_s_setprio(1); _Pragma("unroll") for (int m = 0; m < 4; ++m) _Pragma("unroll") for (int n = 0; n < 2; ++n) _Pragma("unroll") for (int k = 0; k < 2; ++k) { \
        if constexpr (Epi::SWAP1 && (bj) == 1) acc[ai][bj][m][n] = __builtin_amdgcn_mfma_f32_16x16x32_bf16(At[m][k], Bt[n][k], acc[ai][bj][m][n], 0, 0, 0); \
        else acc[ai][bj][m][n] = __builtin_amdgcn_mfma_f32_16x16x32_bf16(Bt[n][k], At[m][k], acc[ai][bj][m][n], 0, 0, 0); } __builtin_amdgcn_s_setprio(0); } while (0)
#define PG8_WAIT_V(n) asm volatile("s_waitcnt vmcnt(" #n ")" ::: "memory")
#define PG8_WAIT_L(n) asm volatile("s_waitcnt lgkmcnt(" #n ")" ::: "memory")
#define PG8_BAR __builtin_amdgcn_s_barrier()
#define PG8_SCHED __builtin_amdgcn_sched_barrier(0)
    Unit cur, nxt; int ui = 0;
    if (!S.next(0, cur)) return;
    f32x4 acc[2][2][4][2];
#pragma unroll
    for (int a = 0; a < 2; ++a)
#pragma unroll
        for (int b = 0; b < 2; ++b)
#pragma unroll
            for (int m = 0; m < 4; ++m)
#pragma unroll
                for (int n = 0; n < 2; ++n) acc[a][b][m][n] = (f32x4){0.f, 0.f, 0.f, 0.f};
    bf16x8 At[4][2], B0[2][2], B1[2][2];
    const char* cA = (const char*)g.A + (size_t)cur.pm * tstepA; const char* cB = (const char*)g.Bt + (size_t)cur.pn * tstepB;
    PG8_STAGE(PG8_SB(0, 0), cB, voffB); PG8_STAGE(PG8_SB(0, 1), cB + hstepB, voffB); PG8_STAGE(PG8_SA(0, 0), cA, voffA); PG8_STAGE(PG8_SA(0, 1), cA + hstepA, voffA);
    if (wr == 1) PG8_BAR;
    PG8_WAIT_V(2); PG8_BAR;
    PG8_STAGE(PG8_SB(1, 0), cB + kstep, voffB); PG8_STAGE(PG8_SA(1, 0), cA + kstep, voffA); PG8_STAGE(PG8_SB(1, 1), cB + hstepB + kstep, voffB);
    PG8_WAIT_V(6); PG8_BAR;
    for (;;) {
        const bool has_next = S.next(ui + 1, nxt);
        const char* nA = has_next ? (const char*)g.A + (size_t)nxt.pm * tstepA : cA; const char* nB = has_next ? (const char*)g.Bt + (size_t)nxt.pn * tstepB : cB;
        for (int t = 0; t < nt; t += 2) {
            const bool last = (t == nt - 2);
            const char* a1 = cA + (size_t)(t + 1) * kstep;
            const char* a2 = last ? nA : cA + (size_t)(t + 2) * kstep; const char* b2 = last ? nB : cB + (size_t)(t + 2) * kstep;
            const char* a3 = a2 + kstep; const char* b3 = b2 + kstep;
            PG8_LDB(B0, 0, 0); PG8_LDB(B1, 0, 1); PG8_SCHED; PG8_LDA(At, 0, 0); PG8_STAGE(PG8_SA(1, 1), a1 + hstepA, voffA);
            PG8_WAIT_V(8); PG8_WAIT_L(0); PG8_BAR; PG8_MMA(0, 0, At, B0); PG8_MMA(0, 1, At, B1); PG8_BAR; PG8_SCHED;
            PG8_LDA(At, 0, 1); PG8_STAGE(PG8_SB(0, 0), b2, voffB); PG8_STAGE(PG8_SB(0, 1), b2 + hstepB, voffB); PG8_STAGE(PG8_SA(0, 0), a2, voffA);
            PG8_WAIT_V(8); PG8_WAIT_L(0); PG8_BAR; PG8_MMA(1, 0, At, B0); PG8_MMA(1, 1, At, B1); PG8_BAR; PG8_SCHED;
            PG8_LDB(B0, 1, 0); PG8_LDB(B1, 1, 1); PG8_SCHED; PG8_LDA(At, 1, 0); PG8_STAGE(PG8_SA(0, 1), a2 + hstepA, voffA);
            PG8_WAIT_V(8); PG8_WAIT_L(0); PG8_BAR; PG8_MMA(0, 0, At, B0); PG8_MMA(0, 1, At, B1); PG8_BAR; PG8_SCHED;
            PG8_LDA(At, 1, 1); PG8_STAGE(PG8_SB(1, 0), b3, voffB); PG8_STAGE(PG8_SB(1, 1), b3 + hstepB, voffB); PG8_STAGE(PG8_SA(1, 0), a3, voffA);
            PG8_WAIT_V(8); PG8_WAIT_L(0); PG8_BAR; PG8_MMA(1, 0, At, B0); PG8_MMA(1, 1, At, B1); PG8_BAR; PG8_SCHED;
        }
        if (wr == 0) PG8_BAR;
        E(acc, cur, wr, wc, fr, fq);
        if (!has_next) break;
#pragma unroll
        for (int a = 0; a < 2; ++a)
#pragma unroll
            for (int b = 0; b < 2; ++b)
#pragma unroll
                for (int m = 0; m < 4; ++m)
#pragma unroll
                    for (int n = 0; n < 2; ++n) acc[a][b][m][n] = (f32x4){0.f, 0.f, 0.f, 0.f};
        cur = nxt; cA = nA; cB = nB; ++ui;
        if (wr == 1) PG8_BAR;
    }
    PG8_WAIT_V(0);
    PG8_BAR;
#undef PG8_SA
#undef PG8_SB
#undef PG8_STAGE
#undef PG8_LDA
#undef PG8_LDB
#undef PG8_MMA
#undef PG8_WAIT_V
#undef PG8_WAIT_L
#undef PG8_BAR
#undef PG8_SCHED
}
}

enum { EP_BF16 = 0, EP_KV, EP_YA, EP_YB, EP_X1, EP_RELU2, EP_ACC, EP_F32, EP_PLE };
__device__ __forceinline__ void store8bf(bf16_t* p, f32x4 a, f32x4 b) { u32x4 w; w.x = pk2(a[0], a[1]); w.y = pk2(a[2], a[3]); w.z = pk2(b[0], b[1]); w.w = pk2(b[2], b[3]); *(u32x4*)p = w; }
__device__ __forceinline__ void load8bf(const bf16_t* p, f32x4& a, f32x4& b) { const u32x4 w = *(const u32x4*)p; a = (f32x4){bflo(w.x), bfhi(w.x), bflo(w.y), bfhi(w.y)}; b = (f32x4){bflo(w.z), bfhi(w.z), bflo(w.w), bfhi(w.w)}; }
__device__ __forceinline__ f32x4 sig4(f32x4 v) { return (f32x4){fast_sigmoid(v[0]), fast_sigmoid(v[1]), fast_sigmoid(v[2]), fast_sigmoid(v[3])}; }
template <int MODE> struct Epi {
    static constexpr bool SWAP1 = (MODE == EP_KV);
    bf16_t* ob; float* of; int ldc; const bf16_t* gate; const float* res; bf16_t* vt; float* ssq;
    struct Pre { f32x4 f[2][2]; u32x4 g[2]; u32x4 y[2]; };
    __device__ __forceinline__ void preload(Pre& p, int row, int col0) const {
#pragma unroll
        for (int bj = 0; bj < 2; ++bj) { const int col = col0 + bj * 128;
            if constexpr (MODE == EP_YA) p.g[bj] = *(const u32x4*)(gate + (size_t)row * LDP + C_GA + col);
            else if constexpr (MODE == EP_YB) { p.g[bj] = *(const u32x4*)(gate + (size_t)row * LDP + C_GB + col); p.y[bj] = *(const u32x4*)(ob + (size_t)row * DM + col); }
            else if constexpr (MODE == EP_X1) { const float* r = res + (size_t)row * DM + col; p.f[bj][0] = *(const f32x4*)r; p.f[bj][1] = *(const f32x4*)(r + 4); }
            else if constexpr (MODE == EP_ACC) p.y[bj] = *(const u32x4*)(ob + (size_t)row * DM + col);
            else if constexpr (MODE == EP_PLE) { p.y[bj] = *(const u32x4*)(vt + (size_t)row * DM + col); p.g[bj] = *(const u32x4*)(gate + (size_t)row * DM + col); }
        }
    }
    static __device__ __forceinline__ void up8(const u32x4 w, f32x4& a, f32x4& b) { a = (f32x4){bflo(w.x), bfhi(w.x), bflo(w.y), bfhi(w.y)}; b = (f32x4){bflo(w.z), bfhi(w.z), bflo(w.w), bfhi(w.w)}; }
    __device__ __forceinline__ void operator()(const f32x4 (&acc)[2][2][4][2], const pg8::Unit& u, int wr, int wc, int fr, int fq) const {
        const int rowb = u.pm * 256 + wr * 64 + fr, col0 = u.pn * 256 + wc * 32 + 8 * fq;
        float rs[8];
        if constexpr (MODE == EP_RELU2 || MODE == EP_PLE) {
#pragma unroll
            for (int it = 0; it < 8; ++it) rs[it] = ssq[rowb + (it >> 2) * 128 + (it & 3) * 16];
#pragma unroll
            for (int it = 0; it < 8; ++it) rs[it] = rsqrtf(rs[it] * (1.f / 2048.f) + EPS);
        }
        Pre pre[2];
        preload(pre[0], rowb, col0);
#pragma unroll
        for (int it = 0; it < 8; ++it) {
            const int ai = it >> 2, m = it & 3, row = rowb + ai * 128 + m * 16;
            if (it + 1 < 8) preload(pre[(it + 1) & 1], rowb + ((it + 1) >> 2) * 128 + ((it + 1) & 3) * 16, col0);
            const Pre& pp = pre[it & 1];
            float rsum = 0.f; const float rstd = (MODE == EP_RELU2 || MODE == EP_PLE) ? rs[it] : 1.f;
#pragma unroll
            for (int bj = 0; bj < 2; ++bj) {
                const int col = col0 + bj * 128;
                f32x4 v0 = acc[ai][bj][m][0], v1 = acc[ai][bj][m][1];
                if constexpr (MODE == EP_BF16) { store8bf(ob + (size_t)row * ldc + col, v0, v1); }
                else if constexpr (MODE == EP_RELU2) {
#pragma unroll
                    for (int e = 0; e < 4; ++e) { const float a = fmaxf(v0[e] * rstd, 0.f), b = fmaxf(v1[e] * rstd, 0.f); v0[e] = a * a; v1[e] = b * b; }
                    store8bf(ob + (size_t)row * ldc + col, v0, v1); }
                else if constexpr (MODE == EP_KV) {
                    if (bj == 0) store8bf(ob + (size_t)row * 1024 + u.pn * 128 + wc * 32 + 8 * fq, v0, v1);
                    else {
                        const int r0 = u.pm * 256 + ai * 128 + wr * 64 + m * 16 + 4 * fq, b = r0 >> 11, s = r0 & 2047;
                        bf16_t* base = vt + ((size_t)((b * 8 + u.pn) * 128 + wc * 32)) * 2048 + s;
                        u32x2 w0, w1; w0.x = pk2(v0[0], v0[1]); w0.y = pk2(v0[2], v0[3]); w1.x = pk2(v1[0], v1[1]); w1.y = pk2(v1[2], v1[3]);
                        *(u32x2*)(base + (size_t)pg8::perm32(fr) * 2048) = w0; *(u32x2*)(base + (size_t)pg8::perm32(16 + fr) * 2048) = w1; } }
                else if constexpr (MODE == EP_YA) { f32x4 g0, g1; up8(pp.g[bj], g0, g1); store8bf(ob + (size_t)row * DM + col, sig4(g0) * v0, sig4(g1) * v1); }
                else if constexpr (MODE == EP_YB) { f32x4 g0, g1, a0, a1; up8(pp.g[bj], g0, g1); up8(pp.y[bj], a0, a1); store8bf(ob + (size_t)row * DM + col, a0 + sig4(g0) * v0, a1 + sig4(g1) * v1); }
                else if constexpr (MODE == EP_X1 || MODE == EP_ACC) { f32x4 r0, r1;
                    if constexpr (MODE == EP_X1) { r0 = pp.f[bj][0]; r1 = pp.f[bj][1]; } else up8(pp.y[bj], r0, r1);
                    const f32x4 x0 = r0 + v0, x1 = r1 + v1;
                    store8bf(ob + (size_t)row * DM + col, x0, x1);
                    rsum += (x0[0] * x0[0] + x0[1] * x0[1]) + (x0[2] * x0[2] + x0[3] * x0[3]) + (x1[0] * x1[0] + x1[1] * x1[1]) + (x1[2] * x1[2] + x1[3] * x1[3]); }
                else if constexpr (MODE == EP_F32) { float* o = of + (size_t)row * DM + col; *(f32x4*)o = v0; *(f32x4*)(o + 4) = v1; }
                else if constexpr (MODE == EP_PLE) { f32x4 p0, p1, x0, x1; up8(pp.g[bj], p0, p1); up8(pp.y[bj], x0, x1); float* o = of + (size_t)row * DM + col;
                    *(f32x4*)o = x0 + sig4(v0 * rstd) * p0; *(f32x4*)(o + 4) = x1 + sig4(v1 * rstd) * p1; }
            }
            if constexpr (MODE == EP_X1 || MODE == EP_ACC) { rsum += __shfl_xor(rsum, 16); rsum += __shfl_xor(rsum, 32);
                if (fq == 0) __hip_atomic_fetch_add(ssq + row, rsum, __ATOMIC_RELAXED, __HIP_MEMORY_SCOPE_AGENT); }
            asm volatile("" ::: "memory");
        }
    }
};

struct Params { const void* in[24]; float* out; unsigned char* ws; float ropeinv[32]; };

__device__ __forceinline__ int win_map(int n) {
    if (n < 4096) return n;
    if (n < 5632) return 4112 + (n - 4096);
    if (n < 6144) return 5648 + (n - 5632);
    if (n < 8192) return 6224 + (n - 6144);
    if (n < 10240) return 8272 + (n - 8192);
    if (n < 10304) return 6160 + (n - 10240);
    if (n < 10312) return 4096 + (n - 10304);
    if (n < 10320) return 4104 + (n - 10312);
    return -1;
}
struct TrJob { int widx, K, N, nblk, item; };
__device__ __forceinline__ const float* opq(const void* p) { unsigned long long v = (unsigned long long)p; asm volatile("" : "+s"(v)); return (const float*)v; }
__device__ __forceinline__ const float* tr_src(const Params& P, int w) {
    const float* a0 = opq(P.in[4]); const float* a1 = opq(P.in[10]); const float* a2 = opq(P.in[15]); const float* a3 = opq(P.in[16]); const float* a4 = opq(P.in[17]);
    const float* a5 = opq(P.in[19]); const float* a6 = opq(P.in[20]); const float* a7 = opq(P.in[22]); const float* a8 = opq(P.in[23]);
    return w == 0 ? a0 : w == 1 ? a1 : w == 2 ? a2 : w == 3 ? a3 : w == 4 ? a4 : w == 5 ? a5 : w == 6 ? a6 : w == 7 ? a7 : a8; }
__device__ __forceinline__ size_t tr_dst_off(int w) { return w == 0 ? WS_WIN : w == 1 ? WS_WKV : w == 2 ? WS_WA : w == 3 ? WS_WB : w == 4 ? WS_WOUT : w == 5 ? WS_WUP : w == 6 ? WS_WDN : w == 7 ? WS_WPG : WS_WPLE; }
__device__ __forceinline__ void tr_load(const Params& P, const TrJob& J, int lane, f32x4 (&v)[8]) {
    const int kb = J.item / J.nblk, nb = J.item % J.nblk, k0 = 64 * kb, n0 = 32 * nb, q4 = lane & 7, kr = lane >> 3;
    int oc = n0 + 4 * q4; if (J.widx == 0) oc = win_map(oc);
    const float* W = tr_src(P, J.widx);
#pragma unroll
    for (int i = 0; i < 8; ++i) v[i] = (oc >= 0) ? *(const f32x4*)(W + (size_t)(k0 + 8 * i + kr) * J.N + oc) : (f32x4){0.f, 0.f, 0.f, 0.f};
}
__device__ __forceinline__ void tr_finish(const Params& P, const TrJob& J, int lane, const f32x4 (&v)[8], LAS float* scr) {
    const int kb = J.item / J.nblk, nb = J.item % J.nblk, k0 = 64 * kb, n0 = 32 * nb, q4 = lane & 7, kr = lane >> 3;
    const float* kg5 = opq(P.in[18]); const float* kg7 = opq(P.in[21]); const float* kgain = (J.widx == 5) ? kg5 : (J.widx == 7) ? kg7 : nullptr;
    bf16_t* WT = (bf16_t*)(P.ws + tr_dst_off(J.widx));
#pragma unroll
    for (int i = 0; i < 8; ++i) { LAS float* d = scr + (8 * i + kr) * 33 + 4 * q4; const float kg = kgain ? kgain[k0 + 8 * i + kr] : 1.f; d[0] = v[i][0] * kg; d[1] = v[i][1] * kg; d[2] = v[i][2] * kg; d[3] = v[i][3] * kg; }
    LDS_WAIT();
    const int c = lane & 7;
#pragma unroll
    for (int j = 0; j < 4; ++j) { const int n = (lane >> 3) + 8 * j; const LAS float* sp = scr + (8 * c) * 33 + n;
        u32x4 o; o.x = pk2(sp[0 * 33], sp[1 * 33]); o.y = pk2(sp[2 * 33], sp[3 * 33]); o.z = pk2(sp[4 * 33], sp[5 * 33]); o.w = pk2(sp[6 * 33], sp[7 * 33]);
        *(u32x4*)(WT + (size_t)(n0 + n) * J.K + k0 + 8 * c) = o; }
    LDS_WAIT();
}
__device__ __forceinline__ void rmsnorm_row(const float* xrow, const float* gain, bf16_t* orow, int lane) {
    const f32x4* xr = (const f32x4*)xrow + lane; const f32x4* gr = (const f32x4*)gain + lane;
    f32x4 v[8]; float s = 0.f;
#pragma unroll
    for (int j = 0; j < 8; ++j) { v[j] = xr[64 * j]; s += (v[j][0] * v[j][0] + v[j][1] * v[j][1]) + (v[j][2] * v[j][2] + v[j][3] * v[j][3]); }
    const float rstd = rsqrtf(wave_sum(s) * (1.f / 2048.f) + EPS);
    u32x2* o8 = (u32x2*)orow + lane;
#pragma unroll
    for (int j = 0; j < 8; ++j) { const f32x4 g = gr[64 * j]; u32x2 w; w.x = pk2(v[j][0] * rstd * g[0], v[j][1] * rstd * g[1]); w.y = pk2(v[j][2] * rstd * g[2], v[j][3] * rstd * g[3]); o8[64 * j] = w; }
}
__device__ __forceinline__ void rmsnorm_rows_phase(const float* X, const float* gain, bf16_t* O, int gw, int NGW, int lane) {
    for (int m = gw; m < MROWS / 2; m += NGW) {
        const f32x4* x0 = (const f32x4*)(X + (size_t)m * DM) + lane; const f32x4* x1 = (const f32x4*)(X + (size_t)(m + MROWS / 2) * DM) + lane; const f32x4* gr = (const f32x4*)gain + lane;
        f32x4 a[8], b[8]; float sa = 0.f, sb = 0.f;
#pragma unroll
        for (int j = 0; j < 8; ++j) { a[j] = x0[64 * j]; b[j] = x1[64 * j]; }
#pragma unroll
        for (int j = 0; j < 8; ++j) { sa += (a[j][0] * a[j][0] + a[j][1] * a[j][1]) + (a[j][2] * a[j][2] + a[j][3] * a[j][3]); sb += (b[j][0] * b[j][0] + b[j][1] * b[j][1]) + (b[j][2] * b[j][2] + b[j][3] * b[j][3]); }
        const float ra = rsqrtf(wave_sum(sa) * (1.f / 2048.f) + EPS), rb = rsqrtf(wave_sum(sb) * (1.f / 2048.f) + EPS);
        u32x2* oa = (u32x2*)(O + (size_t)m * DM) + lane; u32x2* ob = (u32x2*)(O + (size_t)(m + MROWS / 2) * DM) + lane;
#pragma unroll
        for (int j = 0; j < 8; ++j) { const f32x4 g = gr[64 * j]; u32x2 w; w.x = pk2(a[j][0] * ra * g[0], a[j][1] * ra * g[1]); w.y = pk2(a[j][2] * ra * g[2], a[j][3] * ra * g[3]); oa[64 * j] = w;
            w.x = pk2(b[j][0] * rb * g[0], b[j][1] * rb * g[1]); w.y = pk2(b[j][2] * rb * g[2], b[j][3] * rb * g[3]); ob[64 * j] = w; }
    }
}

__device__ __forceinline__ TrJob tr_job(int it) {
    constexpr int I_IN = 32 * (LDP / 32), I_KV = 8 * 64, I_A = 16 * 64, I_B = 16 * 64, I_OUT = 32 * 64, I_UP = 32 * 256, I_DN = 128 * 64, I_PG = 32 * 64;
    int r = it;
    if (r < I_IN) return TrJob{0, 2048, D_IN, LDP / 32, r}; r -= I_IN;
    if (r < I_KV) return TrJob{1, 512, 2048, 64, r}; r -= I_KV;
    if (r < I_A) return TrJob{2, 1024, 2048, 64, r}; r -= I_A;
    if (r < I_B) return TrJob{3, 1024, 2048, 64, r}; r -= I_B;
    if (r < I_OUT) return TrJob{4, 2048, 2048, 64, r}; r -= I_OUT;
    if (r < I_UP) return TrJob{5, 2048, 8192, 256, r}; r -= I_UP;
    if (r < I_DN) return TrJob{6, 8192, 2048, 64, r}; r -= I_DN;
    if (r < I_PG) return TrJob{7, 2048, 2048, 64, r}; r -= I_PG;
    return TrJob{8, 256, 2048, 64, r};
}
constexpr int TR_IN_ITEMS = 32 * (LDP / 32);
constexpr int TR_ALL_ITEMS = 32 * (LDP / 32) + 8 * 64 + 16 * 64 + 16 * 64 + 32 * 64 + 32 * 256 + 128 * 64 + 32 * 64 + 4 * 64;
__device__ __forceinline__ void transpose_range(const Params& P, LAS float* scr, int lo, int hi, int gw, int NGW, int lane) {
    for (int it = lo + gw; it < hi; it += 2 * NGW) {
        const TrJob J0 = tr_job(it); f32x4 v0[8], v1[8]; tr_load(P, J0, lane, v0);
        const bool two = (it + NGW < hi);
        const TrJob J1 = tr_job(two ? it + NGW : it);
        if (two) tr_load(P, J1, lane, v1);
        tr_finish(P, J0, lane, v0, scr);
        if (two) tr_finish(P, J1, lane, v1, scr);
    }
}
__device__ __forceinline__ void p0_prologue(const Params& P, LAS unsigned char* lds, int gw, int NGW, int wave, int lane) {
    unsigned char* ws = P.ws;
    LAS float* scr = (LAS float*)(lds + wave * 16384);
    transpose_range(P, scr, 0, TR_IN_ITEMS, gw, NGW, lane);
    rmsnorm_rows_phase((const float*)P.in[0], (const float*)P.in[3], (bf16_t*)(ws + WS_ACT), gw, NGW, lane);
    { const f32x4* src = (const f32x4*)P.in[1]; u32x4* dst = (u32x4*)(ws + WS_PBF); const size_t n8 = (size_t)MROWS * PLE / 8;
      for (size_t i = (size_t)gw * 64 + lane; i < n8; i += (size_t)NGW * 64) { const f32x4 a = src[2 * i], b = src[2 * i + 1]; u32x4 w; w.x = pk2(a[0], a[1]); w.y = pk2(a[2], a[3]); w.z = pk2(b[0], b[1]); w.w = pk2(b[2], b[3]); dst[i] = w; } }
}

__device__ __forceinline__ void rope_cs(float pos, float inv, float& c, float& s) {
    const float a = pos * inv;
    double rev = (double)a * 0.15915494309189535; rev -= rint(rev);
    const float r = (float)rev; s = __builtin_amdgcn_sinf(r); c = __builtin_amdgcn_cosf(r);
}
__device__ __forceinline__ void unpack8(const u32x4 w, float (&f)[8]) { f[0] = bflo(w.x); f[1] = bfhi(w.x); f[2] = bflo(w.y); f[3] = bfhi(w.y); f[4] = bflo(w.z); f[5] = bfhi(w.z); f[6] = bflo(w.w); f[7] = bfhi(w.w); }
__device__ __forceinline__ u32x4 pack8(const float (&f)[8]) { u32x4 w; w.x = pk2(f[0], f[1]); w.y = pk2(f[2], f[3]); w.z = pk2(f[4], f[5]); w.w = pk2(f[6], f[7]); return w; }
__device__ __forceinline__ void p2_prep(const Params& P, int gw, int NGW, int lane) {
    unsigned char* ws = P.ws;
    bf16_t* proj = (bf16_t*)(ws + WS_PROJ);
    const int* positions = (const int*)P.in[2];
    const float* ckvn = (const float*)P.in[9]; const float* qng = (const float*)P.in[11]; const float* qrg = (const float*)P.in[12]; const float* kng = (const float*)P.in[13]; const float* krg = (const float*)P.in[14];
    const float* dt_bias = (const float*)P.in[6]; const float* a_log = (const float*)P.in[7];
    float* G = (float*)(ws + WS_G); float* BETA = (float*)(ws + WS_BETA);
    const float QSCALE = 0.07216878364870322f * LOG2E;
    {
        const int h = lane >> 3, seg = lane & 7;
        float gn[16], gr[8], inv8[8], gc8[8];
#pragma unroll
        for (int e = 0; e < 16; ++e) gn[e] = qng[16 * seg + e] * kng[16 * seg + e] * QSCALE;
#pragma unroll
        for (int e = 0; e < 8; ++e) { gr[e] = qrg[8 * seg + e]; inv8[e] = P.ropeinv[8 * (seg & 3) + e]; gc8[e] = ckvn[8 * lane + e]; }
        const float inv1 = P.ropeinv[lane & 31], kr_g = krg[lane];
        for (int m = gw; m < MROWS; m += NGW) {
            bf16_t* row = proj + (size_t)m * LDP;
            bf16_t* np = row + C_MQ + h * 192 + 16 * seg; bf16_t* rp = row + C_MQ + h * 192 + 128 + 8 * seg; bf16_t* cp = row + C_CKV + 8 * lane;
            const u32x4 wn0 = *(const u32x4*)np, wn1 = *(const u32x4*)(np + 8), wr = *(const u32x4*)rp, wc = *(const u32x4*)cp;
            const bf16_t wk = row[C_KR + lane]; const bf16_t wba = (lane < 16) ? row[C_BETA + lane] : (bf16_t)0;
            const float pos = (float)positions[m];
            float a[8], b[8]; unpack8(wn0, a); unpack8(wn1, b);
            float ss = 0.f;
#pragma unroll
            for (int e = 0; e < 8; ++e) ss += a[e] * a[e] + b[e] * b[e];
            ss += __shfl_xor(ss, 1); ss += __shfl_xor(ss, 2); ss += __shfl_xor(ss, 4);
            const float rstd = rsqrtf(ss * (1.f / 128.f) + EPS);
#pragma unroll
            for (int e = 0; e < 8; ++e) { a[e] = a[e] * rstd * gn[e]; b[e] = b[e] * rstd * gn[8 + e]; }
            *(u32x4*)np = pack8(a); *(u32x4*)(np + 8) = pack8(b);
            float x[8]; unpack8(wr, x);
            float s2 = 0.f;
#pragma unroll
            for (int e = 0; e < 8; ++e) s2 += x[e] * x[e];
            s2 += __shfl_xor(s2, 1); s2 += __shfl_xor(s2, 2); s2 += __shfl_xor(s2, 4);
            const float rs2 = rsqrtf(s2 * (1.f / 64.f) + EPS);
#pragma unroll
            for (int e = 0; e < 8; ++e) { const float xn = x[e] * rs2 * gr[e]; const float px = __shfl_xor(xn, 4); float cs, sn; rope_cs(pos, inv8[e], cs, sn);
                x[e] = ((seg < 4) ? (xn * cs - px * sn) : (xn * cs + px * sn)) * QSCALE; }
            *(u32x4*)rp = pack8(x);
            float cv[8]; unpack8(wc, cv);
            float s3 = 0.f;
#pragma unroll
            for (int e = 0; e < 8; ++e) s3 += cv[e] * cv[e];
            const float rs3 = rsqrtf(wave_sum(s3) * (1.f / 512.f) + EPS);
#pragma unroll
            for (int e = 0; e < 8; ++e) cv[e] = cv[e] * rs3 * gc8[e];
            *(u32x4*)cp = pack8(cv);
            { float xk = bf2f(wk); const float rs4 = rsqrtf(wave_sum(xk * xk) * (1.f / 64.f) + EPS); xk = xk * rs4 * kr_g;
              float cs, sn; rope_cs(pos, inv1, cs, sn);
              const float px = __shfl_xor(xk, 32); row[C_KR + lane] = f2bf((lane < 32) ? (xk * cs - px * sn) : (xk * cs + px * sn)); }
            if (lane < 8) BETA[(size_t)m * 8 + lane] = 1.f / (1.f + expf(-bf2f(wba)));
            else if (lane < 16) { const int hh = lane - 8; const float z = bf2f(wba) + dt_bias[hh]; const float sp = (z > 20.f) ? z : log1pf(expf(z)); G[(size_t)m * 8 + hh] = -expf(a_log[hh]) * sp; }
        }
    }
    const float* convw = (const float*)P.in[5];
    bf16_t* QA = (bf16_t*)P.out;
    for (int it = gw; it < (MROWS / 16) * 6; it += NGW) {
        const int run = it / 6, gg = it % 6, m0 = run * 16, s0 = m0 & 2047, c = gg * 512 + 8 * lane;
        float w0[8], w1[8], w2[8], w3[8];
#pragma unroll
        for (int e = 0; e < 8; e += 4) { *(f32x4*)(w0 + e) = *(const f32x4*)(convw + 0 * 3072 + c + e); *(f32x4*)(w1 + e) = *(const f32x4*)(convw + 1 * 3072 + c + e);
                                         *(f32x4*)(w2 + e) = *(const f32x4*)(convw + 2 * 3072 + c + e); *(f32x4*)(w3 + e) = *(const f32x4*)(convw + 3 * 3072 + c + e); }
        const bf16_t* src = proj + (size_t)m0 * LDP + c;
        float h1[8], h2[8], h3[8];
        if (s0 != 0) { unpack8(*(const u32x4*)(src - (size_t)1 * LDP), h1); unpack8(*(const u32x4*)(src - (size_t)2 * LDP), h2); unpack8(*(const u32x4*)(src - (size_t)3 * LDP), h3); }
        else {
#pragma unroll
            for (int e = 0; e < 8; ++e) { h1[e] = 0.f; h2[e] = 0.f; h3[e] = 0.f; } }
        bf16_t* dst = QA + (size_t)(gg >> 1) * ((size_t)MROWS * 1024) + (size_t)m0 * 1024 + (gg & 1) * 512 + 8 * lane;
        const float post = (gg < 2) ? 0.08838834764831845f : 1.f;
#pragma unroll
        for (int tb = 0; tb < 2; ++tb) {
            u32x4 raw[8];
#pragma unroll
            for (int q = 0; q < 8; ++q) raw[q] = *(const u32x4*)(src + (size_t)(8 * tb + q) * LDP);
#pragma unroll
            for (int q = 0; q < 8; ++q) {
                float cur[8], y[8]; unpack8(raw[q], cur);
                float ss = 0.f;
#pragma unroll
                for (int e = 0; e < 8; ++e) { y[e] = silu_f(w3[e] * cur[e] + w2[e] * h1[e] + w1[e] * h2[e] + w0[e] * h3[e]); ss += y[e] * y[e]; }
                if (gg < 4) { ss += __shfl_xor(ss, 1); ss += __shfl_xor(ss, 2); ss += __shfl_xor(ss, 4); ss += __shfl_xor(ss, 8); const float sc = rsqrtf(ss + EPS) * post;
#pragma unroll
                    for (int e = 0; e < 8; ++e) y[e] *= sc; }
                *(u32x4*)(dst + (size_t)(8 * tb + q) * 1024) = pack8(y);
#pragma unroll
                for (int e = 0; e < 8; ++e) { h3[e] = h2[e]; h2[e] = h1[e]; h1[e] = cur[e]; }
            }
        }
    }
}

constexpr int SOLVE_NOPS = 528, SOLVE_R = 8, SOLVE_D = 6;
struct SolveOps { unsigned char j[SOLVE_NOPS + SOLVE_R], q[SOLVE_NOPS + SOLVE_R]; };
constexpr SolveOps make_solve_ops() { SolveOps o{}; int t = 0; for (int j = 0; j < 63; ++j) for (int q = (j + 1) >> 2; q < 16; ++q) { o.j[t] = (unsigned char)j; o.q[t] = (unsigned char)q; ++t; } return o; }
constexpr SolveOps SOPS = make_solve_ops();
template <int T, int END> struct SolveStep {
    static __device__ __forceinline__ void run(f32x2 (&r)[32], f32x4 (&buf)[SOLVE_R], const LAS f32x4* Atv) {
        constexpr int TL = T + SOLVE_D;
        if constexpr (TL < END) buf[TL % SOLVE_R] = Atv[SOPS.j[TL] * 16 + SOPS.q[TL]];
        __builtin_amdgcn_sched_barrier(0);
        constexpr int j = SOPS.j[T], q = SOPS.q[T];
        const float xj = r[j >> 1][j & 1]; const f32x2 x2 = {xj, xj}; const f32x4 a = buf[T % SOLVE_R];
        r[2 * q] = r[2 * q] - (f32x2){a[0], a[1]} * x2; r[2 * q + 1] = r[2 * q + 1] - (f32x2){a[2], a[3]} * x2;
        __builtin_amdgcn_sched_barrier(0);
        SolveStep<T + 1, END>::run(r, buf, Atv);
    }
};
template <int END> struct SolveStep<END, END> { static __device__ __forceinline__ void run(f32x2 (&)[32], f32x4 (&)[SOLVE_R], const LAS f32x4*) {} };

__device__ __forceinline__ void delta_prep(const Params& P, LAS unsigned char* lds) {
    unsigned char* ws = P.ws;
    int tid = threadIdx.x; asm volatile("" : "+v"(tid));
    const int wave = __builtin_amdgcn_readfirstlane(tid >> 6), lane = tid & 63, sub = wave >> 2, tid_s = tid & 255, wv = wave & 3, fr = lane & 15, fq = lane >> 4;
    bf16_t* QA = (bf16_t*)P.out; bf16_t* KA = QA + (size_t)MROWS * 1024; bf16_t* VA = KA + (size_t)MROWS * 1024; bf16_t* WB = VA + (size_t)MROWS * 1024;
    const float* G = (const float*)(ws + WS_G); const float* BETA = (const float*)(ws + WS_BETA); bf16_t* QKM = (bf16_t*)(ws + WS_QKM); float* GL = (float*)(ws + WS_GL);
    LAS unsigned char* base = lds + sub * 61440;
    LAS bf16_t* Ks = (LAS bf16_t*)base; LAS bf16_t* Qs = (LAS bf16_t*)(base + 17408); LAS float* At = (LAS float*)(base + 34816);
    LAS float* gcs = (LAS float*)(base + 51200); LAS float* betas = (LAS float*)(base + 51456); LAS float* bes = (LAS float*)(base + 51712);
    LAS bf16_t* QKs = (LAS bf16_t*)(base + 51968);
    for (int unit = blockIdx.x; unit < 2048; unit += gridDim.x) {
        const int ch = unit * 2 + sub, n = ch & 31, bh = ch >> 5, h = bh & 7, b = bh >> 3, m0 = b * 2048 + n * 64;
#pragma unroll
        for (int i = 0; i < 4; ++i) { const int p = tid_s + 256 * i, row = p >> 4, c = p & 15; const size_t go = (size_t)(m0 + row) * 1024 + h * 128 + c * 8;
            *(LAS u32x4*)(Ks + row * 136 + c * 8) = *(const u32x4*)(KA + go); *(LAS u32x4*)(Qs + row * 136 + c * 8) = *(const u32x4*)(QA + go); }
        if (wv == 0) { float g = G[(size_t)(m0 + lane) * 8 + h] * LOG2E;
#pragma unroll
            for (int o = 1; o < 64; o <<= 1) { const float t = __shfl_up(g, o); if (lane >= o) g += t; }
            const float be = BETA[(size_t)(m0 + lane) * 8 + h];
            gcs[lane] = g; betas[lane] = be; bes[lane] = be * __builtin_amdgcn_exp2f(g); if (lane == 63) GL[ch] = __builtin_amdgcn_exp2f(g); }
        __syncthreads();
        { const int ti = wv; bf16x8 ak[4], aq[4];
#pragma unroll
          for (int ks = 0; ks < 4; ++ks) { ak[ks] = *(const LAS bf16x8*)(Ks + (16 * ti + fr) * 136 + 32 * ks + fq * 8); aq[ks] = *(const LAS bf16x8*)(Qs + (16 * ti + fr) * 136 + 32 * ks + fq * 8); }
          f32x4 gi, bi;
#pragma unroll
          for (int j = 0; j < 4; ++j) { gi[j] = gcs[16 * ti + fq * 4 + j]; bi[j] = betas[16 * ti + fq * 4 + j]; }
#pragma unroll
          for (int tj = 0; tj < 4; ++tj) {
              f32x4 ck = {0.f, 0.f, 0.f, 0.f}, cq = {0.f, 0.f, 0.f, 0.f};
              if (tj <= ti) {
#pragma unroll
                  for (int ks = 0; ks < 4; ++ks) { const bf16x8 bk = *(const LAS bf16x8*)(Ks + (16 * tj + fr) * 136 + 32 * ks + fq * 8);
                      ck = __builtin_amdgcn_mfma_f32_16x16x32_bf16(ak[ks], bk, ck, 0, 0, 0); cq = __builtin_amdgcn_mfma_f32_16x16x32_bf16(aq[ks], bk, cq, 0, 0, 0); } }
              const int jj = 16 * tj + fr; const float gj = gcs[jj]; f32x4 av; float qv[4];
#pragma unroll
              for (int j = 0; j < 4; ++j) { const int i = 16 * ti + fq * 4 + j; const float dec = (i >= jj) ? __builtin_amdgcn_exp2f(gi[j] - gj) : 0.f;
                  av[j] = (i > jj) ? bi[j] * ck[j] * dec : 0.f; qv[j] = cq[j] * dec; }
              *(LAS f32x4*)(At + jj * 64 + 16 * ti + fq * 4) = av;
#pragma unroll
              for (int j = 0; j < 4; ++j) QKs[(16 * ti + fq * 4 + j) * 72 + jj] = f2bf(qv[j]);
          } }
        u32x4 vreg[4];
        const float gl = gcs[63];
#pragma unroll
        for (int i = 0; i < 4; ++i) { const int p = tid_s + 256 * i, row = p >> 4, c = p & 15; const size_t go = (size_t)(m0 + row) * 1024 + h * 128 + c * 8;
            vreg[i] = *(const u32x4*)(VA + go);
            const u32x4 q = *(const LAS u32x4*)(Qs + row * 136 + c * 8); const float e = __builtin_amdgcn_exp2f(gcs[row]); u32x4 o;
            o.x = pk2(bflo(q.x) * e, bfhi(q.x) * e); o.y = pk2(bflo(q.y) * e, bfhi(q.y) * e); o.z = pk2(bflo(q.z) * e, bfhi(q.z) * e); o.w = pk2(bflo(q.w) * e, bfhi(q.w) * e);
            *(u32x4*)(QA + go) = o; }
#pragma unroll
        for (int i = 0; i < 4; ++i) { const int p = tid_s + 256 * i, dk = p & 127, j0 = (p >> 7) * 8; float v[8];
#pragma unroll
            for (int e = 0; e < 8; ++e) v[e] = bf2f(Ks[(j0 + e) * 136 + dk]) * __builtin_amdgcn_exp2f(gl - gcs[j0 + e]);
            u32x4 o; o.x = pk2(v[0], v[1]); o.y = pk2(v[2], v[3]); o.z = pk2(v[4], v[5]); o.w = pk2(v[6], v[7]);
            *(u32x4*)(KA + (size_t)(m0 + (dk >> 1)) * 1024 + h * 128 + (dk & 1) * 64 + j0) = o; }
        __syncthreads();
#pragma unroll
        for (int i = 0; i < 4; ++i) { const int p = tid_s + 256 * i, row = p >> 4, c = p & 15; *(LAS u32x4*)(Qs + row * 136 + c * 8) = vreg[i]; }
#pragma unroll
        for (int i = 0; i < 2; ++i) { const int p = tid_s + 256 * i, row = p >> 3, c8 = p & 7; *(u32x4*)(QKM + (size_t)ch * 4096 + row * 64 + c8 * 8) = *(const LAS u32x4*)(QKs + row * 72 + c8 * 8); }
        __syncthreads();
        { const int c = tid_s; LAS bf16_t* rp = Ks + (c >> 7) * 8704 + (c & 127); const LAS float* sp = (c >= 128) ? betas : bes;
          int zv = 0; asm volatile("" : "+v"(zv)); const LAS f32x4* Atv = (const LAS f32x4*)At + zv;
          f32x2 r[32];
#pragma unroll
          for (int i = 0; i < 64; ++i) r[i >> 1][i & 1] = bf2f(rp[i * 136]) * sp[i];
          f32x4 buf[SOLVE_R];
#pragma unroll
          for (int t = 0; t < SOLVE_D; ++t) buf[t] = Atv[SOPS.j[t] * 16 + SOPS.q[t]];
          SolveStep<0, SOLVE_NOPS>::run(r, buf, Atv);
#pragma unroll
          for (int i = 0; i < 64; ++i) rp[i * 136] = f2bf(r[i >> 1][i & 1]); }
        __syncthreads();
#pragma unroll
        for (int i = 0; i < 4; ++i) { const int p = tid_s + 256 * i, row = p >> 4, c = p & 15; const size_t go = (size_t)(m0 + row) * 1024 + h * 128 + c * 8;
            *(u32x4*)(WB + go) = *(const LAS u32x4*)(Ks + row * 136 + c * 8); *(u32x4*)(VA + go) = *(const LAS u32x4*)(Qs + row * 136 + c * 8); }
        __syncthreads();
    }
}

__device__ __forceinline__ void delta_scan(const Params& P, LAS unsigned char* lds) {
    unsigned char* ws = P.ws;
    int tid = threadIdx.x; asm volatile("" : "+v"(tid));
    const int wave = __builtin_amdgcn_readfirstlane(tid >> 6), lane = tid & 63, fr = lane & 15, fq = lane >> 4;
    const bf16_t* QA = (const bf16_t*)P.out; const bf16_t* KA = QA + (size_t)MROWS * 1024; const bf16_t* UA = KA + (size_t)MROWS * 1024; const bf16_t* WB = UA + (size_t)MROWS * 1024;
    const bf16_t* QKM = (const bf16_t*)(ws + WS_QKM); const float* GL = (const float*)(ws + WS_GL); bf16_t* proj = (bf16_t*)(ws + WS_PROJ);
    const float* ogain = (const float*)P.in[8];
    LAS bf16_t* Ws = (LAS bf16_t*)lds; LAS bf16_t* Qs = (LAS bf16_t*)(lds + 17408); LAS bf16_t* Kt = (LAS bf16_t*)(lds + 34816); LAS bf16_t* QKs = (LAS bf16_t*)(lds + 53248);
    LAS bf16_t* Us = (LAS bf16_t*)(lds + 62464); LAS bf16_t* St = (LAS bf16_t*)(lds + 79872); LAS bf16_t* VNt = (LAS bf16_t*)(lds + 114688); LAS float* SSQ = (LAS float*)(lds + 133120);
    const int it = wave >> 1, dvq = wave & 1;
    for (int unit = blockIdx.x; unit < 128; unit += gridDim.x) {
        const int bh = unit, h = bh & 7, b = bh >> 3;
        f32x4 sacc[8];
#pragma unroll
        for (int d = 0; d < 8; ++d) sacc[d] = (f32x4){0.f, 0.f, 0.f, 0.f};
        float og[4];
#pragma unroll
        for (int d = 0; d < 4; ++d) og[d] = ogain[16 * (4 * dvq + d) + fr];
        u32x4 rw[2], rq[2], rk[2], ru[2], rqk;
#define SCAN_LOAD(nn) do { const int m0_ = b * 2048 + (nn) * 64; const size_t ch_ = (size_t)bh * 32 + (nn); \
            _Pragma("unroll") for (int i = 0; i < 2; ++i) { const int p = tid + 512 * i, row = p >> 4, c = p & 15; const size_t go = (size_t)(m0_ + row) * 1024 + h * 128 + c * 8; rw[i] = *(const u32x4*)(WB + go); rq[i] = *(const u32x4*)(QA + go); ru[i] = *(const u32x4*)(UA + go); \
                const int dk = p >> 3, c8 = p & 7; rk[i] = *(const u32x4*)(KA + (size_t)(m0_ + (dk >> 1)) * 1024 + h * 128 + (dk & 1) * 64 + c8 * 8); } \
            { const int row = tid >> 3, c8 = tid & 7; rqk = *(const u32x4*)(QKM + ch_ * 4096 + row * 64 + c8 * 8); } } while (0)
#define SCAN_STORE() do { \
            _Pragma("unroll") for (int i = 0; i < 2; ++i) { const int p = tid + 512 * i, row = p >> 4, c = p & 15; *(LAS u32x4*)(Ws + row * 136 + c * 8) = rw[i]; *(LAS u32x4*)(Qs + row * 136 + c * 8) = rq[i]; *(LAS u32x4*)(Us + row * 136 + c * 8) = ru[i]; \
                const int dk = p >> 3, c8 = p & 7; *(LAS u32x4*)(Kt + dk * 72 + c8 * 8) = rk[i]; } \
            { const int row = tid >> 3, c8 = tid & 7; *(LAS u32x4*)(QKs + row * 72 + c8 * 8) = rqk; } } while (0)
        SCAN_LOAD(0);
        for (int n = 0; n < 32; ++n) {
            const int m0 = b * 2048 + n * 64;
            SCAN_STORE();
#pragma unroll
            for (int d = 0; d < 8; ++d) { u32x2 w; w.x = pk2(sacc[d][0], sacc[d][1]); w.y = pk2(sacc[d][2], sacc[d][3]); *(LAS u32x2*)(St + (16 * d + fr) * 136 + 16 * wave + fq * 4) = w; }
            const float gl = GL[bh * 32 + n];
            __syncthreads();
            if (n + 1 < 32) SCAN_LOAD(n + 1);
            bf16_t zr[4][4];
#pragma unroll
            for (int d = 0; d < 4; ++d)
#pragma unroll
                for (int j = 0; j < 4; ++j) zr[d][j] = proj[(size_t)(m0 + 16 * it + fq * 4 + j) * LDP + C_Z + h * 128 + 16 * (4 * dvq + d) + fr];
            f32x4 a1[4], a2[4];
#pragma unroll
            for (int d = 0; d < 4; ++d) { a1[d] = (f32x4){0.f, 0.f, 0.f, 0.f}; a2[d] = (f32x4){0.f, 0.f, 0.f, 0.f}; }
#pragma unroll
            for (int ks = 0; ks < 4; ++ks) { const bf16x8 wf = *(const LAS bf16x8*)(Ws + (16 * it + fr) * 136 + 32 * ks + fq * 8), qf = *(const LAS bf16x8*)(Qs + (16 * it + fr) * 136 + 32 * ks + fq * 8);
#pragma unroll
                for (int d = 0; d < 4; ++d) { const bf16x8 sf = *(const LAS bf16x8*)(St + (16 * (4 * dvq + d) + fr) * 136 + 32 * ks + fq * 8);
                    a1[d] = __builtin_amdgcn_mfma_f32_16x16x32_bf16(wf, sf, a1[d], 0, 0, 0); a2[d] = __builtin_amdgcn_mfma_f32_16x16x32_bf16(qf, sf, a2[d], 0, 0, 0); } }
#pragma unroll
            for (int d = 0; d < 4; ++d) { const int dv = 16 * (4 * dvq + d) + fr; float vn[4];
#pragma unroll
                for (int j = 0; j < 4; ++j) vn[j] = bf2f(Us[(16 * it + fq * 4 + j) * 136 + dv]) - a1[d][j];
                u32x2 w; w.x = pk2(vn[0], vn[1]); w.y = pk2(vn[2], vn[3]); *(LAS u32x2*)(VNt + dv * 72 + 16 * it + fq * 4) = w; }
            __syncthreads();
#pragma unroll
            for (int d = 0; d < 8; ++d) sacc[d] = sacc[d] * gl;
#pragma unroll
            for (int k2 = 0; k2 < 2; ++k2) { const bf16x8 qkf = *(const LAS bf16x8*)(QKs + (16 * it + fr) * 72 + 32 * k2 + fq * 8), kf = *(const LAS bf16x8*)(Kt + (16 * wave + fr) * 72 + 32 * k2 + fq * 8);
#pragma unroll
                for (int d = 0; d < 8; ++d) { const bf16x8 vf = *(const LAS bf16x8*)(VNt + (16 * d + fr) * 72 + 32 * k2 + fq * 8);
                    sacc[d] = __builtin_amdgcn_mfma_f32_16x16x32_bf16(kf, vf, sacc[d], 0, 0, 0);
                    if ((d >> 2) == dvq) a2[d & 3] = __builtin_amdgcn_mfma_f32_16x16x32_bf16(qkf, vf, a2[d & 3], 0, 0, 0); } }
            float ssq[4];
#pragma unroll
            for (int j = 0; j < 4; ++j) { float t = 0.f;
#pragma unroll
                for (int d = 0; d < 4; ++d) t += a2[d][j] * a2[d][j];
                t += __shfl_xor(t, 1); t += __shfl_xor(t, 2); t += __shfl_xor(t, 4); t += __shfl_xor(t, 8); ssq[j] = t; }
            if (fr == 0) {
#pragma unroll
                for (int j = 0; j < 4; ++j) SSQ[(16 * it + fq * 4 + j) * 2 + dvq] = ssq[j]; }
            __syncthreads();
#pragma unroll
            for (int j = 0; j < 4; ++j) { const int row = 16 * it + fq * 4 + j; const float rstd = rsqrtf((SSQ[row * 2] + SSQ[row * 2 + 1]) * (1.f / 128.f) + EPS);
#pragma unroll
                for (int d = 0; d < 4; ++d) proj[(size_t)(m0 + row) * LDP + C_Q + h * 128 + 16 * (4 * dvq + d) + fr] = f2bf(a2[d][j] * rstd * og[d] * silu_f(bf2f(zr[d][j]))); }
        }
        __syncthreads();
#undef SCAN_LOAD
#undef SCAN_STORE
    }
}

__device__ __forceinline__ void mla_attention(const Params& P, LAS unsigned char* lds) {
    unsigned char* ws = P.ws;
    int tid = threadIdx.x; asm volatile("" : "+v"(tid));
    const int wave = __builtin_amdgcn_readfirstlane(tid >> 6), lane = tid & 63, fr = lane & 15, fq = lane >> 4;
    bf16_t* proj = (bf16_t*)(ws + WS_PROJ); const bf16_t* KN = (const bf16_t*)(ws + WS_ACT); const bf16_t* VT = KN + (size_t)MROWS * 1024;
    const int kkey = tid >> 3, kseg = tid & 7, vdv = tid >> 2, vseg = tid & 3;
    unsigned* qctr = (unsigned*)(ws + WS_CTL + 128 * 1024);
    volatile LAS unsigned* qslot = (volatile LAS unsigned*)(lds + 139264);
    const bool stat = (gridDim.x == 256);
    for (int iter = 0;; ++iter) {
        int qi, bh;
        if (stat) { const bool sc = (int)blockIdx.x < 128; if (iter >= (sc ? 2 : 6)) break; bh = (int)blockIdx.x & 127;
            qi = sc ? (iter == 0 ? 7 : 4) : (iter == 0 ? 6 : iter == 1 ? 5 : iter == 2 ? 3 : iter == 3 ? 2 : iter == 4 ? 1 : 0); }
        else {
            if (tid == 0) qslot[0] = __hip_atomic_fetch_add(qctr, 1u, __ATOMIC_RELAXED, __HIP_MEMORY_SCOPE_AGENT);
            __syncthreads();
            const int L = (int)qslot[0];
            if (L >= 1024) break;
            qi = 7 - (L >> 7); bh = L & 127; }
        const int h = bh & 7, b = bh >> 3;
        const int q0 = qi * 256, ntiles = 4 * (qi + 1);
        bf16x8 qf[2][6];
#pragma unroll
        for (int m = 0; m < 2; ++m)
#pragma unroll
            for (int ks = 0; ks < 6; ++ks) qf[m][ks] = *(const bf16x8*)(proj + (size_t)(b * 2048 + q0 + 32 * wave + 16 * m + fr) * LDP + C_MQ + h * 192 + 32 * ks + fq * 8);
        f32x4 accO[2][8];
#pragma unroll
        for (int m = 0; m < 2; ++m)
#pragma unroll
            for (int d = 0; d < 8; ++d) accO[m][d] = (f32x4){0.f, 0.f, 0.f, 0.f};
        float mrow[2] = {-INFINITY, -INFINITY}, lsum[2] = {0.f, 0.f};
        u32x4 rk0, rk1, rkr, rv0, rv1;
#define ATT_LOAD(kt) do { const size_t krow = (size_t)(b * 2048 + (kt) * 64 + kkey); const bf16_t* kp = KN + krow * 1024 + h * 128 + 16 * kseg; rk0 = *(const u32x4*)kp; rk1 = *(const u32x4*)(kp + 8); \
            rkr = *(const u32x4*)(proj + krow * LDP + C_KR + 8 * kseg); const bf16_t* vp = VT + ((size_t)bh * 128 + vdv) * 2048 + (kt) * 64 + 16 * vseg; rv0 = *(const u32x4*)vp; rv1 = *(const u32x4*)(vp + 8); } while (0)
#define ATT_STORE(buf) do { LAS bf16_t* Kb = (LAS bf16_t*)(lds + (buf) * 25600); LAS bf16_t* Vb = (LAS bf16_t*)(lds + 51200 + (buf) * 18432); \
            float f[16]; f[0] = bflo(rk0.x); f[1] = bfhi(rk0.x); f[2] = bflo(rk0.y); f[3] = bfhi(rk0.y); f[4] = bflo(rk0.z); f[5] = bfhi(rk0.z); f[6] = bflo(rk0.w); f[7] = bfhi(rk0.w); \
            f[8] = bflo(rk1.x); f[9] = bfhi(rk1.x); f[10] = bflo(rk1.y); f[11] = bfhi(rk1.y); f[12] = bflo(rk1.z); f[13] = bfhi(rk1.z); f[14] = bflo(rk1.w); f[15] = bfhi(rk1.w); \
            float ss = 0.f; _Pragma("unroll") for (int e = 0; e < 16; ++e) ss += f[e] * f[e]; \
            ss += __shfl_xor(ss, 1); ss += __shfl_xor(ss, 2); ss += __shfl_xor(ss, 4); const float rs = rsqrtf(ss * (1.f / 128.f) + EPS); \
            u32x4 o0, o1; o0.x = pk2(f[0] * rs, f[1] * rs); o0.y = pk2(f[2] * rs, f[3] * rs); o0.z = pk2(f[4] * rs, f[5] * rs); o0.w = pk2(f[6] * rs, f[7] * rs); \
            o1.x = pk2(f[8] * rs, f[9] * rs); o1.y = pk2(f[10] * rs, f[11] * rs); o1.z = pk2(f[12] * rs, f[13] * rs); o1.w = pk2(f[14] * rs, f[15] * rs); \
            *(LAS u32x4*)(Kb + kkey * 200 + 16 * kseg) = o0; *(LAS u32x4*)(Kb + kkey * 200 + 16 * kseg + 8) = o1; *(LAS u32x4*)(Kb + kkey * 200 + 128 + 8 * kseg) = rkr; \
            *(LAS u32x4*)(Vb + vdv * 72 + 16 * vseg) = rv0; *(LAS u32x4*)(Vb + vdv * 72 + 16 * vseg + 8) = rv1; } while (0)
        ATT_LOAD(0); ATT_STORE(0);
        __syncthreads();
        for (int kt = 0; kt < ntiles; ++kt) {
            const bool more = (kt + 1 < ntiles);
            if (more) ATT_LOAD(kt + 1);
            const bool active = (kt < 4 * qi) || ((kt - 4 * qi) <= (wave >> 1));
            if (active) {
                const LAS bf16_t* Kb = (const LAS bf16_t*)(lds + (kt & 1) * 25600); const LAS bf16_t* Vb = (const LAS bf16_t*)(lds + 51200 + (kt & 1) * 18432);
                f32x4 accS[2][4];
#pragma unroll
                for (int m = 0; m < 2; ++m)
#pragma unroll
                    for (int n = 0; n < 4; ++n) accS[m][n] = (f32x4){0.f, 0.f, 0.f, 0.f};
#pragma unroll
                for (int ks = 0; ks < 6; ++ks)
#pragma unroll
                    for (int n = 0; n < 4; ++n) { const bf16x8 kf = *(const LAS bf16x8*)(Kb + (16 * n + fr) * 200 + 32 * ks + fq * 8);
                        accS[0][n] = __builtin_amdgcn_mfma_f32_16x16x32_bf16(kf, qf[0][ks], accS[0][n], 0, 0, 0); accS[1][n] = __builtin_amdgcn_mfma_f32_16x16x32_bf16(kf, qf[1][ks], accS[1][n], 0, 0, 0); }
                bf16x8 pf[2][2];
#pragma unroll
                for (int m = 0; m < 2; ++m) {
                    float mx = accS[m][0][0];
#pragma unroll
                    for (int n = 0; n < 4; ++n)
#pragma unroll
                        for (int j = 0; j < 4; ++j) mx = fmaxf(mx, accS[m][n][j]);
                    mx = fmaxf(mx, __shfl_xor(mx, 16)); mx = fmaxf(mx, __shfl_xor(mx, 32));
                    const float mnew = fmaxf(mrow[m], mx), alpha = __builtin_amdgcn_exp2f(mrow[m] - mnew); mrow[m] = mnew;
                    float ps = 0.f; float p[4][4];
#pragma unroll
                    for (int n = 0; n < 4; ++n)
#pragma unroll
                        for (int j = 0; j < 4; ++j) { p[n][j] = __builtin_amdgcn_exp2f(accS[m][n][j] - mnew); ps += p[n][j]; }
                    lsum[m] = lsum[m] * alpha + ps;
                    if (__any(alpha != 1.f)) {
#pragma unroll
                        for (int d = 0; d < 8; ++d) accO[m][d] = accO[m][d] * alpha; }
#pragma unroll
                    for (int t = 0; t < 2; ++t) { u32x4 w; w.x = pk2(p[2 * t][0], p[2 * t][1]); w.y = pk2(p[2 * t][2], p[2 * t][3]); w.z = pk2(p[2 * t + 1][0], p[2 * t + 1][1]); w.w = pk2(p[2 * t + 1][2], p[2 * t + 1][3]);
                        pf[m][t] = __builtin_bit_cast(bf16x8, w); }
                }
#pragma unroll
                for (int d = 0; d < 8; ++d)
#pragma unroll
                    for (int t = 0; t < 2; ++t) { const LAS bf16_t* vp = Vb + (16 * d + fr) * 72 + 32 * t + fq * 4; u32x4 w; const u32x2 lo = *(const LAS u32x2*)vp, hi = *(const LAS u32x2*)(vp + 16);
                        w.x = lo.x; w.y = lo.y; w.z = hi.x; w.w = hi.y; const bf16x8 vf = __builtin_bit_cast(bf16x8, w);
                        accO[0][d] = __builtin_amdgcn_mfma_f32_16x16x32_bf16(vf, pf[0][t], accO[0][d], 0, 0, 0); accO[1][d] = __builtin_amdgcn_mfma_f32_16x16x32_bf16(vf, pf[1][t], accO[1][d], 0, 0, 0); }
            }
            if (more) ATT_STORE((kt + 1) & 1);
            __syncthreads();
        }
#undef ATT_LOAD
#undef ATT_STORE
#pragma unroll
        for (int m = 0; m < 2; ++m) { float l = lsum[m]; l += __shfl_xor(l, 16); l += __shfl_xor(l, 32); const float il = 1.f / l;
            bf16_t* op = proj + (size_t)(b * 2048 + q0 + 32 * wave + 16 * m + fr) * LDP + C_K + h * 128 + fq * 4;
#pragma unroll
            for (int d = 0; d < 8; ++d) { u32x2 w; w.x = pk2(accO[m][d][0] * il, accO[m][d][1] * il); w.y = pk2(accO[m][d][2] * il, accO[m][d][3] * il); *(u32x2*)(op + 16 * d) = w; } }
    }
}

__device__ __forceinline__ void oa_finalize(const Params& P, int gw, int NGW, int lane) {
    bf16_t* proj = (bf16_t*)(P.ws + WS_PROJ); const float* gain = (const float*)P.in[8];
    const int h = lane >> 3, seg = lane & 7;
    float g[16];
#pragma unroll
    for (int e = 0; e < 16; ++e) g[e] = gain[16 * seg + e];
    for (int m = gw; m < MROWS; m += NGW) { bf16_t* op = proj + (size_t)m * LDP + C_Q + h * 128 + 16 * seg; const bf16_t* zp = proj + (size_t)m * LDP + C_Z + h * 128 + 16 * seg;
        const u32x4 o0 = *(const u32x4*)op, o1 = *(const u32x4*)(op + 8), z0 = *(const u32x4*)zp, z1 = *(const u32x4*)(zp + 8);
        float a[8], b[8], za[8], zb[8]; unpack8(o0, a); unpack8(o1, b); unpack8(z0, za); unpack8(z1, zb);
        float ss = 0.f;
#pragma unroll
        for (int e = 0; e < 8; ++e) ss += a[e] * a[e] + b[e] * b[e];
        ss += __shfl_xor(ss, 1); ss += __shfl_xor(ss, 2); ss += __shfl_xor(ss, 4);
        const float rstd = rsqrtf(ss * (1.f / 128.f) + EPS);
#pragma unroll
        for (int e = 0; e < 8; ++e) { a[e] = a[e] * rstd * g[e] * silu_f(za[e]); b[e] = b[e] * rstd * g[8 + e] * silu_f(zb[e]); }
        *(u32x4*)op = pack8(a); *(u32x4*)(op + 8) = pack8(b); }
}


#define XB_TMO      128
#define XB_XCNT(j)  (256  + 64 * (j))
#define XB_XSUB(j)  (1280 + 64 * (j))
#define XB_XGEN(j)  (2304 + 64 * (j))
#define XB_TOP      3328
#define XB_TOPGEN   3392
#define XCD_BAR_WORDS 3456
#define XB_SPIN_CAP (1u << 18)
__device__ __forceinline__ unsigned xb_ld(unsigned* p)              { return __hip_atomic_load(p, __ATOMIC_RELAXED, __HIP_MEMORY_SCOPE_AGENT); }
__device__ __forceinline__ unsigned xb_add(unsigned* p, unsigned v) { return __hip_atomic_fetch_add(p, v, __ATOMIC_RELAXED, __HIP_MEMORY_SCOPE_AGENT); }
__device__ __forceinline__ unsigned xb_xcc_id() { return (unsigned)__builtin_amdgcn_s_getreg((3 << 11) | 20) & 0xFu; }
#define XB_SPIN(cond, bar) do { unsigned _sp = 0; while (cond) { __builtin_amdgcn_s_sleep(1); \
    if ((++_sp & 255u) == 0u) { if (xb_ld(&(bar)[XB_TMO])) break; if (_sp > XB_SPIN_CAP) { atomicAdd(&(bar)[XB_TMO], 1u); break; } } } } while (0)
struct XcdBarrier { unsigned* bar; unsigned x; volatile LAS unsigned* st; };
__device__ __forceinline__ XcdBarrier xcd_barrier_post(unsigned* bar, volatile LAS unsigned* st) {
    XcdBarrier b; b.bar = bar; b.x = xb_xcc_id(); b.st = st;
    if (threadIdx.x == 0) (void)xb_add(&bar[XB_XCNT(b.x)], 1u);
    return b;
}
__device__ __forceinline__ void xcd_barrier_complete(unsigned* bar, unsigned x, unsigned& nloc, unsigned& nx) {
    const unsigned G = gridDim.x * gridDim.y * gridDim.z;
    unsigned sum, cnt, mine, sp = 0u;
    for (;;) {
        sum = 0u; cnt = 0u; mine = 0u;
#pragma unroll
        for (unsigned j = 0; j < 16; ++j) { const unsigned c = xb_ld(&bar[XB_XCNT(j)]); sum += c; cnt += (c > 0u) ? 1u : 0u; mine = (j == x) ? c : mine; }
        if (sum == G) break;
        __builtin_amdgcn_s_sleep(1);
        if ((++sp & 255u) == 0u) { if (xb_ld(&bar[XB_TMO])) break; if (sp > XB_SPIN_CAP) { atomicAdd(&bar[XB_TMO], 1u); break; } }
    }
    nloc = mine > 0u ? mine : 1u; nx = cnt > 0u ? cnt : 1u;
}
__device__ __forceinline__ void xcd_barrier(const XcdBarrier& b) {
    asm volatile("s_waitcnt vmcnt(0)" ::: "memory");
    __syncthreads();
    if (threadIdx.x == 0) {
        unsigned* bar = b.bar;
        __builtin_amdgcn_s_waitcnt(0);
        unsigned nloc = b.st[0], nx = b.st[1];
        if (nloc == 0u) { xcd_barrier_complete(bar, b.x, nloc, nx); b.st[0] = nloc; b.st[1] = nx; }
        const unsigned old = xb_add(&bar[XB_XSUB(b.x)], 1u);
        const unsigned gen = old / nloc;
        if (old + 1u == (gen + 1u) * nloc) {
            __builtin_amdgcn_fence(__ATOMIC_RELEASE, "agent");
            asm volatile("s_waitcnt vmcnt(0)" ::: "memory");
            const unsigned og = xb_add(&bar[XB_TOP], 1u);
            const unsigned tg = og / nx;
            if (og + 1u == (tg + 1u) * nx) xb_add(&bar[XB_TOPGEN], 1u);
            else XB_SPIN(xb_ld(&bar[XB_TOPGEN]) == tg, bar);
            __builtin_amdgcn_fence(__ATOMIC_ACQUIRE, "agent");
            xb_add(&bar[XB_XGEN(b.x)], 1u);
            asm volatile("s_waitcnt vmcnt(0)" ::: "memory");
        } else {
            XB_SPIN(xb_ld(&bar[XB_XGEN(b.x)]) == gen, bar);
            __builtin_amdgcn_fence(__ATOMIC_ACQUIRE, "agent");
            asm volatile("s_waitcnt vmcnt(0)" ::: "memory");
        }
    }
    __syncthreads();
}

__global__ void __launch_bounds__(512) fwd_megakernel(Params P) {
    extern __shared__ __attribute__((aligned(16))) unsigned char lds_raw[];
    LAS unsigned char* lds = (LAS unsigned char*)lds_raw;
    cg::grid_group grid = cg::this_grid();
    const int G = gridDim.x, NGW = G * 8;
#define PHASE_IDS() int tid_ = threadIdx.x; asm volatile("" : "+v"(tid_)); const int lane = tid_ & 63, wave = __builtin_amdgcn_readfirstlane(tid_ >> 6), gw = blockIdx.x * 8 + wave
    unsigned char* ws = P.ws;
    bf16_t* ACT = (bf16_t*)(ws + WS_ACT); bf16_t* PROJ = (bf16_t*)(ws + WS_PROJ);
    pg8::StaticOrder S;
    unsigned long long pt_acc = 0, pt_last = 0;
    volatile LAS unsigned* MISC = (volatile LAS unsigned*)(lds + 139264);
    if (threadIdx.x < 16) MISC[threadIdx.x] = 0u;
    __syncthreads();
    const XcdBarrier xbar = xcd_barrier_post((unsigned*)(ws + WS_CTL), MISC + 8);
#define GRID_BAR() xcd_barrier(xbar)

    PT_B(0);
    { PHASE_IDS(); p0_prologue(P, lds, gw, NGW, wave, lane); }
    if (P.ws == nullptr) grid.sync();
    GRID_BAR();
    PT_E(0);
    PT_B(1);
    { pg8::Gemm g{ACT, (const bf16_t*)(ws + WS_WIN), MROWS, LDP, 2048, 2048}; S.init(MROWS, LDP, G, blockIdx.x);
      Epi<EP_BF16> E{PROJ, nullptr, LDP, nullptr, nullptr, nullptr, nullptr}; pg8::gemm_phase(lds, g, S, E); }
    {
      const int nwg = (MROWS / 256) * (LDP / 256), rem = nwg % G; const bool is_short = (rem == 0) || ((int)blockIdx.x >= rem);
      const int nshort = (rem == 0) ? G : G - rem, sidx = (rem == 0) ? (int)blockIdx.x : (int)blockIdx.x - rem;
      if (is_short) { PHASE_IDS(); (void)gw; transpose_range(P, (LAS float*)(lds + wave * 16384), TR_IN_ITEMS, TR_ALL_ITEMS, sidx * 8 + wave, nshort * 8, lane); } }
    GRID_BAR();
    PT_E(1);
    PT_B(2);
    { PHASE_IDS(); p2_prep(P, gw, NGW, lane); }
    GRID_BAR();
    PT_E(2);
    PT_B(3);
    { pg8::Gemm g{PROJ + C_CKV, (const bf16_t*)(ws + WS_WKV), MROWS, 2048, 512, LDP}; S.init(MROWS, 2048, G, blockIdx.x);
      Epi<EP_KV> E{ACT, nullptr, 1024, nullptr, nullptr, ACT + (size_t)MROWS * 1024, nullptr}; pg8::gemm_phase(lds, g, S, E); }
    __syncthreads();
    PT_E(3);
    PT_B(4);
    delta_prep(P, lds);
    GRID_BAR();
    PT_E(4);
    PT_B(5);
    delta_scan(P, lds);
    __syncthreads();
    PT_E(5);
    PT_B(6);
    mla_attention(P, lds);
    GRID_BAR();
    PT_E(6);
    PT_B(8);
    { pg8::Gemm g{PROJ + C_Q, (const bf16_t*)(ws + WS_WA), MROWS, 2048, 1024, LDP}; S.init(MROWS, 2048, G, blockIdx.x);
      Epi<EP_YA> E{ACT, nullptr, DM, PROJ, nullptr, nullptr, nullptr}; pg8::gemm_phase(lds, g, S, E); }
    { pg8::Gemm g{PROJ + C_K, (const bf16_t*)(ws + WS_WB), MROWS, 2048, 1024, LDP}; S.init(MROWS, 2048, G, blockIdx.x);
      Epi<EP_YB> E{ACT, nullptr, DM, PROJ, nullptr, nullptr, nullptr}; pg8::gemm_phase(lds, g, S, E); }
    GRID_BAR();
    PT_E(8);
    PT_B(9);
    { pg8::Gemm g{ACT, (const bf16_t*)(ws + WS_WOUT), MROWS, 2048, 2048, 2048}; S.init(MROWS, 2048, G, blockIdx.x);
      Epi<EP_X1> E{(bf16_t*)(ws + WS_XB), nullptr, DM, nullptr, (const float*)P.in[0], nullptr, (float*)(ws + WS_SSQ1)}; pg8::gemm_phase(lds, g, S, E); }
    GRID_BAR();
    PT_E(9);
    PT_B(11);
    { pg8::Gemm g{(const bf16_t*)(ws + WS_XB), (const bf16_t*)(ws + WS_WUP), MROWS, DFF, 2048, 2048}; S.init(MROWS, DFF, G, blockIdx.x);
      Epi<EP_RELU2> E{PROJ, nullptr, DFF, nullptr, nullptr, nullptr, (float*)(ws + WS_SSQ1)}; pg8::gemm_phase(lds, g, S, E); }
    { pg8::Gemm g{(const bf16_t*)(ws + WS_PBF), (const bf16_t*)(ws + WS_WPLE), MROWS, 2048, 256, 256}; S.init(MROWS, 2048, G, blockIdx.x);
      Epi<EP_BF16> E{ACT, nullptr, DM, nullptr, nullptr, nullptr, nullptr}; pg8::gemm_phase(lds, g, S, E); }
    GRID_BAR();
    PT_E(11);
    PT_B(12);
    { pg8::Gemm g{PROJ, (const bf16_t*)(ws + WS_WDN), MROWS, 2048, DFF, DFF}; S.init(MROWS, 2048, G, blockIdx.x);
      Epi<EP_ACC> E{(bf16_t*)(ws + WS_XB), nullptr, DM, nullptr, nullptr, nullptr, (float*)(ws + WS_SSQ2)}; pg8::gemm_phase(lds, g, S, E); }
    GRID_BAR();
    PT_E(12);
    PT_B(14);
    { pg8::Gemm g{(const bf16_t*)(ws + WS_XB), (const bf16_t*)(ws + WS_WPG), MROWS, 2048, 2048, 2048}; S.init(MROWS, 2048, G, blockIdx.x);
      Epi<EP_PLE> E{nullptr, P.out, DM, ACT, nullptr, (bf16_t*)(ws + WS_XB), (float*)(ws + WS_SSQ2)}; pg8::gemm_phase(lds, g, S, E); }
    PT_E(14);
    if (PROBE_MASK != 0u && blockIdx.x == 0) { const unsigned long long t_end = __builtin_amdgcn_s_memrealtime() + (unsigned long long)PROBE_MULT * pt_acc;
        while (__builtin_amdgcn_s_memrealtime() < t_end) __builtin_amdgcn_s_sleep(8); }
}

extern "C" void kernel_launch(void* const* d_in, const int* in_sizes, int n_in, void* d_out, int out_size, void* d_ws, size_t ws_size, hipStream_t stream) {
    static int grid = 0;
    if (grid == 0) {
        if (n_in != 24 || out_size != MROWS * DM || ws_size < WS_END) { fprintf(stderr, "kernel_launch: unexpected shapes: n_in %d out %d ws %zu (need %zu)\n", n_in, out_size, ws_size, (size_t)WS_END); grid = -1; return; }
        int dev = 0, cus = 0, per_cu = 0;
        if (hipGetDevice(&dev) != hipSuccess || hipDeviceGetAttribute(&cus, hipDeviceAttributeMultiprocessorCount, dev) != hipSuccess) { grid = -1; return; }
        if (hipFuncSetAttribute((const void*)fwd_megakernel, hipFuncAttributeMaxDynamicSharedMemorySize, LDS_BYTES) != hipSuccess) { fprintf(stderr, "kernel_launch: hipFuncSetAttribute failed\n"); grid = -1; return; }
        if (hipOccupancyMaxActiveBlocksPerMultiprocessor(&per_cu, (const void*)fwd_megakernel, 512, LDS_BYTES) != hipSuccess || per_cu < 1) { fprintf(stderr, "kernel_launch: occupancy query gave %d\n", per_cu); per_cu = 1; }
        (void)hipGetLastError();
        grid = cus * per_cu;
        fprintf(stderr, "kernel_launch: grid %d (cus %d x %d), ws %zu\n", grid, cus, per_cu, ws_size);
    }
    if (grid < 0) return;
    Params p{};
    for (int i = 0; i < 24; ++i) p.in[i] = d_in[i];
    p.out = (float*)d_out; p.ws = (unsigned char*)d_ws;
    for (int i = 0; i < 32; ++i) p.ropeinv[i] = (float)pow(10000.0, -(double)i / 32.0);
    if (hipMemsetAsync((char*)d_ws + WS_CTL, 0, CTL_BYTES, stream) != hipSuccess) { fprintf(stderr, "kernel_launch: hipMemsetAsync failed\n"); return; }
    void* args[] = {&p};
    hipError_t e = hipLaunchCooperativeKernel((const void*)fwd_megakernel, dim3(grid), dim3(512), args, LDS_BYTES, stream);
    if (e != hipSuccess) fprintf(stderr, "kernel_launch: cooperative launch failed: %s (grid %d)\n", hipGetErrorString(e), grid);
}
```

```cpp
#include <hip/hip_runtime.h>
#include <hip/hip_cooperative_groups.h>
#include <cstdio>
#include <cstdint>
#include <cmath>
namespace cg = cooperative_groups;
#ifndef PROBE_MASK
#define PROBE_MASK 0u
#endif
#define PROBE_MULT 3
#define PT_B(bit) do { if ((PROBE_MASK >> (bit)) & 1u) { __builtin_amdgcn_s_waitcnt(0); pt_last = __builtin_amdgcn_s_memrealtime(); } } while (0)
#define PT_E(bit) do { if ((PROBE_MASK >> (bit)) & 1u) { __builtin_amdgcn_s_waitcnt(0); pt_acc += __builtin_amdgcn_s_memrealtime() - pt_last; } } while (0)

#define LAS __attribute__((address_space(3)))
typedef unsigned short bf16_t;
typedef short bf16x8 __attribute__((ext_vector_type(8)));
typedef float f32x4 __attribute__((ext_vector_type(4)));
typedef float f32x2 __attribute__((ext_vector_type(2)));
typedef unsigned u32x4 __attribute__((ext_vector_type(4)));
typedef unsigned u32x2 __attribute__((ext_vector_type(2)));

constexpr int NB = 16, SEQ = 2048, MROWS = NB * SEQ, DM = 2048, LDP = 10496, DFF = 8192, PLE = 256;
constexpr int C_Q = 0, C_K = 1024, C_V = 2048, C_Z = 3072, C_MQ = 4096, C_CKV = 5632, C_GA = 6144, C_GB = 8192, C_KR = 10240, C_BETA = 10304, C_ALPHA = 10312;
constexpr int D_IN = 10320;
constexpr float EPS = 1e-6f;
constexpr float LOG2E = 1.4426950408889634f;
constexpr size_t MiB = 1u << 20;
constexpr size_t WS_WIN = 0, WS_WKV = 41 * MiB, WS_WA = 43 * MiB, WS_WB = 47 * MiB, WS_WOUT = 51 * MiB, WS_WUP = 59 * MiB, WS_WDN = 91 * MiB, WS_WPG = 123 * MiB,
                 WS_WPLE = 131 * MiB, WS_PBF = 132 * MiB, WS_G = 148 * MiB, WS_BETA = 149 * MiB, WS_QKM = 150 * MiB, WS_ACT = 182 * MiB, WS_PROJ = 310 * MiB,
                 WS_GL = 966 * MiB, WS_CTL = 967 * MiB, WS_END = 968 * MiB;
constexpr size_t CTL_BYTES = 1 * MiB;
constexpr size_t WS_SSQ1 = WS_CTL + 256 * 1024, WS_SSQ2 = WS_CTL + 512 * 1024;
constexpr size_t WS_XB = WS_PROJ + 512 * MiB;
constexpr int LDS_BYTES = 147456;

__device__ __forceinline__ float bf2f(bf16_t v) { return __uint_as_float((unsigned)v << 16); }
__device__ __forceinline__ float bflo(unsigned w) { return __uint_as_float(w << 16); }
__device__ __forceinline__ float bfhi(unsigned w) { return __uint_as_float(w & 0xffff0000u); }
__device__ __forceinline__ unsigned pk2(float lo, float hi) { unsigned r; asm("v_cvt_pk_bf16_f32 %0, %1, %2" : "=v"(r) : "v"(lo), "v"(hi)); return r; }
__device__ __forceinline__ bf16_t f2bf(float f) { return (bf16_t)(pk2(f, 0.f) & 0xffffu); }
__device__ __forceinline__ float wave_sum(float v) {
#pragma unroll
    for (int o = 1; o < 64; o <<= 1) v += __shfl_xor(v, o);
    return v;
}
__device__ __forceinline__ float fast_sigmoid(float x) { return __builtin_amdgcn_rcpf(1.f + __builtin_amdgcn_exp2f(-x * LOG2E)); }
__device__ __forceinline__ float silu_f(float x) { return x * fast_sigmoid(x); }
#define LDS_WAIT() asm volatile("s_waitcnt lgkmcnt(0)" ::: "memory")

namespace pg8 {
constexpr int BM = 256, BK = 64, HALF = 128, HTB = HALF * BK * 2, STAGE_BYTES = 8 * HTB, NXCD = 8, WGM = 8;
__host__ __device__ __forceinline__ int lds_byte(int r, int c) { const int st = (r >> 4) * 2 + (c >> 5), rr = r & 15, cc = c & 31, ob = rr * 64 + cc * 2; return st * 1024 + (ob ^ (((ob >> 9) & 1) << 5)); }
__host__ __device__ __forceinline__ void stage_rc(int b, int& R, int& C) { const int st = b / 1024, sb = b % 1024, swz = sb ^ (((sb >> 9) & 1) << 5); R = (st >> 1) * 16 + swz / 64; C = (st & 1) * 32 + (swz % 64) / 2; }
__host__ __device__ __forceinline__ int perm32(int rho) { const int n = rho >> 4, i = rho & 15; return 8 * (i >> 2) + 4 * n + (i & 3); }
struct Unit { int pm, pn; };
struct Gemm { const bf16_t* A; const bf16_t* Bt; int M, N, K, lda; };
struct StaticOrder {
    int nM, nN, nwg, G, c;
    __device__ void init(int M, int N, int G_, int c_) { nM = M / BM; nN = N / BM; nwg = nM * nN; G = G_; c = c_; }
    __device__ bool next(int i, Unit& u) const {
        const long L = (long)i * G + c; if (L >= nwg) return false;
        int wgid = (int)L; { const int q = nwg / NXCD, r = nwg % NXCD, xcd = wgid % NXCD, off = wgid / NXCD; wgid = (xcd < r ? xcd * (q + 1) : r * (q + 1) + (xcd - r) * q) + off; }
        const int nig = WGM * nN, gid = wgid / nig, fm = gid * WGM, gsz = (nM - fm) < WGM ? (nM - fm) : WGM;
        u.pm = fm + ((wgid % nig) % gsz); u.pn = (wgid % nig) / gsz; return true;
    }
};
template <class Epi>
__device__ __forceinline__ void gemm_phase(LAS unsigned char* lds, const Gemm g, const StaticOrder& S, const Epi& E) {
    int tid = threadIdx.x; asm volatile("" : "+v"(tid));
    const int wid = __builtin_amdgcn_readfirstlane(tid >> 6), lane = tid & 63, wr = wid >> 2, wc = wid & 3, fr = lane & 15, fq = lane >> 4;
    const int K = g.K, nt = K / BK, lda = g.lda;
    unsigned voffA[2], voffB[2];
#pragma unroll
    for (int i = 0; i < 2; ++i) { int R, C; stage_rc(tid * 16 + i * 8192, R, C); const int Rb = ((R & ~31) + perm32(R & 31));
        voffA[i] = (unsigned)(R * lda + C) * 2u; voffB[i] = (unsigned)(Rb * K + C) * 2u; }
    const size_t kstep = (size_t)(BK * 2);
    const size_t hstepA = (size_t)HALF * lda * 2, tstepA = 2 * hstepA, hstepB = (size_t)HALF * K * 2, tstepB = 2 * hstepB;
    const unsigned ldsw = (unsigned)wid * 1024u;
    const int aoff = lds_byte(wr * 64 + fr, fq * 8), boff = lds_byte(wc * 32 + fr, fq * 8);
#define PG8_SA(b, h) (((b) * 2 + (h)) * HTB)
#define PG8_SB(b, h) ((4 + (b) * 2 + (h)) * HTB)
#define PG8_STAGE(bufoff, gbase, voff) do { _Pragma("unroll") for (int _i = 0; _i < 2; ++_i) \
        __builtin_amdgcn_global_load_lds((const unsigned*)((const char*)(gbase) + (voff)[_i]), (LAS unsigned*)(lds + (bufoff) + ldsw + _i * 8192), 16, 0, 0); } while (0)
#define PG8_LDA(dst, b, h) do { _Pragma("unroll") for (int m = 0; m < 4; ++m) _Pragma("unroll") for (int k = 0; k < 2; ++k) dst[m][k] = *(const LAS bf16x8*)(lds + PG8_SA(b, h) + aoff + m * 2048 + k * 1024); } while (0)
#define PG8_LDB(dst, b, h) do { _Pragma("unroll") for (int n = 0; n < 2; ++n) _Pragma("unroll") for (int k = 0; k < 2; ++k) dst[n][k] = *(const LAS bf16x8*)(lds + PG8_SB(b, h) + boff + n * 2048 + k * 1024); } while (0)
#define PG8_MMA(ai, bj, At, Bt) do { __builtin_amdgcn_s_setprio(1); _Pragma("unroll") for (int m = 0; m < 4; ++m) _Pragma("unroll") for (int n = 0; n < 2; ++n) _Pragma("unroll") for (int k = 0; k < 2; ++k) { \
        if constexpr (Epi::SWAP1 && (bj) == 1) acc[ai][bj][m][n] = __builtin_amdgcn_mfma_f32_16x16x32_bf16(At[m][k], Bt[n][k], acc[ai][bj][m][n], 0, 0, 0); \
        else acc[ai][bj][m][n] = __builtin_amdgcn_mfma_f32_16x16x32_bf16(Bt[n][k], At[m][k], acc[ai][bj][m][n], 0, 0, 0); } __builtin_amdgcn_s_setprio(0); } while (0)
#define PG8_WAIT_V(n) asm volatile("s_waitcnt vmcnt(" #n ")" ::: "memory")
#define PG8_WAIT_L(n) asm volatile("s_waitcnt lgkmcnt(" #n ")" ::: "memory")
#define PG8_BAR __builtin_amdgcn_s_barrier()
#define PG8_SCHED __builtin_amdgcn_sched_barrier(0)
    Unit cur, nxt; int ui = 0;
    if (!S.next(0, cur)) return;
    f32x4 acc[2][2][4][2];
#pragma unroll
    for (int a = 0; a < 2; ++a)
#pragma unroll
        for (int b = 0; b < 2; ++b)
#pragma unroll
            for (int m = 0; m < 4; ++m)
#pragma unroll
                for (int n = 0; n < 2; ++n) acc[a][b][m][n] = (f32x4){0.f, 0.f, 0.f, 0.f};
    bf16x8 At[4][2], B0[2][2], B1[2][2];
    const char* cA = (const char*)g.A + (size_t)cur.pm * tstepA; const char* cB = (const char*)g.Bt + (size_t)cur.pn * tstepB;
    PG8_STAGE(PG8_SB(0, 0), cB, voffB); PG8_STAGE(PG8_SB(0, 1), cB + hstepB, voffB); PG8_STAGE(PG8_SA(0, 0), cA, voffA); PG8_STAGE(PG8_SA(0, 1), cA + hstepA, voffA);
    if (wr == 1) PG8_BAR;
    PG8_WAIT_V(2); PG8_BAR;
    PG8_STAGE(PG8_SB(1, 0), cB + kstep, voffB); PG8_STAGE(PG8_SA(1, 0), cA + kstep, voffA); PG8_STAGE(PG8_SB(1, 1), cB + hstepB + kstep, voffB);
    PG8_WAIT_V(6); PG8_BAR;
    for (;;) {
        const bool has_next = S.next(ui + 1, nxt);
        const char* nA = has_next ? (const char*)g.A + (size_t)nxt.pm * tstepA : cA; const char* nB = has_next ? (const char*)g.Bt + (size_t)nxt.pn * tstepB : cB;
        for (int t = 0; t < nt; t += 2) {
            if constexpr (Epi::MID_T > 0) { if (t == Epi::MID_T) E.mid(acc, cur, wr, wc, fr, fq); }
            const bool last = (t == nt - 2);
            const char* a1 = cA + (size_t)(t + 1) * kstep;
            const char* a2 = last ? nA : cA + (size_t)(t + 2) * kstep; const char* b2 = last ? nB : cB + (size_t)(t + 2) * kstep;
            const char* a3 = a2 + kstep; const char* b3 = b2 + kstep;
            PG8_LDB(B0, 0, 0); PG8_LDB(B1, 0, 1); PG8_SCHED; PG8_LDA(At, 0, 0); PG8_STAGE(PG8_SA(1, 1), a1 + hstepA, voffA);
            PG8_WAIT_V(8); PG8_WAIT_L(0); PG8_BAR; PG8_MMA(0, 0, At, B0); PG8_MMA(0, 1, At, B1); PG8_BAR; PG8_SCHED;
            PG8_LDA(At, 0, 1); PG8_STAGE(PG8_SB(0, 0), b2, voffB); PG8_STAGE(PG8_SB(0, 1), b2 + hstepB, voffB); PG8_STAGE(PG8_SA(0, 0), a2, voffA);
            PG8_WAIT_V(8); PG8_WAIT_L(0); PG8_BAR; PG8_MMA(1, 0, At, B0); PG8_MMA(1, 1, At, B1); PG8_BAR; PG8_SCHED;
            PG8_LDB(B0, 1, 0); PG8_LDB(B1, 1, 1); PG8_SCHED; PG8_LDA(At, 1, 0); PG8_STAGE(PG8_SA(0, 1), a2 + hstepA, voffA);
            PG8_WAIT_V(8); PG8_WAIT_L(0); PG8_BAR; PG8_MMA(0, 0, At, B0); PG8_MMA(0, 1, At, B1); PG8_BAR; PG8_SCHED;
            PG8_LDA(At, 1, 1); PG8_STAGE(PG8_SB(1, 0), b3, voffB); PG8_STAGE(PG8_SB(1, 1), b3 + hstepB, voffB); PG8_STAGE(PG8_SA(1, 0), a3, voffA);
            PG8_WAIT_V(8); PG8_WAIT_L(0); PG8_BAR; PG8_MMA(1, 0, At, B0); PG8_MMA(1, 1, At, B1); PG8_BAR; PG8_SCHED;
        }
        if (wr == 0) PG8_BAR;
        E(acc, cur, wr, wc, fr, fq);
        if (!has_next) break;
#pragma unroll
        for (int a = 0; a < 2; ++a)
#pragma unroll
            for (int b = 0; b < 2; ++b)
#pragma unroll
                for (int m = 0; m < 4; ++m)
#pragma unroll
                    for (int n = 0; n < 2; ++n) acc[a][b][m][n] = (f32x4){0.f, 0.f, 0.f, 0.f};
        cur = nxt; cA = nA; cB = nB; ++ui;
        if (wr == 1) PG8_BAR;
    }
    PG8_WAIT_V(0);
    PG8_BAR;
#undef PG8_SA
#undef PG8_SB
#undef PG8_STAGE
#undef PG8_LDA
#undef PG8_LDB
#undef PG8_MMA
#undef PG8_WAIT_V
#undef PG8_WAIT_L
#undef PG8_BAR
#undef PG8_SCHED
}
}

enum { EP_BF16 = 0, EP_KV, EP_YA, EP_YB, EP_X1, EP_RELU2, EP_ACC, EP_F32, EP_PLE, EP_YAB };
__device__ __forceinline__ void store8bf(bf16_t* p, f32x4 a, f32x4 b) { u32x4 w; w.x = pk2(a[0], a[1]); w.y = pk2(a[2], a[3]); w.z = pk2(b[0], b[1]); w.w = pk2(b[2], b[3]); *(u32x4*)p = w; }
__device__ __forceinline__ void load8bf(const bf16_t* p, f32x4& a, f32x4& b) { const u32x4 w = *(const u32x4*)p; a = (f32x4){bflo(w.x), bfhi(w.x), bflo(w.y), bfhi(w.y)}; b = (f32x4){bflo(w.z), bfhi(w.z), bflo(w.w), bfhi(w.w)}; }
__device__ __forceinline__ f32x4 sig4(f32x4 v) { return (f32x4){fast_sigmoid(v[0]), fast_sigmoid(v[1]), fast_sigmoid(v[2]), fast_sigmoid(v[3])}; }
template <int MODE> struct Epi {
    static constexpr bool SWAP1 = (MODE == EP_KV);
    static constexpr int MID_T = (MODE == EP_YAB) ? 16 : 0;
    bf16_t* ob; float* of; int ldc; const bf16_t* gate; const float* res; bf16_t* vt; float* ssq;
    __device__ __forceinline__ void mid(f32x4 (&acc)[2][2][4][2], const pg8::Unit& u, int wr, int wc, int fr, int fq) const {
        int rowb = u.pm * 256 + wr * 64 + fr, col0 = u.pn * 256 + wc * 32 + 8 * fq;
        asm volatile("" : "+v"(rowb), "+v"(col0));
        u32x4 ga[2], gb[2];
        ga[0] = *(const u32x4*)(gate + (size_t)rowb * LDP + C_GA + col0); gb[0] = *(const u32x4*)(gate + (size_t)rowb * LDP + C_GB + col0);
#pragma unroll
        for (int st = 0; st < 16; ++st) {
            const int it = st >> 1, bj = st & 1, ai = it >> 2, m = it & 3;
            if (st + 1 < 16) { const int itn = (st + 1) >> 1, bjn = (st + 1) & 1; const size_t off = (size_t)(rowb + (itn >> 2) * 128 + (itn & 3) * 16) * LDP + col0 + bjn * 128;
                ga[(st + 1) & 1] = *(const u32x4*)(gate + off + C_GA); gb[(st + 1) & 1] = *(const u32x4*)(gate + off + C_GB); }
            f32x4 a0, a1, b0, b1; up8(ga[st & 1], a0, a1); up8(gb[st & 1], b0, b1);
#pragma unroll
            for (int e = 0; e < 4; ++e) {
                acc[ai][bj][m][0][e] *= (1.f + __builtin_amdgcn_exp2f(-b0[e] * LOG2E)) * __builtin_amdgcn_rcpf(1.f + __builtin_amdgcn_exp2f(-a0[e] * LOG2E));
                acc[ai][bj][m][1][e] *= (1.f + __builtin_amdgcn_exp2f(-b1[e] * LOG2E)) * __builtin_amdgcn_rcpf(1.f + __builtin_amdgcn_exp2f(-a1[e] * LOG2E)); }
            asm volatile("" ::: "memory");
        }
    }
    struct Pre { f32x4 f[2][2]; u32x4 g[2]; u32x4 y[2]; };
    __device__ __forceinline__ void preload(Pre& p, int row, int col0) const {
#pragma unroll
        for (int bj = 0; bj < 2; ++bj) { const int col = col0 + bj * 128;
            if constexpr (MODE == EP_YA) p.g[bj] = *(const u32x4*)(gate + (size_t)row * LDP + C_GA + col);
            else if constexpr (MODE == EP_YAB) p.g[bj] = *(const u32x4*)(gate + (size_t)row * LDP + C_GB + col);
            else if constexpr (MODE == EP_YB) { p.g[bj] = *(const u32x4*)(gate + (size_t)row * LDP + C_GB + col); p.y[bj] = *(const u32x4*)(ob + (size_t)row * DM + col); }
            else if constexpr (MODE == EP_X1) { const float* r = res + (size_t)row * DM + col; p.f[bj][0] = *(const f32x4*)r; p.f[bj][1] = *(const f32x4*)(r + 4); }
            else if constexpr (MODE == EP_ACC) p.y[bj] = *(const u32x4*)(ob + (size_t)row * DM + col);
            else if constexpr (MODE == EP_PLE) { p.y[bj] = *(const u32x4*)(vt + (size_t)row * DM + col); p.g[bj] = *(const u32x4*)(gate + (size_t)row * DM + col); }
        }
    }
    static __device__ __forceinline__ void up8(const u32x4 w, f32x4& a, f32x4& b) { a = (f32x4){bflo(w.x), bfhi(w.x), bflo(w.y), bfhi(w.y)}; b = (f32x4){bflo(w.z), bfhi(w.z), bflo(w.w), bfhi(w.w)}; }
    __device__ __forceinline__ void operator()(const f32x4 (&acc)[2][2][4][2], const pg8::Unit& u, int wr, int wc, int fr, int fq) const {
        const int rowb = u.pm * 256 + wr * 64 + fr, col0 = u.pn * 256 + wc * 32 + 8 * fq;
        float rs[8];
        if constexpr (MODE == EP_RELU2 || MODE == EP_PLE) {
#pragma unroll
            for (int it = 0; it < 8; ++it) rs[it] = ssq[rowb + (it >> 2) * 128 + (it & 3) * 16];
#pragma unroll
            for (int it = 0; it < 8; ++it) rs[it] = rsqrtf(rs[it] * (1.f / 2048.f) + EPS);
        }
        Pre pre[2];
        preload(pre[0], rowb, col0);
#pragma unroll
        for (int it = 0; it < 8; ++it) {
            const int ai = it >> 2, m = it & 3, row = rowb + ai * 128 + m * 16;
            if (it + 1 < 8) preload(pre[(it + 1) & 1], rowb + ((it + 1) >> 2) * 128 + ((it + 1) & 3) * 16, col0);
            const Pre& pp = pre[it & 1];
            float rsum = 0.f; const float rstd = (MODE == EP_RELU2 || MODE == EP_PLE) ? rs[it] : 1.f;
#pragma unroll
            for (int bj = 0; bj < 2; ++bj) {
                const int col = col0 + bj * 128;
                f32x4 v0 = acc[ai][bj][m][0], v1 = acc[ai][bj][m][1];
                if constexpr (MODE == EP_BF16) { store8bf(ob + (size_t)row * ldc + col, v0, v1); }
                else if constexpr (MODE == EP_RELU2) {
#pragma unroll
                    for (int e = 0; e < 4; ++e) { const float a = fmaxf(v0[e] * rstd, 0.f), b = fmaxf(v1[e] * rstd, 0.f); v0[e] = a * a; v1[e] = b * b; }
                    store8bf(ob + (size_t)row * ldc + col, v0, v1); }
                else if constexpr (MODE == EP_KV) {
                    if (bj == 0) store8bf(ob + (size_t)row * 1024 + u.pn * 128 + wc * 32 + 8 * fq, v0, v1);
                    else {
                        const int r0 = u.pm * 256 + ai * 128 + wr * 64 + m * 16 + 4 * fq, b = r0 >> 11, s = r0 & 2047;
                        bf16_t* base = vt + ((size_t)((b * 8 + u.pn) * 128 + wc * 32)) * 2048 + s;
                        u32x2 w0, w1; w0.x = pk2(v0[0], v0[1]); w0.y = pk2(v0[2], v0[3]); w1.x = pk2(v1[0], v1[1]); w1.y = pk2(v1[2], v1[3]);
                        *(u32x2*)(base + (size_t)pg8::perm32(fr) * 2048) = w0; *(u32x2*)(base + (size_t)pg8::perm32(16 + fr) * 2048) = w1; } }
                else if constexpr (MODE == EP_YA || MODE == EP_YAB) { f32x4 g0, g1; up8(pp.g[bj], g0, g1); store8bf(ob + (size_t)row * DM + col, sig4(g0) * v0, sig4(g1) * v1); }
                else if constexpr (MODE == EP_YB) { f32x4 g0, g1, a0, a1; up8(pp.g[bj], g0, g1); up8(pp.y[bj], a0, a1); store8bf(ob + (size_t)row * DM + col, a0 + sig4(g0) * v0, a1 + sig4(g1) * v1); }
                else if constexpr (MODE == EP_X1 || MODE == EP_ACC) { f32x4 r0, r1;
                    if constexpr (MODE == EP_X1) { r0 = pp.f[bj][0]; r1 = pp.f[bj][1]; } else up8(pp.y[bj], r0, r1);
                    const f32x4 x0 = r0 + v0, x1 = r1 + v1;
                    store8bf(ob + (size_t)row * DM + col, x0, x1);
                    rsum += (x0[0] * x0[0] + x0[1] * x0[1]) + (x0[2] * x0[2] + x0[3] * x0[3]) + (x1[0] * x1[0] + x1[1] * x1[1]) + (x1[2] * x1[2] + x1[3] * x1[3]); }
                else if constexpr (MODE == EP_F32) { float* o = of + (size_t)row * DM + col; *(f32x4*)o = v0; *(f32x4*)(o + 4) = v1; }
                else if constexpr (MODE == EP_PLE) { f32x4 p0, p1, x0, x1; up8(pp.g[bj], p0, p1); up8(pp.y[bj], x0, x1); float* o = of + (size_t)row * DM + col;
                    *(f32x4*)o = x0 + sig4(v0 * rstd) * p0; *(f32x4*)(o + 4) = x1 + sig4(v1 * rstd) * p1; }
            }
            if constexpr (MODE == EP_X1 || MODE == EP_ACC) { rsum += __shfl_xor(rsum, 16); rsum += __shfl_xor(rsum, 32);
                if (fq == 0) __hip_atomic_fetch_add(ssq + row, rsum, __ATOMIC_RELAXED, __HIP_MEMORY_SCOPE_AGENT); }
            asm volatile("" ::: "memory");
        }
    }
};

struct Params { const void* in[24]; float* out; unsigned char* ws; float ropeinv[32]; };

__device__ __forceinline__ int win_map(int n) {
    if (n < 4096) return n;
    if (n < 5632) return 4112 + (n - 4096);
    if (n < 6144) return 5648 + (n - 5632);
    if (n < 8192) return 6224 + (n - 6144);
    if (n < 10240) return 8272 + (n - 8192);
    if (n < 10304) return 6160 + (n - 10240);
    if (n < 10312) return 4096 + (n - 10304);
    if (n < 10320) return 4104 + (n - 10312);
    return -1;
}
struct TrJob { int widx, K, N, nblk, item; };
__device__ __forceinline__ const float* opq(const void* p) { unsigned long long v = (unsigned long long)p; asm volatile("" : "+s"(v)); return (const float*)v; }
__device__ __forceinline__ const float* tr_src(const Params& P, int w) {
    const float* a0 = opq(P.in[4]); const float* a1 = opq(P.in[10]); const float* a2 = opq(P.in[15]); const float* a3 = opq(P.in[16]); const float* a4 = opq(P.in[17]);
    const float* a5 = opq(P.in[19]); const float* a6 = opq(P.in[20]); const float* a7 = opq(P.in[22]); const float* a8 = opq(P.in[23]);
    return w == 0 ? a0 : w == 1 ? a1 : w == 2 ? a2 : w == 3 ? a3 : w == 4 ? a4 : w == 5 ? a5 : w == 6 ? a6 : w == 7 ? a7 : a8; }
__device__ __forceinline__ size_t tr_dst_off(int w) { return w == 0 ? WS_WIN : w == 1 ? WS_WKV : w == 2 ? WS_WA : w == 3 ? (WS_WA + 2048) : w == 4 ? WS_WOUT : w == 5 ? WS_WUP : w == 6 ? WS_WDN : w == 7 ? WS_WPG : WS_WPLE; }
__device__ __forceinline__ void tr_load(const Params& P, const TrJob& J, int lane, f32x4 (&v)[8]) {
    const int kb = J.item / J.nblk, nb = J.item % J.nblk, k0 = 64 * kb, n0 = 32 * nb, q4 = lane & 7, kr = lane >> 3;
    int oc = n0 + 4 * q4; if (J.widx == 0) oc = win_map(oc);
    const float* W = tr_src(P, J.widx);
#pragma unroll
    for (int i = 0; i < 8; ++i) v[i] = (oc >= 0) ? *(const f32x4*)(W + (size_t)(k0 + 8 * i + kr) * J.N + oc) : (f32x4){0.f, 0.f, 0.f, 0.f};
}
__device__ __forceinline__ void tr_finish(const Params& P, const TrJob& J, int lane, const f32x4 (&v)[8], LAS float* scr) {
    const int kb = J.item / J.nblk, nb = J.item % J.nblk, k0 = 64 * kb, n0 = 32 * nb, q4 = lane & 7, kr = lane >> 3;
    const float* kg5 = opq(P.in[18]); const float* kg7 = opq(P.in[21]); const float* kgain = (J.widx == 5) ? kg5 : (J.widx == 7) ? kg7 : nullptr;
    bf16_t* WT = (bf16_t*)(P.ws + tr_dst_off(J.widx));
    const int ldk = (J.widx == 2 || J.widx == 3) ? 2048 : J.K;
#pragma unroll
    for (int i = 0; i < 8; ++i) { LAS float* d = scr + (8 * i + kr) * 33 + 4 * q4; const float kg = kgain ? kgain[k0 + 8 * i + kr] : 1.f; d[0] = v[i][0] * kg; d[1] = v[i][1] * kg; d[2] = v[i][2] * kg; d[3] = v[i][3] * kg; }
    LDS_WAIT();
    const int c = lane & 7;
#pragma unroll
    for (int j = 0; j < 4; ++j) { const int n = (lane >> 3) + 8 * j; const LAS float* sp = scr + (8 * c) * 33 + n;
        u32x4 o; o.x = pk2(sp[0 * 33], sp[1 * 33]); o.y = pk2(sp[2 * 33], sp[3 * 33]); o.z = pk2(sp[4 * 33], sp[5 * 33]); o.w = pk2(sp[6 * 33], sp[7 * 33]);
        *(u32x4*)(WT + (size_t)(n0 + n) * ldk + k0 + 8 * c) = o; }
    LDS_WAIT();
}
__device__ __forceinline__ void rmsnorm_row(const float* xrow, const float* gain, bf16_t* orow, int lane) {
    const f32x4* xr = (const f32x4*)xrow + lane; const f32x4* gr = (const f32x4*)gain + lane;
    f32x4 v[8]; float s = 0.f;
#pragma unroll
    for (int j = 0; j < 8; ++j) { v[j] = xr[64 * j]; s += (v[j][0] * v[j][0] + v[j][1] * v[j][1]) + (v[j][2] * v[j][2] + v[j][3] * v[j][3]); }
    const float rstd = rsqrtf(wave_sum(s) * (1.f / 2048.f) + EPS);
    u32x2* o8 = (u32x2*)orow + lane;
#pragma unroll
    for (int j = 0; j < 8; ++j) { const f32x4 g = gr[64 * j]; u32x2 w; w.x = pk2(v[j][0] * rstd * g[0], v[j][1] * rstd * g[1]); w.y = pk2(v[j][2] * rstd * g[2], v[j][3] * rstd * g[3]); o8[64 * j] = w; }
}
__device__ __forceinline__ void rmsnorm_rows_phase(const float* X, const float* gain, bf16_t* O, int gw, int NGW, int lane) {
    for (int m = gw; m < MROWS / 2; m += NGW) {
        const f32x4* x0 = (const f32x4*)(X + (size_t)m * DM) + lane; const f32x4* x1 = (const f32x4*)(X + (size_t)(m + MROWS / 2) * DM) + lane; const f32x4* gr = (const f32x4*)gain + lane;
        f32x4 a[8], b[8]; float sa = 0.f, sb = 0.f;
#pragma unroll
        for (int j = 0; j < 8; ++j) { a[j] = x0[64 * j]; b[j] = x1[64 * j]; }
#pragma unroll
        for (int j = 0; j < 8; ++j) { sa += (a[j][0] * a[j][0] + a[j][1] * a[j][1]) + (a[j][2] * a[j][2] + a[j][3] * a[j][3]); sb += (b[j][0] * b[j][0] + b[j][1] * b[j][1]) + (b[j][2] * b[j][2] + b[j][3] * b[j][3]); }
        const float ra = rsqrtf(wave_sum(sa) * (1.f / 2048.f) + EPS), rb = rsqrtf(wave_sum(sb) * (1.f / 2048.f) + EPS);
        u32x2* oa = (u32x2*)(O + (size_t)m * DM) + lane; u32x2* ob = (u32x2*)(O + (size_t)(m + MROWS / 2) * DM) + lane;
#pragma unroll
        for (int j = 0; j < 8; ++j) { const f32x4 g = gr[64 * j]; u32x2 w; w.x = pk2(a[j][0] * ra * g[0], a[j][1] * ra * g[1]); w.y = pk2(a[j][2] * ra * g[2], a[j][3] * ra * g[3]); oa[64 * j] = w;
            w.x = pk2(b[j][0] * rb * g[0], b[j][1] * rb * g[1]); w.y = pk2(b[j][2] * rb * g[2], b[j][3] * rb * g[3]); ob[64 * j] = w; }
    }
}

__device__ __forceinline__ TrJob tr_job(int it) {
    constexpr int I_IN = 32 * (LDP / 32), I_KV = 8 * 64, I_A = 16 * 64, I_B = 16 * 64, I_OUT = 32 * 64, I_UP = 32 * 256, I_DN = 128 * 64, I_PG = 32 * 64;
    int r = it;
    if (r < I_IN) return TrJob{0, 2048, D_IN, LDP / 32, r}; r -= I_IN;
    if (r < I_KV) return TrJob{1, 512, 2048, 64, r}; r -= I_KV;
    if (r < I_A) return TrJob{2, 1024, 2048, 64, r}; r -= I_A;
    if (r < I_B) return TrJob{3, 1024, 2048, 64, r}; r -= I_B;
    if (r < I_OUT) return TrJob{4, 2048, 2048, 64, r}; r -= I_OUT;
    if (r < I_UP) return TrJob{5, 2048, 8192, 256, r}; r -= I_UP;
    if (r < I_DN) return TrJob{6, 8192, 2048, 64, r}; r -= I_DN;
    if (r < I_PG) return TrJob{7, 2048, 2048, 64, r}; r -= I_PG;
    return TrJob{8, 256, 2048, 64, r};
}
constexpr int TR_IN_ITEMS = 32 * (LDP / 32);
constexpr int TR_ALL_ITEMS = 32 * (LDP / 32) + 8 * 64 + 16 * 64 + 16 * 64 + 32 * 64 + 32 * 256 + 128 * 64 + 32 * 64 + 4 * 64;
__device__ __forceinline__ void transpose_range(const Params& P, LAS float* scr, int lo, int hi, int gw, int NGW, int lane) {
    for (int it = lo + gw; it < hi; it += 2 * NGW) {
        const TrJob J0 = tr_job(it); f32x4 v0[8], v1[8]; tr_load(P, J0, lane, v0);
        const bool two = (it + NGW < hi);
        const TrJob J1 = tr_job(two ? it + NGW : it);
        if (two) tr_load(P, J1, lane, v1);
        tr_finish(P, J0, lane, v0, scr);
        if (two) tr_finish(P, J1, lane, v1, scr);
    }
}
__device__ __forceinline__ void p0_prologue(const Params& P, LAS unsigned char* lds, int gw, int NGW, int wave, int lane) {
    unsigned char* ws = P.ws;
    LAS float* scr = (LAS float*)(lds + wave * 16384);
    transpose_range(P, scr, 0, TR_IN_ITEMS, gw, NGW, lane);
    rmsnorm_rows_phase((const float*)P.in[0], (const float*)P.in[3], (bf16_t*)(ws + WS_ACT), gw, NGW, lane);
    { const f32x4* src = (const f32x4*)P.in[1]; u32x4* dst = (u32x4*)(ws + WS_PBF); const size_t n8 = (size_t)MROWS * PLE / 8;
      for (size_t i = (size_t)gw * 64 + lane; i < n8; i += (size_t)NGW * 64) { const f32x4 a = src[2 * i], b = src[2 * i + 1]; u32x4 w; w.x = pk2(a[0], a[1]); w.y = pk2(a[2], a[3]); w.z = pk2(b[0], b[1]); w.w = pk2(b[2], b[3]); dst[i] = w; } }
}

__device__ __forceinline__ void rope_cs(float pos, float inv, float& c, float& s) {
    const float a = pos * inv;
    double rev = (double)a * 0.15915494309189535; rev -= rint(rev);
    const float r = (float)rev; s = __builtin_amdgcn_sinf(r); c = __builtin_amdgcn_cosf(r);
}
__device__ __forceinline__ void unpack8(const u32x4 w, float (&f)[8]) { f[0] = bflo(w.x); f[1] = bfhi(w.x); f[2] = bflo(w.y); f[3] = bfhi(w.y); f[4] = bflo(w.z); f[5] = bfhi(w.z); f[6] = bflo(w.w); f[7] = bfhi(w.w); }
__device__ __forceinline__ u32x4 pack8(const float (&f)[8]) { u32x4 w; w.x = pk2(f[0], f[1]); w.y = pk2(f[2], f[3]); w.z = pk2(f[4], f[5]); w.w = pk2(f[6], f[7]); return w; }
__device__ __forceinline__ void p2_prep(const Params& P, int gw, int NGW, int lane) {
    unsigned char* ws = P.ws;
    bf16_t* proj = (bf16_t*)(ws + WS_PROJ);
    const int* positions = (const int*)P.in[2];
    const float* ckvn = (const float*)P.in[9]; const float* qng = (const float*)P.in[11]; const float* qrg = (const float*)P.in[12]; const float* kng = (const float*)P.in[13]; const float* krg = (const float*)P.in[14];
    const float* dt_bias = (const float*)P.in[6]; const float* a_log = (const float*)P.in[7];
    float* G = (float*)(ws + WS_G); float* BETA = (float*)(ws + WS_BETA);
    const float QSCALE = 0.07216878364870322f * LOG2E;
    {
        const int h = lane >> 3, seg = lane & 7;
        float gn[16], gr[8], inv8[8], gc8[8];
#pragma unroll
        for (int e = 0; e < 16; ++e) gn[e] = qng[16 * seg + e] * kng[16 * seg + e] * QSCALE;
#pragma unroll
        for (int e = 0; e < 8; ++e) { gr[e] = qrg[8 * seg + e]; inv8[e] = P.ropeinv[8 * (seg & 3) + e]; gc8[e] = ckvn[8 * lane + e]; }
        const float inv1 = P.ropeinv[lane & 31], kr_g = krg[lane];
        for (int m = gw; m < MROWS; m += NGW) {
            bf16_t* row = proj + (size_t)m * LDP;
            bf16_t* np = row + C_MQ + h * 192 + 16 * seg; bf16_t* rp = row + C_MQ + h * 192 + 128 + 8 * seg; bf16_t* cp = row + C_CKV + 8 * lane;
            const u32x4 wn0 = *(const u32x4*)np, wn1 = *(const u32x4*)(np + 8), wr = *(const u32x4*)rp, wc = *(const u32x4*)cp;
            const bf16_t wk = row[C_KR + lane]; const bf16_t wba = (lane < 16) ? row[C_BETA + lane] : (bf16_t)0;
            const float pos = (float)positions[m];
            float a[8], b[8]; unpack8(wn0, a); unpack8(wn1, b);
            float ss = 0.f;
#pragma unroll
            for (int e = 0; e < 8; ++e) ss += a[e] * a[e] + b[e] * b[e];
            ss += __shfl_xor(ss, 1); ss += __shfl_xor(ss, 2); ss += __shfl_xor(ss, 4);
            const float rstd = rsqrtf(ss * (1.f / 128.f) + EPS);
#pragma unroll
            for (int e = 0; e < 8; ++e) { a[e] = a[e] * rstd * gn[e]; b[e] = b[e] * rstd * gn[8 + e]; }
            *(u32x4*)np = pack8(a); *(u32x4*)(np + 8) = pack8(b);
            float x[8]; unpack8(wr, x);
            float s2 = 0.f;
#pragma unroll
            for (int e = 0; e < 8; ++e) s2 += x[e] * x[e];
            s2 += __shfl_xor(s2, 1); s2 += __shfl_xor(s2, 2); s2 += __shfl_xor(s2, 4);
            const float rs2 = rsqrtf(s2 * (1.f / 64.f) + EPS);
#pragma unroll
            for (int e = 0; e < 8; ++e) { const float xn = x[e] * rs2 * gr[e]; const float px = __shfl_xor(xn, 4); float cs, sn; rope_cs(pos, inv8[e], cs, sn);
                x[e] = ((seg < 4) ? (xn * cs - px * sn) : (xn * cs + px * sn)) * QSCALE; }
            *(u32x4*)rp = pack8(x);
            float cv[8]; unpack8(wc, cv);
            float s3 = 0.f;
#pragma unroll
            for (int e = 0; e < 8; ++e) s3 += cv[e] * cv[e];
            const float rs3 = rsqrtf(wave_sum(s3) * (1.f / 512.f) + EPS);
#pragma unroll
            for (int e = 0; e < 8; ++e) cv[e] = cv[e] * rs3 * gc8[e];
            *(u32x4*)cp = pack8(cv);
            { float xk = bf2f(wk); const float rs4 = rsqrtf(wave_sum(xk * xk) * (1.f / 64.f) + EPS); xk = xk * rs4 * kr_g;
              float cs, sn; rope_cs(pos, inv1, cs, sn);
              const float px = __shfl_xor(xk, 32); row[C_KR + lane] = f2bf((lane < 32) ? (xk * cs - px * sn) : (xk * cs + px * sn)); }
            if (lane < 8) BETA[(size_t)m * 8 + lane] = 1.f / (1.f + expf(-bf2f(wba)));
            else if (lane < 16) { const int hh = lane - 8; const float z = bf2f(wba) + dt_bias[hh]; const float sp = (z > 20.f) ? z : log1pf(expf(z)); G[(size_t)m * 8 + hh] = -expf(a_log[hh]) * sp; }
        }
    }
    const float* convw = (const float*)P.in[5];
    bf16_t* QA = (bf16_t*)P.out;
    for (int it = gw; it < (MROWS / 16) * 6; it += NGW) {
        const int run = it / 6, gg = it % 6, m0 = run * 16, s0 = m0 & 2047, c = gg * 512 + 8 * lane;
        float w0[8], w1[8], w2[8], w3[8];
#pragma unroll
        for (int e = 0; e < 8; e += 4) { *(f32x4*)(w0 + e) = *(const f32x4*)(convw + 0 * 3072 + c + e); *(f32x4*)(w1 + e) = *(const f32x4*)(convw + 1 * 3072 + c + e);
                                         *(f32x4*)(w2 + e) = *(const f32x4*)(convw + 2 * 3072 + c + e); *(f32x4*)(w3 + e) = *(const f32x4*)(convw + 3 * 3072 + c + e); }
        const bf16_t* src = proj + (size_t)m0 * LDP + c;
        float h1[8], h2[8], h3[8];
        if (s0 != 0) { unpack8(*(const u32x4*)(src - (size_t)1 * LDP), h1); unpack8(*(const u32x4*)(src - (size_t)2 * LDP), h2); unpack8(*(const u32x4*)(src - (size_t)3 * LDP), h3); }
        else {
#pragma unroll
            for (int e = 0; e < 8; ++e) { h1[e] = 0.f; h2[e] = 0.f; h3[e] = 0.f; } }
        bf16_t* dst = QA + (size_t)(gg >> 1) * ((size_t)MROWS * 1024) + (size_t)m0 * 1024 + (gg & 1) * 512 + 8 * lane;
        const float post = (gg < 2) ? 0.08838834764831845f : 1.f;
#pragma unroll
        for (int tb = 0; tb < 2; ++tb) {
            u32x4 raw[8];
#pragma unroll
            for (int q = 0; q < 8; ++q) raw[q] = *(const u32x4*)(src + (size_t)(8 * tb + q) * LDP);
#pragma unroll
            for (int q = 0; q < 8; ++q) {
                float cur[8], y[8]; unpack8(raw[q], cur);
                float ss = 0.f;
#pragma unroll
                for (int e = 0; e < 8; ++e) { y[e] = silu_f(w3[e] * cur[e] + w2[e] * h1[e] + w1[e] * h2[e] + w0[e] * h3[e]); ss += y[e] * y[e]; }
                if (gg < 4) { ss += __shfl_xor(ss, 1); ss += __shfl_xor(ss, 2); ss += __shfl_xor(ss, 4); ss += __shfl_xor(ss, 8); const float sc = rsqrtf(ss + EPS) * post;
#pragma unroll
                    for (int e = 0; e < 8; ++e) y[e] *= sc; }
                *(u32x4*)(dst + (size_t)(8 * tb + q) * 1024) = pack8(y);
#pragma unroll
                for (int e = 0; e < 8; ++e) { h3[e] = h2[e]; h2[e] = h1[e]; h1[e] = cur[e]; }
            }
        }
    }
}

constexpr int SOLVE_NOPS = 528, SOLVE_R = 8, SOLVE_D = 6;
struct SolveOps { unsigned char j[SOLVE_NOPS + SOLVE_R], q[SOLVE_NOPS + SOLVE_R]; };
constexpr SolveOps make_solve_ops() { SolveOps o{}; int t = 0; for (int j = 0; j < 63; ++j) for (int q = (j + 1) >> 2; q < 16; ++q) { o.j[t] = (unsigned char)j; o.q[t] = (unsigned char)q; ++t; } return o; }
constexpr SolveOps SOPS = make_solve_ops();
template <int T, int END> struct SolveStep {
    static __device__ __forceinline__ void run(f32x2 (&r)[32], f32x4 (&buf)[SOLVE_R], const LAS f32x4* Atv) {
        constexpr int TL = T + SOLVE_D;
        if constexpr (TL < END) buf[TL % SOLVE_R] = Atv[SOPS.j[TL] * 16 + SOPS.q[TL]];
        __builtin_amdgcn_sched_barrier(0);
        constexpr int j = SOPS.j[T], q = SOPS.q[T];
        const float xj = r[j >> 1][j & 1]; const f32x2 x2 = {xj, xj}; const f32x4 a = buf[T % SOLVE_R];
        r[2 * q] = r[2 * q] - (f32x2){a[0], a[1]} * x2; r[2 * q + 1] = r[2 * q + 1] - (f32x2){a[2], a[3]} * x2;
        __builtin_amdgcn_sched_barrier(0);
        SolveStep<T + 1, END>::run(r, buf, Atv);
    }
};
template <int END> struct SolveStep<END, END> { static __device__ __forceinline__ void run(f32x2 (&)[32], f32x4 (&)[SOLVE_R], const LAS f32x4*) {} };

__device__ __forceinline__ void delta_prep(const Params& P, LAS unsigned char* lds) {
    unsigned char* ws = P.ws;
    int tid = threadIdx.x; asm volatile("" : "+v"(tid));
    const int wave = __builtin_amdgcn_readfirstlane(tid >> 6), lane = tid & 63, sub = wave >> 2, tid_s = tid & 255, wv = wave & 3, fr = lane & 15, fq = lane >> 4;
    bf16_t* QA = (bf16_t*)P.out; bf16_t* KA = QA + (size_t)MROWS * 1024; bf16_t* VA = KA + (size_t)MROWS * 1024; bf16_t* WB = VA + (size_t)MROWS * 1024;
    const float* G = (const float*)(ws + WS_G); const float* BETA = (const float*)(ws + WS_BETA); bf16_t* QKM = (bf16_t*)(ws + WS_QKM); float* GL = (float*)(ws + WS_GL);
    LAS unsigned char* base = lds + sub * 61440;
    LAS bf16_t* Ks = (LAS bf16_t*)base; LAS bf16_t* Qs = (LAS bf16_t*)(base + 17408); LAS float* At = (LAS float*)(base + 34816);
    LAS float* gcs = (LAS float*)(base + 51200); LAS float* betas = (LAS float*)(base + 51456); LAS float* bes = (LAS float*)(base + 51712);
    LAS bf16_t* QKs = (LAS bf16_t*)(base + 51968);
    for (int unit = blockIdx.x; unit < 2048; unit += gridDim.x) {
        const int ch = unit * 2 + sub, n = ch & 31, bh = ch >> 5, h = bh & 7, b = bh >> 3, m0 = b * 2048 + n * 64;
#pragma unroll
        for (int i = 0; i < 4; ++i) { const int p = tid_s + 256 * i, row = p >> 4, c = p & 15; const size_t go = (size_t)(m0 + row) * 1024 + h * 128 + c * 8;
            *(LAS u32x4*)(Ks + row * 136 + c * 8) = *(const u32x4*)(KA + go); *(LAS u32x4*)(Qs + row * 136 + c * 8) = *(const u32x4*)(QA + go); }
        if (wv == 0) { float g = G[(size_t)(m0 + lane) * 8 + h] * LOG2E;
#pragma unroll
            for (int o = 1; o < 64; o <<= 1) { const float t = __shfl_up(g, o); if (lane >= o) g += t; }
            const float be = BETA[(size_t)(m0 + lane) * 8 + h];
            gcs[lane] = g; betas[lane] = be; bes[lane] = be * __builtin_amdgcn_exp2f(g); if (lane == 63) GL[ch] = __builtin_amdgcn_exp2f(g); }
        __syncthreads();
        { const int ti = wv; bf16x8 ak[4], aq[4];
#pragma unroll
          for (int ks = 0; ks < 4; ++ks) { ak[ks] = *(const LAS bf16x8*)(Ks + (16 * ti + fr) * 136 + 32 * ks + fq * 8); aq[ks] = *(const LAS bf16x8*)(Qs + (16 * ti + fr) * 136 + 32 * ks + fq * 8); }
          f32x4 gi, bi;
#pragma unroll
          for (int j = 0; j < 4; ++j) { gi[j] = gcs[16 * ti + fq * 4 + j]; bi[j] = betas[16 * ti + fq * 4 + j]; }
#pragma unroll
          for (int tj = 0; tj < 4; ++tj) {
              f32x4 ck = {0.f, 0.f, 0.f, 0.f}, cq = {0.f, 0.f, 0.f, 0.f};
              if (tj <= ti) {
#pragma unroll
                  for (int ks = 0; ks < 4; ++ks) { const bf16x8 bk = *(const LAS bf16x8*)(Ks + (16 * tj + fr) * 136 + 32 * ks + fq * 8);
                      ck = __builtin_amdgcn_mfma_f32_16x16x32_bf16(ak[ks], bk, ck, 0, 0, 0); cq = __builtin_amdgcn_mfma_f32_16x16x32_bf16(aq[ks], bk, cq, 0, 0, 0); } }
              const int jj = 16 * tj + fr; const float gj = gcs[jj]; f32x4 av; float qv[4];
#pragma unroll
              for (int j = 0; j < 4; ++j) { const int i = 16 * ti + fq * 4 + j; const float dec = (i >= jj) ? __builtin_amdgcn_exp2f(gi[j] - gj) : 0.f;
                  av[j] = (i > jj) ? bi[j] * ck[j] * dec : 0.f; qv[j] = cq[j] * dec; }
              *(LAS f32x4*)(At + jj * 64 + 16 * ti + fq * 4) = av;
#pragma unroll
              for (int j = 0; j < 4; ++j) QKs[(16 * ti + fq * 4 + j) * 72 + jj] = f2bf(qv[j]);
          } }
        u32x4 vreg[4];
        const float gl = gcs[63];
#pragma unroll
        for (int i = 0; i < 4; ++i) { const int p = tid_s + 256 * i, row = p >> 4, c = p & 15; const size_t go = (size_t)(m0 + row) * 1024 + h * 128 + c * 8;
            vreg[i] = *(const u32x4*)(VA + go);
            const u32x4 q = *(const LAS u32x4*)(Qs + row * 136 + c * 8); const float e = __builtin_amdgcn_exp2f(gcs[row]); u32x4 o;
            o.x = pk2(bflo(q.x) * e, bfhi(q.x) * e); o.y = pk2(bflo(q.y) * e, bfhi(q.y) * e); o.z = pk2(bflo(q.z) * e, bfhi(q.z) * e); o.w = pk2(bflo(q.w) * e, bfhi(q.w) * e);
            *(u32x4*)(QA + go) = o; }
#pragma unroll
        for (int i = 0; i < 4; ++i) { const int p = tid_s + 256 * i, dk = p & 127, j0 = (p >> 7) * 8; float v[8];
#pragma unroll
            for (int e = 0; e < 8; ++e) v[e] = bf2f(Ks[(j0 + e) * 136 + dk]) * __builtin_amdgcn_exp2f(gl - gcs[j0 + e]);
            u32x4 o; o.x = pk2(v[0], v[1]); o.y = pk2(v[2], v[3]); o.z = pk2(v[4], v[5]); o.w = pk2(v[6], v[7]);
            *(u32x4*)(KA + (size_t)(m0 + (dk >> 1)) * 1024 + h * 128 + (dk & 1) * 64 + j0) = o; }
        __syncthreads();
#pragma unroll
        for (int i = 0; i < 4; ++i) { const int p = tid_s + 256 * i, row = p >> 4, c = p & 15; *(LAS u32x4*)(Qs + row * 136 + c * 8) = vreg[i]; }
#pragma unroll
        for (int i = 0; i < 2; ++i) { const int p = tid_s + 256 * i, row = p >> 3, c8 = p & 7; *(u32x4*)(QKM + (size_t)ch * 4096 + row * 64 + c8 * 8) = *(const LAS u32x4*)(QKs + row * 72 + c8 * 8); }
        __syncthreads();
        { const int c = tid_s; LAS bf16_t* rp = Ks + (c >> 7) * 8704 + (c & 127); const LAS float* sp = (c >= 128) ? betas : bes;
          int zv = 0; asm volatile("" : "+v"(zv)); const LAS f32x4* Atv = (const LAS f32x4*)At + zv;
          f32x2 r[32];
#pragma unroll
          for (int i = 0; i < 64; ++i) r[i >> 1][i & 1] = bf2f(rp[i * 136]) * sp[i];
          f32x4 buf[SOLVE_R];
#pragma unroll
          for (int t = 0; t < SOLVE_D; ++t) buf[t] = Atv[SOPS.j[t] * 16 + SOPS.q[t]];
          SolveStep<0, SOLVE_NOPS>::run(r, buf, Atv);
#pragma unroll
          for (int i = 0; i < 64; ++i) rp[i * 136] = f2bf(r[i >> 1][i & 1]); }
        __syncthreads();
#pragma unroll
        for (int i = 0; i < 4; ++i) { const int p = tid_s + 256 * i, row = p >> 4, c = p & 15; const size_t go = (size_t)(m0 + row) * 1024 + h * 128 + c * 8;
            *(u32x4*)(WB + go) = *(const LAS u32x4*)(Ks + row * 136 + c * 8); *(u32x4*)(VA + go) = *(const LAS u32x4*)(Qs + row * 136 + c * 8); }
        __syncthreads();
    }
}

__device__ __forceinline__ void delta_scan(const Params& P, LAS unsigned char* lds) {
    unsigned char* ws = P.ws;
    int tid = threadIdx.x; asm volatile("" : "+v"(tid));
    const int wave = __builtin_amdgcn_readfirstlane(tid >> 6), lane = tid & 63, fr = lane & 15, fq = lane >> 4;
    const bf16_t* QA = (const bf16_t*)P.out; const bf16_t* KA = QA + (size_t)MROWS * 1024; const bf16_t* UA = KA + (size_t)MROWS * 1024; const bf16_t* WB = UA + (size_t)MROWS * 1024;
    const bf16_t* QKM = (const bf16_t*)(ws + WS_QKM); const float* GL = (const float*)(ws + WS_GL); bf16_t* proj = (bf16_t*)(ws + WS_PROJ);
    const float* ogain = (const float*)P.in[8];
    LAS bf16_t* Ws = (LAS bf16_t*)lds; LAS bf16_t* Qs = (LAS bf16_t*)(lds + 17408); LAS bf16_t* Kt = (LAS bf16_t*)(lds + 34816); LAS bf16_t* QKs = (LAS bf16_t*)(lds + 53248);
    LAS bf16_t* Us = (LAS bf16_t*)(lds + 62464); LAS bf16_t* St = (LAS bf16_t*)(lds + 79872); LAS bf16_t* VNt = (LAS bf16_t*)(lds + 114688); LAS float* SSQ = (LAS float*)(lds + 133120);
    const int it = wave >> 1, dvq = wave & 1;
    for (int unit = blockIdx.x; unit < 128; unit += gridDim.x) {
        const int bh = unit, h = bh & 7, b = bh >> 3;
        f32x4 sacc[8];
#pragma unroll
        for (int d = 0; d < 8; ++d) sacc[d] = (f32x4){0.f, 0.f, 0.f, 0.f};
        float og[4];
#pragma unroll
        for (int d = 0; d < 4; ++d) og[d] = ogain[16 * (4 * dvq + d) + fr];
        u32x4 rw[2], rq[2], rk[2], ru[2], rqk;
#define SCAN_LOAD(nn) do { const int m0_ = b * 2048 + (nn) * 64; const size_t ch_ = (size_t)bh * 32 + (nn); \
            _Pragma("unroll") for (int i = 0; i < 2; ++i) { const int p = tid + 512 * i, row = p >> 4, c = p & 15; const size_t go = (size_t)(m0_ + row) * 1024 + h * 128 + c * 8; rw[i] = *(const u32x4*)(WB + go); rq[i] = *(const u32x4*)(QA + go); ru[i] = *(const u32x4*)(UA + go); \
                const int dk = p >> 3, c8 = p & 7; rk[i] = *(const u32x4*)(KA + (size_t)(m0_ + (dk >> 1)) * 1024 + h * 128 + (dk & 1) * 64 + c8 * 8); } \
            { const int row = tid >> 3, c8 = tid & 7; rqk = *(const u32x4*)(QKM + ch_ * 4096 + row * 64 + c8 * 8); } } while (0)
#define SCAN_STORE() do { \
            _Pragma("unroll") for (int i = 0; i < 2; ++i) { const int p = tid + 512 * i, row = p >> 4, c = p & 15; *(LAS u32x4*)(Ws + row * 136 + c * 8) = rw[i]; *(LAS u32x4*)(Qs + row * 136 + c * 8) = rq[i]; *(LAS u32x4*)(Us + row * 136 + c * 8) = ru[i]; \
                const int dk = p >> 3, c8 = p & 7; *(LAS u32x4*)(Kt + dk * 72 + c8 * 8) = rk[i]; } \
            { const int row = tid >> 3, c8 = tid & 7; *(LAS u32x4*)(QKs + row * 72 + c8 * 8) = rqk; } } while (0)
        SCAN_LOAD(0);
        for (int n = 0; n < 32; ++n) {
            const int m0 = b * 2048 + n * 64;
            SCAN_STORE();
#pragma unroll
            for (int d = 0; d < 8; ++d) { u32x2 w; w.x = pk2(sacc[d][0], sacc[d][1]); w.y = pk2(sacc[d][2], sacc[d][3]); *(LAS u32x2*)(St + (16 * d + fr) * 136 + 16 * wave + fq * 4) = w; }
            const float gl = GL[bh * 32 + n];
            __syncthreads();
            if (n + 1 < 32) SCAN_LOAD(n + 1);
            bf16_t zr[4][4];
#pragma unroll
            for (int d = 0; d < 4; ++d)
#pragma unroll
                for (int j = 0; j < 4; ++j) zr[d][j] = proj[(size_t)(m0 + 16 * it + fq * 4 + j) * LDP + C_Z + h * 128 + 16 * (4 * dvq + d) + fr];
            f32x4 a1[4], a2[4];
#pragma unroll
            for (int d = 0; d < 4; ++d) { a1[d] = (f32x4){0.f, 0.f, 0.f, 0.f}; a2[d] = (f32x4){0.f, 0.f, 0.f, 0.f}; }
#pragma unroll
            for (int ks = 0; ks < 4; ++ks) { const bf16x8 wf = *(const LAS bf16x8*)(Ws + (16 * it + fr) * 136 + 32 * ks + fq * 8), qf = *(const LAS bf16x8*)(Qs + (16 * it + fr) * 136 + 32 * ks + fq * 8);
#pragma unroll
                for (int d = 0; d < 4; ++d) { const bf16x8 sf = *(const LAS bf16x8*)(St + (16 * (4 * dvq + d) + fr) * 136 + 32 * ks + fq * 8);
                    a1[d] = __builtin_amdgcn_mfma_f32_16x16x32_bf16(wf, sf, a1[d], 0, 0, 0); a2[d] = __builtin_amdgcn_mfma_f32_16x16x32_bf16(qf, sf, a2[d], 0, 0, 0); } }
#pragma unroll
            for (int d = 0; d < 4; ++d) { const int dv = 16 * (4 * dvq + d) + fr; float vn[4];
#pragma unroll
                for (int j = 0; j < 4; ++j) vn[j] = bf2f(Us[(16 * it + fq * 4 + j) * 136 + dv]) - a1[d][j];
                u32x2 w; w.x = pk2(vn[0], vn[1]); w.y = pk2(vn[2], vn[3]); *(LAS u32x2*)(VNt + dv * 72 + 16 * it + fq * 4) = w; }
            __syncthreads();
#pragma unroll
            for (int d = 0; d < 8; ++d) sacc[d] = sacc[d] * gl;
#pragma unroll
            for (int k2 = 0; k2 < 2; ++k2) { const bf16x8 qkf = *(const LAS bf16x8*)(QKs + (16 * it + fr) * 72 + 32 * k2 + fq * 8), kf = *(const LAS bf16x8*)(Kt + (16 * wave + fr) * 72 + 32 * k2 + fq * 8);
#pragma unroll
                for (int d = 0; d < 8; ++d) { const bf16x8 vf = *(const LAS bf16x8*)(VNt + (16 * d + fr) * 72 + 32 * k2 + fq * 8);
                    sacc[d] = __builtin_amdgcn_mfma_f32_16x16x32_bf16(kf, vf, sacc[d], 0, 0, 0);
                    if ((d >> 2) == dvq) a2[d & 3] = __builtin_amdgcn_mfma_f32_16x16x32_bf16(qkf, vf, a2[d & 3], 0, 0, 0); } }
            float ssq[4];
#pragma unroll
            for (int j = 0; j < 4; ++j) { float t = 0.f;
#pragma unroll
                for (int d = 0; d < 4; ++d) t += a2[d][j] * a2[d][j];
                t += __shfl_xor(t, 1); t += __shfl_xor(t, 2); t += __shfl_xor(t, 4); t += __shfl_xor(t, 8); ssq[j] = t; }
            if (fr == 0) {
#pragma unroll
                for (int j = 0; j < 4; ++j) SSQ[(16 * it + fq * 4 + j) * 2 + dvq] = ssq[j]; }
            __syncthreads();
#pragma unroll
            for (int j = 0; j < 4; ++j) { const int row = 16 * it + fq * 4 + j; const float rstd = rsqrtf((SSQ[row * 2] + SSQ[row * 2 + 1]) * (1.f / 128.f) + EPS);
#pragma unroll
                for (int d = 0; d < 4; ++d) proj[(size_t)(m0 + row) * LDP + C_Q + h * 128 + 16 * (4 * dvq + d) + fr] = f2bf(a2[d][j] * rstd * og[d] * silu_f(bf2f(zr[d][j]))); }
        }
        __syncthreads();
#undef SCAN_LOAD
#undef SCAN_STORE
    }
}

__device__ __forceinline__ void mla_attention(const Params& P, LAS unsigned char* lds) {
    unsigned char* ws = P.ws;
    int tid = threadIdx.x; asm volatile("" : "+v"(tid));
    const int wave = __builtin_amdgcn_readfirstlane(tid >> 6), lane = tid & 63, fr = lane & 15, fq = lane >> 4;
    bf16_t* proj = (bf16_t*)(ws + WS_PROJ); const bf16_t* KN = (const bf16_t*)(ws + WS_ACT); const bf16_t* VT = KN + (size_t)MROWS * 1024;
    const int kkey = tid >> 3, kseg = tid & 7, vdv = tid >> 2, vseg = tid & 3;
    unsigned* qctr = (unsigned*)(ws + WS_CTL + 128 * 1024);
    volatile LAS unsigned* qslot = (volatile LAS unsigned*)(lds + 139264);
    const bool stat = (gridDim.x == 256);
    for (int iter = 0;; ++iter) {
        int qi, bh;
        if (stat) { const bool sc = (int)blockIdx.x < 128; if (iter >= (sc ? 2 : 6)) break; bh = (int)blockIdx.x & 127;
            qi = sc ? (iter == 0 ? 7 : 4) : (iter == 0 ? 6 : iter == 1 ? 5 : iter == 2 ? 3 : iter == 3 ? 2 : iter == 4 ? 1 : 0); }
        else {
            if (tid == 0) qslot[0] = __hip_atomic_fetch_add(qctr, 1u, __ATOMIC_RELAXED, __HIP_MEMORY_SCOPE_AGENT);
            __syncthreads();
            const int L = (int)qslot[0];
            if (L >= 1024) break;
            qi = 7 - (L >> 7); bh = L & 127; }
        const int h = bh & 7, b = bh >> 3;
        const int q0 = qi * 256, ntiles = 4 * (qi + 1);
        bf16x8 qf[2][6];
#pragma unroll
        for (int m = 0; m < 2; ++m)
#pragma unroll
            for (int ks = 0; ks < 6; ++ks) qf[m][ks] = *(const bf16x8*)(proj + (size_t)(b * 2048 + q0 + 32 * wave + 16 * m + fr) * LDP + C_MQ + h * 192 + 32 * ks + fq * 8);
        f32x4 accO[2][8];
#pragma unroll
        for (int m = 0; m < 2; ++m)
#pragma unroll
            for (int d = 0; d < 8; ++d) accO[m][d] = (f32x4){0.f, 0.f, 0.f, 0.f};
        float mrow[2] = {-INFINITY, -INFINITY}, lsum[2] = {0.f, 0.f};
        u32x4 rk0, rk1, rkr, rv0, rv1;
#define ATT_LOAD(kt) do { const size_t krow = (size_t)(b * 2048 + (kt) * 64 + kkey); const bf16_t* kp = KN + krow * 1024 + h * 128 + 16 * kseg; rk0 = *(const u32x4*)kp; rk1 = *(const u32x4*)(kp + 8); \
            rkr = *(const u32x4*)(proj + krow * LDP + C_KR + 8 * kseg); const bf16_t* vp = VT + ((size_t)bh * 128 + vdv) * 2048 + (kt) * 64 + 16 * vseg; rv0 = *(const u32x4*)vp; rv1 = *(const u32x4*)(vp + 8); } while (0)
#define ATT_STORE(buf) do { LAS bf16_t* Kb = (LAS bf16_t*)(lds + (buf) * 25600); LAS bf16_t* Vb = (LAS bf16_t*)(lds + 51200 + (buf) * 18432); \
            float f[16]; f[0] = bflo(rk0.x); f[1] = bfhi(rk0.x); f[2] = bflo(rk0.y); f[3] = bfhi(rk0.y); f[4] = bflo(rk0.z); f[5] = bfhi(rk0.z); f[6] = bflo(rk0.w); f[7] = bfhi(rk0.w); \
            f[8] = bflo(rk1.x); f[9] = bfhi(rk1.x); f[10] = bflo(rk1.y); f[11] = bfhi(rk1.y); f[12] = bflo(rk1.z); f[13] = bfhi(rk1.z); f[14] = bflo(rk1.w); f[15] = bfhi(rk1.w); \
            float ss = 0.f; _Pragma("unroll") for (int e = 0; e < 16; ++e) ss += f[e] * f[e]; \
            ss += __shfl_xor(ss, 1); ss += __shfl_xor(ss, 2); ss += __shfl_xor(ss, 4); const float rs = rsqrtf(ss * (1.f / 128.f) + EPS); \
            u32x4 o0, o1; o0.x = pk2(f[0] * rs, f[1] * rs); o0.y = pk2(f[2] * rs, f[3] * rs); o0.z = pk2(f[4] * rs, f[5] * rs); o0.w = pk2(f[6] * rs, f[7] * rs); \
            o1.x = pk2(f[8] * rs, f[9] * rs); o1.y = pk2(f[10] * rs, f[11] * rs); o1.z = pk2(f[12] * rs, f[13] * rs); o1.w = pk2(f[14] * rs, f[15] * rs); \
            *(LAS u32x4*)(Kb + kkey * 200 + 16 * kseg) = o0; *(LAS u32x4*)(Kb + kkey * 200 + 16 * kseg + 8) = o1; *(LAS u32x4*)(Kb + kkey * 200 + 128 + 8 * kseg) = rkr; \
            *(LAS u32x4*)(Vb + vdv * 72 + 16 * vseg) = rv0; *(LAS u32x4*)(Vb + vdv * 72 + 16 * vseg + 8) = rv1; } while (0)
        ATT_LOAD(0); ATT_STORE(0);
        __syncthreads();
        for (int kt = 0; kt < ntiles; ++kt) {
            const bool more = (kt + 1 < ntiles);
            if (more) ATT_LOAD(kt + 1);
            const bool active = (kt < 4 * qi) || ((kt - 4 * qi) <= (wave >> 1));
            if (active) {
                const LAS bf16_t* Kb = (const LAS bf16_t*)(lds + (kt & 1) * 25600); const LAS bf16_t* Vb = (const LAS bf16_t*)(lds + 51200 + (kt & 1) * 18432);
                f32x4 accS[2][4];
#pragma unroll
                for (int m = 0; m < 2; ++m)
#pragma unroll
                    for (int n = 0; n < 4; ++n) accS[m][n] = (f32x4){0.f, 0.f, 0.f, 0.f};
#pragma unroll
                for (int ks = 0; ks < 6; ++ks)
#pragma unroll
                    for (int n = 0; n < 4; ++n) { const bf16x8 kf = *(const LAS bf16x8*)(Kb + (16 * n + fr) * 200 + 32 * ks + fq * 8);
                        accS[0][n] = __builtin_amdgcn_mfma_f32_16x16x32_bf16(kf, qf[0][ks], accS[0][n], 0, 0, 0); accS[1][n] = __builtin_amdgcn_mfma_f32_16x16x32_bf16(kf, qf[1][ks], accS[1][n], 0, 0, 0); }
                bf16x8 pf[2][2];
#pragma unroll
                for (int m = 0; m < 2; ++m) {
                    float mx = accS[m][0][0];
#pragma unroll
                    for (int n = 0; n < 4; ++n)
#pragma unroll
                        for (int j = 0; j < 4; ++j) mx = fmaxf(mx, accS[m][n][j]);
                    mx = fmaxf(mx, __shfl_xor(mx, 16)); mx = fmaxf(mx, __shfl_xor(mx, 32));
                    const float mnew = fmaxf(mrow[m], mx), alpha = __builtin_amdgcn_exp2f(mrow[m] - mnew); mrow[m] = mnew;
                    float ps = 0.f; float p[4][4];
#pragma unroll
                    for (int n = 0; n < 4; ++n)
#pragma unroll
                        for (int j = 0; j < 4; ++j) { p[n][j] = __builtin_amdgcn_exp2f(accS[m][n][j] - mnew); ps += p[n][j]; }
                    lsum[m] = lsum[m] * alpha + ps;
                    if (__any(alpha != 1.f)) {
#pragma unroll
                        for (int d = 0; d < 8; ++d) accO[m][d] = accO[m][d] * alpha; }
#pragma unroll
                    for (int t = 0; t < 2; ++t) { u32x4 w; w.x = pk2(p[2 * t][0], p[2 * t][1]); w.y = pk2(p[2 * t][2], p[2 * t][3]); w.z = pk2(p[2 * t + 1][0], p[2 * t + 1][1]); w.w = pk2(p[2 * t + 1][2], p[2 * t + 1][3]);
                        pf[m][t] = __builtin_bit_cast(bf16x8, w); }
                }
#pragma unroll
                for (int d = 0; d < 8; ++d)
#pragma unroll
                    for (int t = 0; t < 2; ++t) { const LAS bf16_t* vp = Vb + (16 * d + fr) * 72 + 32 * t + fq * 4; u32x4 w; const u32x2 lo = *(const LAS u32x2*)vp, hi = *(const LAS u32x2*)(vp + 16);
                        w.x = lo.x; w.y = lo.y; w.z = hi.x; w.w = hi.y; const bf16x8 vf = __builtin_bit_cast(bf16x8, w);
                        accO[0][d] = __builtin_amdgcn_mfma_f32_16x16x32_bf16(vf, pf[0][t], accO[0][d], 0, 0, 0); accO[1][d] = __builtin_amdgcn_mfma_f32_16x16x32_bf16(vf, pf[1][t], accO[1][d], 0, 0, 0); }
            }
            if (more) ATT_STORE((kt + 1) & 1);
            __syncthreads();
        }
#undef ATT_LOAD
#undef ATT_STORE
#pragma unroll
        for (int m = 0; m < 2; ++m) { float l = lsum[m]; l += __shfl_xor(l, 16); l += __shfl_xor(l, 32); const float il = 1.f / l;
            bf16_t* op = proj + (size_t)(b * 2048 + q0 + 32 * wave + 16 * m + fr) * LDP + C_K + h * 128 + fq * 4;
#pragma unroll
            for (int d = 0; d < 8; ++d) { u32x2 w; w.x = pk2(accO[m][d][0] * il, accO[m][d][1] * il); w.y = pk2(accO[m][d][2] * il, accO[m][d][3] * il); *(u32x2*)(op + 16 * d) = w; } }
    }
}

__device__ __forceinline__ void oa_finalize(const Params& P, int gw, int NGW, int lane) {
    bf16_t* proj = (bf16_t*)(P.ws + WS_PROJ); const float* gain = (const float*)P.in[8];
    const int h = lane >> 3, seg = lane & 7;
    float g[16];
#pragma unroll
    for (int e = 0; e < 16; ++e) g[e] = gain[16 * seg + e];
    for (int m = gw; m < MROWS; m += NGW) { bf16_t* op = proj + (size_t)m * LDP + C_Q + h * 128 + 16 * seg; const bf16_t* zp = proj + (size_t)m * LDP + C_Z + h * 128 + 16 * seg;
        const u32x4 o0 = *(const u32x4*)op, o1 = *(const u32x4*)(op + 8), z0 = *(const u32x4*)zp, z1 = *(const u32x4*)(zp + 8);
        float a[8], b[8], za[8], zb[8]; unpack8(o0, a); unpack8(o1, b); unpack8(z0, za); unpack8(z1, zb);
        float ss = 0.f;
#pragma unroll
        for (int e = 0; e < 8; ++e) ss += a[e] * a[e] + b[e] * b[e];
        ss += __shfl_xor(ss, 1); ss += __shfl_xor(ss, 2); ss += __shfl_xor(ss, 4);
        const float rstd = rsqrtf(ss * (1.f / 128.f) + EPS);
#pragma unroll
        for (int e = 0; e < 8; ++e) { a[e] = a[e] * rstd * g[e] * silu_f(za[e]); b[e] = b[e] * rstd * g[8 + e] * silu_f(zb[e]); }
        *(u32x4*)op = pack8(a); *(u32x4*)(op + 8) = pack8(b); }
}


#define XB_TMO      128
#define XB_XCNT(j)  (256  + 64 * (j))
#define XB_XSUB(j)  (1280 + 64 * (j))
#define XB_XGEN(j)  (2304 + 64 * (j))
#define XB_TOP      3328
#define XB_TOPGEN   3392
#define XCD_BAR_WORDS 3456
#define XB_SPIN_CAP (1u << 18)
__device__ __forceinline__ unsigned xb_ld(unsigned* p)              { return __hip_atomic_load(p, __ATOMIC_RELAXED, __HIP_MEMORY_SCOPE_AGENT); }
__device__ __forceinline__ unsigned xb_add(unsigned* p, unsigned v) { return __hip_atomic_fetch_add(p, v, __ATOMIC_RELAXED, __HIP_MEMORY_SCOPE_AGENT); }
__device__ __forceinline__ unsigned xb_xcc_id() { return (unsigned)__builtin_amdgcn_s_getreg((3 << 11) | 20) & 0xFu; }
#define XB_SPIN(cond, bar) do { unsigned _sp = 0; while (cond) { __builtin_amdgcn_s_sleep(1); \
    if ((++_sp & 255u) == 0u) { if (xb_ld(&(bar)[XB_TMO])) break; if (_sp > XB_SPIN_CAP) { atomicAdd(&(bar)[XB_TMO], 1u); break; } } } } while (0)
struct XcdBarrier { unsigned* bar; unsigned x; volatile LAS unsigned* st; };
__device__ __forceinline__ XcdBarrier xcd_barrier_post(unsigned* bar, volatile LAS unsigned* st) {
    XcdBarrier b; b.bar = bar; b.x = xb_xcc_id(); b.st = st;
    if (threadIdx.x == 0) (void)xb_add(&bar[XB_XCNT(b.x)], 1u);
    return b;
}
__device__ __forceinline__ void xcd_barrier_complete(unsigned* bar, unsigned x, unsigned& nloc, unsigned& nx) {
    const unsigned G = gridDim.x * gridDim.y * gridDim.z;
    unsigned sum, cnt, mine, sp = 0u;
    for (;;) {
        sum = 0u; cnt = 0u; mine = 0u;
#pragma unroll
        for (unsigned j = 0; j < 16; ++j) { const unsigned c = xb_ld(&bar[XB_XCNT(j)]); sum += c; cnt += (c > 0u) ? 1u : 0u; mine = (j == x) ? c : mine; }
        if (sum == G) break;
        __builtin_amdgcn_s_sleep(1);
        if ((++sp & 255u) == 0u) { if (xb_ld(&bar[XB_TMO])) break; if (sp > XB_SPIN_CAP) { atomicAdd(&bar[XB_TMO], 1u); break; } }
    }
    nloc = mine > 0u ? mine : 1u; nx = cnt > 0u ? cnt : 1u;
}
__device__ __forceinline__ void xcd_barrier(const XcdBarrier& b) {
    asm volatile("s_waitcnt vmcnt(0)" ::: "memory");
    __syncthreads();
    if (threadIdx.x == 0) {
        unsigned* bar = b.bar;
        __builtin_amdgcn_s_waitcnt(0);
        unsigned nloc = b.st[0], nx = b.st[1];
        if (nloc == 0u) { xcd_barrier_complete(bar, b.x, nloc, nx); b.st[0] = nloc; b.st[1] = nx; }
        const unsigned old = xb_add(&bar[XB_XSUB(b.x)], 1u);
        const unsigned gen = old / nloc;
        if (old + 1u == (gen + 1u) * nloc) {
            __builtin_amdgcn_fence(__ATOMIC_RELEASE, "agent");
            asm volatile("s_waitcnt vmcnt(0)" ::: "memory");
            const unsigned og = xb_add(&bar[XB_TOP], 1u);
            const unsigned tg = og / nx;
            if (og + 1u == (tg + 1u) * nx) xb_add(&bar[XB_TOPGEN], 1u);
            else XB_SPIN(xb_ld(&bar[XB_TOPGEN]) == tg, bar);
            __builtin_amdgcn_fence(__ATOMIC_ACQUIRE, "agent");
            xb_add(&bar[XB_XGEN(b.x)], 1u);
            asm volatile("s_waitcnt vmcnt(0)" ::: "memory");
        } else {
            XB_SPIN(xb_ld(&bar[XB_XGEN(b.x)]) == gen, bar);
            __builtin_amdgcn_fence(__ATOMIC_ACQUIRE, "agent");
            asm volatile("s_waitcnt vmcnt(0)" ::: "memory");
        }
    }
    __syncthreads();
}

__global__ void __launch_bounds__(512) fwd_megakernel(Params P) {
    extern __shared__ __attribute__((aligned(16))) unsigned char lds_raw[];
    LAS unsigned char* lds = (LAS unsigned char*)lds_raw;
    cg::grid_group grid = cg::this_grid();
    const int G = gridDim.x, NGW = G * 8;
#define PHASE_IDS() int tid_ = threadIdx.x; asm volatile("" : "+v"(tid_)); const int lane = tid_ & 63, wave = __builtin_amdgcn_readfirstlane(tid_ >> 6), gw = blockIdx.x * 8 + wave
    unsigned char* ws = P.ws;
    bf16_t* ACT = (bf16_t*)(ws + WS_ACT); bf16_t* PROJ = (bf16_t*)(ws + WS_PROJ);
    pg8::StaticOrder S;
    unsigned long long pt_acc = 0, pt_last = 0;
    volatile LAS unsigned* MISC = (volatile LAS unsigned*)(lds + 139264);
    if (threadIdx.x < 16) MISC[threadIdx.x] = 0u;
    __syncthreads();
    const XcdBarrier xbar = xcd_barrier_post((unsigned*)(ws + WS_CTL), MISC + 8);
#define GRID_BAR() xcd_barrier(xbar)

    PT_B(0);
    { PHASE_IDS(); p0_prologue(P, lds, gw, NGW, wave, lane); }
    if (P.ws == nullptr) grid.sync();
    GRID_BAR();
    PT_E(0);
    PT_B(1);
    { pg8::Gemm g{ACT, (const bf16_t*)(ws + WS_WIN), MROWS, LDP, 2048, 2048}; S.init(MROWS, LDP, G, blockIdx.x);
      Epi<EP_BF16> E{PROJ, nullptr, LDP, nullptr, nullptr, nullptr, nullptr}; pg8::gemm_phase(lds, g, S, E); }
    {
      const int nwg = (MROWS / 256) * (LDP / 256), rem = nwg % G; const bool is_short = (rem == 0) || ((int)blockIdx.x >= rem);
      const int nshort = (rem == 0) ? G : G - rem, sidx = (rem == 0) ? (int)blockIdx.x : (int)blockIdx.x - rem;
      if (is_short) { PHASE_IDS(); (void)gw; transpose_range(P, (LAS float*)(lds + wave * 16384), TR_IN_ITEMS, TR_ALL_ITEMS, sidx * 8 + wave, nshort * 8, lane); } }
    GRID_BAR();
    PT_E(1);
    PT_B(2);
    { PHASE_IDS(); p2_prep(P, gw, NGW, lane); }
    GRID_BAR();
    PT_E(2);
    PT_B(3);
    { pg8::Gemm g{PROJ + C_CKV, (const bf16_t*)(ws + WS_WKV), MROWS, 2048, 512, LDP}; S.init(MROWS, 2048, G, blockIdx.x);
      Epi<EP_KV> E{ACT, nullptr, 1024, nullptr, nullptr, ACT + (size_t)MROWS * 1024, nullptr}; pg8::gemm_phase(lds, g, S, E); }
    __syncthreads();
    PT_E(3);
    PT_B(4);
    delta_prep(P, lds);
    GRID_BAR();
    PT_E(4);
    PT_B(5);
    delta_scan(P, lds);
    __syncthreads();
    PT_E(5);
    PT_B(6);
    mla_attention(P, lds);
    GRID_BAR();
    PT_E(6);
    PT_B(8);
    { pg8::Gemm g{PROJ + C_Q, (const bf16_t*)(ws + WS_WA), MROWS, 2048, 2048, LDP}; S.init(MROWS, 2048, G, blockIdx.x);
      Epi<EP_YAB> E{ACT, nullptr, DM, PROJ, nullptr, nullptr, nullptr}; pg8::gemm_phase(lds, g, S, E); }
    GRID_BAR();
    PT_E(8);
    PT_B(9);
    { pg8::Gemm g{ACT, (const bf16_t*)(ws + WS_WOUT), MROWS, 2048, 2048, 2048}; S.init(MROWS, 2048, G, blockIdx.x);
      Epi<EP_X1> E{(bf16_t*)(ws + WS_XB), nullptr, DM, nullptr, (const float*)P.in[0], nullptr, (float*)(ws + WS_SSQ1)}; pg8::gemm_phase(lds, g, S, E); }
    GRID_BAR();
    PT_E(9);
    PT_B(11);
    { pg8::Gemm g{(const bf16_t*)(ws + WS_XB), (const bf16_t*)(ws + WS_WUP), MROWS, DFF, 2048, 2048}; S.init(MROWS, DFF, G, blockIdx.x);
      Epi<EP_RELU2> E{PROJ, nullptr, DFF, nullptr, nullptr, nullptr, (float*)(ws + WS_SSQ1)}; pg8::gemm_phase(lds, g, S, E); }
    { pg8::Gemm g{(const bf16_t*)(ws + WS_PBF), (const bf16_t*)(ws + WS_WPLE), MROWS, 2048, 256, 256}; S.init(MROWS, 2048, G, blockIdx.x);
      Epi<EP_BF16> E{ACT, nullptr, DM, nullptr, nullptr, nullptr, nullptr}; pg8::gemm_phase(lds, g, S, E); }
    GRID_BAR();
    PT_E(11);
    PT_B(12);
    { pg8::Gemm g{PROJ, (const bf16_t*)(ws + WS_WDN), MROWS, 2048, DFF, DFF}; S.init(MROWS, 2048, G, blockIdx.x);
      Epi<EP_ACC> E{(bf16_t*)(ws + WS_XB), nullptr, DM, nullptr, nullptr, nullptr, (float*)(ws + WS_SSQ2)}; pg8::gemm_phase(lds, g, S, E); }
    GRID_BAR();
    PT_E(12);
    PT_B(14);
    { pg8::Gemm g{(const bf16_t*)(ws + WS_XB), (const bf16_t*)(ws + WS_WPG), MROWS, 2048, 2048, 2048}; S.init(MROWS, 2048, G, blockIdx.x);
      Epi<EP_PLE> E{nullptr, P.out, DM, ACT, nullptr, (bf16_t*)(ws + WS_XB), (float*)(ws + WS_SSQ2)}; pg8::gemm_phase(lds, g, S, E); }
    PT_E(14);
    if (PROBE_MASK != 0u && blockIdx.x == 0) { const unsigned long long t_end = __builtin_amdgcn_s_memrealtime() + (unsigned long long)PROBE_MULT * pt_acc;
        while (__builtin_amdgcn_s_memrealtime() < t_end) __builtin_amdgcn_s_sleep(8); }
}

extern "C" void kernel_launch(void* const* d_in, const int* in_sizes, int n_in, void* d_out, int out_size, void* d_ws, size_t ws_size, hipStream_t stream) {
    static int grid = 0;
    if (grid == 0) {
        if (n_in != 24 || out_size != MROWS * DM || ws_size < WS_END) { fprintf(stderr, "kernel_launch: unexpected shapes: n_in %d out %d ws %zu (need %zu)\n", n_in, out_size, ws_size, (size_t)WS_END); grid = -1; return; }
        int dev = 0, cus = 0, per_cu = 0;
        if (hipGetDevice(&dev) != hipSuccess || hipDeviceGetAttribute(&cus, hipDeviceAttributeMultiprocessorCount, dev) != hipSuccess) { grid = -1; return; }
        if (hipFuncSetAttribute((const void*)fwd_megakernel, hipFuncAttributeMaxDynamicSharedMemorySize, LDS_BYTES) != hipSuccess) { fprintf(stderr, "kernel_launch: hipFuncSetAttribute failed\n"); grid = -1; return; }
        if (hipOccupancyMaxActiveBlocksPerMultiprocessor(&per_cu, (const void*)fwd_megakernel, 512, LDS_BYTES) != hipSuccess || per_cu < 1) { fprintf(stderr, "kernel_launch: occupancy query gave %d\n", per_cu); per_cu = 1; }
        (void)hipGetLastError();
        grid = cus * per_cu;
        fprintf(stderr, "kernel_launch: grid %d (cus %d x %d), ws %zu\n", grid, cus, per_cu, ws_size);
    }
    if (grid < 0) return;
    Params p{};
    for (int i = 0; i < 24; ++i) p.in[i] = d_in[i];
    p.out = (float*)d_out; p.ws = (unsigned char*)d_ws;
    for (int i = 0; i < 32; ++i) p.ropeinv[i] = (float)pow(10000.0, -(double)i / 32.0);
    if (hipMemsetAsync((char*)d_ws + WS_CTL, 0, CTL_BYTES, stream) != hipSuccess) { fprintf(stderr, "kernel_launch: hipMemsetAsync failed\n"); return; }
    void* args[] = {&p};
    hipError_t e = hipLaunchCooperativeKernel((const void*)fwd_megakernel, dim3(grid), dim3(512), args, LDS_BYTES, stream);
    if (e != hipSuccess) fprintf(stderr, "kernel_launch: cooperative launch failed: %s (grid %d)\n", hipGetErrorString(e), grid);
}
```

```cpp
#include <hip/hip_runtime.h>
#include <hip/hip_cooperative_groups.h>
#include <cstdio>
#include <cstdint>
#include <cmath>
namespace cg = cooperative_groups;
#ifndef PROBE_MASK
#define PROBE_MASK 0u
#endif
#define PROBE_MULT 3
#define PT_B(bit) do { if ((PROBE_MASK >> (bit)) & 1u) { __builtin_amdgcn_s_waitcnt(0); pt_last = __builtin_amdgcn_s_memrealtime(); } } while (0)
#define PT_E(bit) do { if ((PROBE_MASK >> (bit)) & 1u) { __builtin_amdgcn_s_waitcnt(0); pt_acc += __builtin_amdgcn_s_memrealtime() - pt_last; } } while (0)

#define LAS __attribute__((address_space(3)))
typedef unsigned short bf16_t;
typedef short bf16x8 __attribute__((ext_vector_type(8)));
typedef float f32x4 __attribute__((ext_vector_type(4)));
typedef float f32x2 __attribute__((ext_vector_type(2)));
typedef unsigned u32x4 __attribute__((ext_vector_type(4)));
typedef unsigned u32x2 __attribute__((ext_vector_type(2)));

constexpr int NB = 16, SEQ = 2048, MROWS = NB * SEQ, DM = 2048, LDP = 10496, DFF = 8192, PLE = 256;
constexpr int C_Q = 0, C_K = 1024, C_V = 2048, C_Z = 3072, C_MQ = 4096, C_CKV = 5632, C_GA = 6144, C_GB = 8192, C_KR = 10240, C_BETA = 10304, C_ALPHA = 10312;
constexpr int D_IN = 10320;
constexpr float EPS = 1e-6f;
constexpr float LOG2E = 1.4426950408889634f;
constexpr size_t MiB = 1u << 20;
constexpr size_t WS_WIN = 0, WS_WKV = 41 * MiB, WS_WA = 43 * MiB, WS_WB = 47 * MiB, WS_WOUT = 51 * MiB, WS_WUP = 59 * MiB, WS_WDN = 91 * MiB, WS_WPG = 123 * MiB,
                 WS_WPLE = 131 * MiB, WS_PBF = 132 * MiB, WS_G = 148 * MiB, WS_BETA = 149 * MiB, WS_QKM = 150 * MiB, WS_ACT = 182 * MiB, WS_PROJ = 310 * MiB,
                 WS_GL = 966 * MiB, WS_CTL = 967 * MiB, WS_END = 968 * MiB;
constexpr size_t CTL_BYTES = 1 * MiB;
constexpr size_t WS_SSQ1 = WS_CTL + 256 * 1024, WS_SSQ2 = WS_CTL + 512 * 1024;
constexpr size_t WS_XB = WS_PROJ + 512 * MiB;
constexpr int LDS_BYTES = 147456;

__device__ __forceinline__ float bf2f(bf16_t v) { return __uint_as_float((unsigned)v << 16); }
__device__ __forceinline__ float bflo(unsigned w) { return __uint_as_float(w << 16); }
__device__ __forceinline__ float bfhi(unsigned w) { return __uint_as_float(w & 0xffff0000u); }
__device__ __forceinline__ unsigned pk2(float lo, float hi) { unsigned r; asm("v_cvt_pk_bf16_f32 %0, %1, %2" : "=v"(r) : "v"(lo), "v"(hi)); return r; }
__device__ __forceinline__ bf16_t f2bf(float f) { return (bf16_t)(pk2(f, 0.f) & 0xffffu); }
__device__ __forceinline__ float wave_sum(float v) {
#pragma unroll
    for (int o = 1; o < 64; o <<= 1) v += __shfl_xor(v, o);
    return v;
}
__device__ __forceinline__ float fast_sigmoid(float x) { return __builtin_amdgcn_rcpf(1.f + __builtin_amdgcn_exp2f(-x * LOG2E)); }
__device__ __forceinline__ float silu_f(float x) { return x * fast_sigmoid(x); }
#define LDS_WAIT() asm volatile("s_waitcnt lgkmcnt(0)" ::: "memory")

namespace pg8 {
constexpr int BM = 256, BK = 64, HALF = 128, HTB = HALF * BK * 2, STAGE_BYTES = 8 * HTB, NXCD = 8, WGM = 8;
__host__ __device__ __forceinline__ int lds_byte(int r, int c) { const int st = (r >> 4) * 2 + (c >> 5), rr = r & 15, cc = c & 31, ob = rr * 64 + cc * 2; return st * 1024 + (ob ^ (((ob >> 9) & 1) << 5)); }
__host__ __device__ __forceinline__ void stage_rc(int b, int& R, int& C) { const int st = b / 1024, sb = b % 1024, swz = sb ^ (((sb >> 9) & 1) << 5); R = (st >> 1) * 16 + swz / 64; C = (st & 1) * 32 + (swz % 64) / 2; }
__host__ __device__ __forceinline__ int perm32(int rho) { const int n = rho >> 4, i = rho & 15; return 8 * (i >> 2) + 4 * n + (i & 3); }
struct Unit { int pm, pn; };
struct Gemm { const bf16_t* A; const bf16_t* Bt; int M, N, K, lda; };
struct StaticOrder {
    int nM, nN, nwg, G, c;
    __device__ void init(int M, int N, int G_, int c_) { nM = M / BM; nN = N / BM; nwg = nM * nN; G = G_; c = c_; }
    __device__ bool next(int i, Unit& u) const {
        const long L = (long)i * G + c; if (L >= nwg) return false;
        int wgid = (int)L; { const int q = nwg / NXCD, r = nwg % NXCD, xcd = wgid % NXCD, off = wgid / NXCD; wgid = (xcd < r ? xcd * (q + 1) : r * (q + 1) + (xcd - r) * q) + off; }
        const int nig = WGM * nN, gid = wgid / nig, fm = gid * WGM, gsz = (nM - fm) < WGM ? (nM - fm) : WGM;
        u.pm = fm + ((wgid % nig) % gsz); u.pn = (wgid % nig) / gsz; return true;
    }
};
template <class Epi>
__device__ __forceinline__ void gemm_phase(LAS unsigned char* lds, const Gemm g, const StaticOrder& S, const Epi& E) {
    int tid = threadIdx.x; asm volatile("" : "+v"(tid));
    const int wid = __builtin_amdgcn_readfirstlane(tid >> 6), lane = tid & 63, wr = wid >> 2, wc = wid & 3, fr = lane & 15, fq = lane >> 4;
    const int K = g.K, nt = K / BK, lda = g.lda;
    unsigned voffA[2], voffB[2];
#pragma unroll
    for (int i = 0; i < 2; ++i) { int R, C; stage_rc(tid * 16 + i * 8192, R, C); const int Rb = ((R & ~31) + perm32(R & 31));
        voffA[i] = (unsigned)(R * lda + C) * 2u; voffB[i] = (unsigned)(Rb * K + C) * 2u; }
    const size_t kstep = (size_t)(BK * 2);
    const size_t hstepA = (size_t)HALF * lda * 2, tstepA = 2 * hstepA, hstepB = (size_t)HALF * K * 2, tstepB = 2 * hstepB;
    const unsigned ldsw = (unsigned)wid * 1024u;
    const int aoff = lds_byte(wr * 64 + fr, fq * 8), boff = lds_byte(wc * 32 + fr, fq * 8);
#define PG8_SA(b, h) (((b) * 2 + (h)) * HTB)
#define PG8_SB(b, h) ((4 + (b) * 2 + (h)) * HTB)
#define PG8_STAGE(bufoff, gbase, voff) do { _Pragma("unroll") for (int _i = 0; _i < 2; ++_i) \
        __builtin_amdgcn_global_load_lds((const unsigned*)((const char*)(gbase) + (voff)[_i]), (LAS unsigned*)(lds + (bufoff) + ldsw + _i * 8192), 16, 0, 0); } while (0)
#define PG8_LDA(dst, b, h) do { _Pragma("unroll") for (int m = 0; m < 4; ++m) _Pragma("unroll") for (int k = 0; k < 2; ++k) dst[m][k] = *(const LAS bf16x8*)(lds + PG8_SA(b, h) + aoff + m * 2048 + k * 1024); } while (0)
#define PG8_LDB(dst, b, h) do { _Pragma("unroll") for (int n = 0; n < 2; ++n) _Pragma("unroll") for (int k = 0; k < 2; ++k) dst[n][k] = *(const LAS bf16x8*)(lds + PG8_SB(b, h) + boff + n * 2048 + k * 1024); } while (0)
#define PG8_MMA(ai, bj, At, Bt) do { __builtin_amdgcn_s_setprio(1); _Pragma("unroll") for (int m = 0; m < 4; ++m) _Pragma("unroll") for (int n = 0; n < 2; ++n) _Pragma("unroll") for (int k = 0; k < 2; ++k) { \
        if constexpr (Epi::SWAP1 && (bj) == 1) acc[ai][bj][m][n] = __builtin_amdgcn_mfma_f32_16x16x32_bf16(At[m][k], Bt[n][k], acc[ai][bj][m][n], 0, 0, 0); \
        else acc[ai][bj][m][n] = __builtin_amdgcn_mfma_f32_16x16x32_bf16(Bt[n][k], At[m][k], acc[ai][bj][m][n], 0, 0, 0); } __builtin_amdgcn_s_setprio(0); } while (0)
#define PG8_WAIT_V(n) asm volatile("s_waitcnt vmcnt(" #n ")" ::: "memory")
#define PG8_WAIT_L(n) asm volatile("s_waitcnt lgkmcnt(" #n ")" ::: "memory")
#define PG8_BAR __builtin_amdgcn_s_barrier()
#define PG8_SCHED __builtin_amdgcn_sched_barrier(0)
    Unit cur, nxt; int ui = 0;
    if (!S.next(0, cur)) return;
    f32x4 acc[2][2][4][2];
#pragma unroll
    for (int a = 0; a < 2; ++a)
#pragma unroll
        for (int b = 0; b < 2; ++b)
#pragma unroll
            for (int m = 0; m < 4; ++m)
#pragma unroll
                for (int n = 0; n < 2; ++n) acc[a][b][m][n] = (f32x4){0.f, 0.f, 0.f, 0.f};
    bf16x8 At[4][2], B0[2][2], B1[2][2];
    const char* cA = (const char*)g.A + (size_t)cur.pm * tstepA; const char* cB = (const char*)g.Bt + (size_t)cur.pn * tstepB;
    PG8_STAGE(PG8_SB(0, 0), cB, voffB); PG8_STAGE(PG8_SB(0, 1), cB + hstepB, voffB); PG8_STAGE(PG8_SA(0, 0), cA, voffA); PG8_STAGE(PG8_SA(0, 1), cA + hstepA, voffA);
    if (wr == 1) PG8_BAR;
    PG8_WAIT_V(2); PG8_BAR;
    PG8_STAGE(PG8_SB(1, 0), cB + kstep, voffB); PG8_STAGE(PG8_SA(1, 0), cA + kstep, voffA); PG8_STAGE(PG8_SB(1, 1), cB + hstepB + kstep, voffB);
    PG8_WAIT_V(6); PG8_BAR;
    for (;;) {
        const bool has_next = S.next(ui + 1, nxt);
        const char* nA = has_next ? (const char*)g.A + (size_t)nxt.pm * tstepA : cA; const char* nB = has_next ? (const char*)g.Bt + (size_t)nxt.pn * tstepB : cB;
        for (int t = 0; t < nt; t += 2) {
            if constexpr (Epi::MID_T > 0) { if (t == Epi::MID_T) E.mid(acc, cur, wr, wc, fr, fq); }
            const bool last = (t == nt - 2);
            const char* a1 = cA + (size_t)(t + 1) * kstep;
            const char* a2 = last ? nA : cA + (size_t)(t + 2) * kstep; const char* b2 = last ? nB : cB + (size_t)(t + 2) * kstep;
            const char* a3 = a2 + kstep; const char* b3 = b2 + kstep;
            PG8_LDB(B0, 0, 0); PG8_LDB(B1, 0, 1); PG8_SCHED; PG8_LDA(At, 0, 0); PG8_STAGE(PG8_SA(1, 1), a1 + hstepA, voffA);
            PG8_WAIT_V(8); PG8_WAIT_L(0); PG8_BAR; PG8_MMA(0, 0, At, B0); PG8_MMA(0, 1, At, B1); PG8_BAR; PG8_SCHED;
            PG8_LDA(At, 0, 1); PG8_STAGE(PG8_SB(0, 0), b2, voffB); PG8_STAGE(PG8_SB(0, 1), b2 + hstepB, voffB); PG8_STAGE(PG8_SA(0, 0), a2, voffA);
            PG8_WAIT_V(8); PG8_WAIT_L(0); PG8_BAR; PG8_MMA(1, 0, At, B0); PG8_MMA(1, 1, At, B1); PG8_BAR; PG8_SCHED;
            PG8_LDB(B0, 1, 0); PG8_LDB(B1, 1, 1); PG8_SCHED; PG8_LDA(At, 1, 0); PG8_STAGE(PG8_SA(0, 1), a2 + hstepA, voffA);
            PG8_WAIT_V(8); PG8_WAIT_L(0); PG8_BAR; PG8_MMA(0, 0, At, B0); PG8_MMA(0, 1, At, B1); PG8_BAR; PG8_SCHED;
            PG8_LDA(At, 1, 1); PG8_STAGE(PG8_SB(1, 0), b3, voffB); PG8_STAGE(PG8_SB(1, 1), b3 + hstepB, voffB); PG8_STAGE(PG8_SA(1, 0), a3, voffA);
            PG8_WAIT_V(8); PG8_WAIT_L(0); PG8_BAR; PG8_MMA(1, 0, At, B0); PG8_MMA(1, 1, At, B1); PG8_BAR; PG8_SCHED;
        }
        if (wr == 0) PG8_BAR;
        E(acc, cur, wr, wc, fr, fq);
        if (!has_next) break;
#pragma unroll
        for (int a = 0; a < 2; ++a)
#pragma unroll
            for (int b = 0; b < 2; ++b)
#pragma unroll
                for (int m = 0; m < 4; ++m)
#pragma unroll
                    for (int n = 0; n < 2; ++n) acc[a][b][m][n] = (f32x4){0.f, 0.f, 0.f, 0.f};
        cur = nxt; cA = nA; cB = nB; ++ui;
        if (wr == 1) PG8_BAR;
    }
    PG8_WAIT_V(0);
    PG8_BAR;
#undef PG8_SA
#undef PG8_SB
#undef PG8_STAGE
#undef PG8_LDA
#undef PG8_LDB
#undef PG8_MMA
#undef PG8_WAIT_V
#undef PG8_WAIT_L
#undef PG8_BAR
#undef PG8_SCHED
}
}

enum { EP_BF16 = 0, EP_KV, EP_YA, EP_YB, EP_X1, EP_RELU2, EP_ACC, EP_F32, EP_PLE, EP_YAB };
__device__ __forceinline__ void store8bf(bf16_t* p, f32x4 a, f32x4 b) { u32x4 w; w.x = pk2(a[0], a[1]); w.y = pk2(a[2], a[3]); w.z = pk2(b[0], b[1]); w.w = pk2(b[2], b[3]); *(u32x4*)p = w; }
__device__ __forceinline__ void load8bf(const bf16_t* p, f32x4& a, f32x4& b) { const u32x4 w = *(const u32x4*)p; a = (f32x4){bflo(w.x), bfhi(w.x), bflo(w.y), bfhi(w.y)}; b = (f32x4){bflo(w.z), bfhi(w.z), bflo(w.w), bfhi(w.w)}; }
__device__ __forceinline__ f32x4 sig4(f32x4 v) { return (f32x4){fast_sigmoid(v[0]), fast_sigmoid(v[1]), fast_sigmoid(v[2]), fast_sigmoid(v[3])}; }
template <int MODE> struct Epi {
    static constexpr bool SWAP1 = (MODE == EP_KV);
    static constexpr int MID_T = (MODE == EP_YAB) ? 16 : 0;
    bf16_t* ob; float* of; int ldc; const bf16_t* gate; const float* res; bf16_t* vt; float* ssq;
    __device__ __forceinline__ void mid(f32x4 (&acc)[2][2][4][2], const pg8::Unit& u, int wr, int wc, int fr, int fq) const {
        int rowb = u.pm * 256 + wr * 64 + fr, col0 = u.pn * 256 + wc * 32 + 8 * fq;
        asm volatile("" : "+v"(rowb), "+v"(col0));
        u32x4 ga[2], gb[2];
        ga[0] = *(const u32x4*)(gate + (size_t)rowb * LDP + C_GA + col0); gb[0] = *(const u32x4*)(gate + (size_t)rowb * LDP + C_GB + col0);
#pragma unroll
        for (int st = 0; st < 16; ++st) {
            const int it = st >> 1, bj = st & 1, ai = it >> 2, m = it & 3;
            if (st + 1 < 16) { const int itn = (st + 1) >> 1, bjn = (st + 1) & 1; const size_t off = (size_t)(rowb + (itn >> 2) * 128 + (itn & 3) * 16) * LDP + col0 + bjn * 128;
                ga[(st + 1) & 1] = *(const u32x4*)(gate + off + C_GA); gb[(st + 1) & 1] = *(const u32x4*)(gate + off + C_GB); }
            f32x4 a0, a1, b0, b1; up8(ga[st & 1], a0, a1); up8(gb[st & 1], b0, b1);
#pragma unroll
            for (int e = 0; e < 4; ++e) {
                acc[ai][bj][m][0][e] *= (1.f + __builtin_amdgcn_exp2f(-b0[e] * LOG2E)) * __builtin_amdgcn_rcpf(1.f + __builtin_amdgcn_exp2f(-a0[e] * LOG2E));
                acc[ai][bj][m][1][e] *= (1.f + __builtin_amdgcn_exp2f(-b1[e] * LOG2E)) * __builtin_amdgcn_rcpf(1.f + __builtin_amdgcn_exp2f(-a1[e] * LOG2E)); }
            asm volatile("" ::: "memory");
        }
    }
    struct Pre { f32x4 f[2][2]; u32x4 g[2]; u32x4 y[2]; };
    __device__ __forceinline__ void preload(Pre& p, int row, int col0) const {
#pragma unroll
        for (int bj = 0; bj < 2; ++bj) { const int col = col0 + bj * 128;
            if constexpr (MODE == EP_YA) p.g[bj] = *(const u32x4*)(gate + (size_t)row * LDP + C_GA + col);
            else if constexpr (MODE == EP_YAB) p.g[bj] = *(const u32x4*)(gate + (size_t)row * LDP + C_GB + col);
            else if constexpr (MODE == EP_YB) { p.g[bj] = *(const u32x4*)(gate + (size_t)row * LDP + C_GB + col); p.y[bj] = *(const u32x4*)(ob + (size_t)row * DM + col); }
            else if constexpr (MODE == EP_X1) { const float* r = res + (size_t)row * DM + col; p.f[bj][0] = *(const f32x4*)r; p.f[bj][1] = *(const f32x4*)(r + 4); }
            else if constexpr (MODE == EP_ACC) p.y[bj] = *(const u32x4*)(ob + (size_t)row * DM + col);
            else if constexpr (MODE == EP_PLE) { p.y[bj] = *(const u32x4*)(vt + (size_t)row * DM + col); p.g[bj] = *(const u32x4*)(gate + (size_t)row * DM + col); }
        }
    }
    static __device__ __forceinline__ void up8(const u32x4 w, f32x4& a, f32x4& b) { a = (f32x4){bflo(w.x), bfhi(w.x), bflo(w.y), bfhi(w.y)}; b = (f32x4){bflo(w.z), bfhi(w.z), bflo(w.w), bfhi(w.w)}; }
    __device__ __forceinline__ void operator()(const f32x4 (&acc)[2][2][4][2], const pg8::Unit& u, int wr, int wc, int fr, int fq) const {
        const int rowb = u.pm * 256 + wr * 64 + fr, col0 = u.pn * 256 + wc * 32 + 8 * fq;
        float rs[8];
        if constexpr (MODE == EP_RELU2 || MODE == EP_PLE) {
#pragma unroll
            for (int it = 0; it < 8; ++it) rs[it] = ssq[rowb + (it >> 2) * 128 + (it & 3) * 16];
#pragma unroll
            for (int it = 0; it < 8; ++it) rs[it] = rsqrtf(rs[it] * (1.f / 2048.f) + EPS);
        }
        Pre pre[2];
        preload(pre[0], rowb, col0);
#pragma unroll
        for (int it = 0; it < 8; ++it) {
            const int ai = it >> 2, m = it & 3, row = rowb + ai * 128 + m * 16;
            if (it + 1 < 8) preload(pre[(it + 1) & 1], rowb + ((it + 1) >> 2) * 128 + ((it + 1) & 3) * 16, col0);
            const Pre& pp = pre[it & 1];
            float rsum = 0.f; const float rstd = (MODE == EP_RELU2 || MODE == EP_PLE) ? rs[it] : 1.f;
#pragma unroll
            for (int bj = 0; bj < 2; ++bj) {
                const int col = col0 + bj * 128;
                f32x4 v0 = acc[ai][bj][m][0], v1 = acc[ai][bj][m][1];
                if constexpr (MODE == EP_BF16) { store8bf(ob + (size_t)row * ldc + col, v0, v1); }
                else if constexpr (MODE == EP_RELU2) {
#pragma unroll
                    for (int e = 0; e < 4; ++e) { const float a = fmaxf(v0[e] * rstd, 0.f), b = fmaxf(v1[e] * rstd, 0.f); v0[e] = a * a; v1[e] = b * b; }
                    store8bf(ob + (size_t)row * ldc + col, v0, v1); }
                else if constexpr (MODE == EP_KV) {
                    if (bj == 0) store8bf(ob + (size_t)row * 1024 + u.pn * 128 + wc * 32 + 8 * fq, v0, v1);
                    else {
                        const int r0 = u.pm * 256 + ai * 128 + wr * 64 + m * 16 + 4 * fq, b = r0 >> 11, s = r0 & 2047;
                        bf16_t* base = vt + ((size_t)((b * 8 + u.pn) * 128 + wc * 32)) * 2048 + s;
                        u32x2 w0, w1; w0.x = pk2(v0[0], v0[1]); w0.y = pk2(v0[2], v0[3]); w1.x = pk2(v1[0], v1[1]); w1.y = pk2(v1[2], v1[3]);
                        *(u32x2*)(base + (size_t)pg8::perm32(fr) * 2048) = w0; *(u32x2*)(base + (size_t)pg8::perm32(16 + fr) * 2048) = w1; } }
                else if constexpr (MODE == EP_YA || MODE == EP_YAB) { f32x4 g0, g1; up8(pp.g[bj], g0, g1); store8bf(ob + (size_t)row * DM + col, sig4(g0) * v0, sig4(g1) * v1); }
                else if constexpr (MODE == EP_YB) { f32x4 g0, g1, a0, a1; up8(pp.g[bj], g0, g1); up8(pp.y[bj], a0, a1); store8bf(ob + (size_t)row * DM + col, a0 + sig4(g0) * v0, a1 + sig4(g1) * v1); }
                else if constexpr (MODE == EP_X1 || MODE == EP_ACC) { f32x4 r0, r1;
                    if constexpr (MODE == EP_X1) { r0 = pp.f[bj][0]; r1 = pp.f[bj][1]; } else up8(pp.y[bj], r0, r1);
                    const f32x4 x0 = r0 + v0, x1 = r1 + v1;
                    store8bf(ob + (size_t)row * DM + col, x0, x1);
                    rsum += (x0[0] * x0[0] + x0[1] * x0[1]) + (x0[2] * x0[2] + x0[3] * x0[3]) + (x1[0] * x1[0] + x1[1] * x1[1]) + (x1[2] * x1[2] + x1[3] * x1[3]); }
                else if constexpr (MODE == EP_F32) { float* o = of + (size_t)row * DM + col; *(f32x4*)o = v0; *(f32x4*)(o + 4) = v1; }
                else if constexpr (MODE == EP_PLE) { f32x4 p0, p1, x0, x1; up8(pp.g[bj], p0, p1); up8(pp.y[bj], x0, x1); float* o = of + (size_t)row * DM + col;
                    *(f32x4*)o = x0 + sig4(v0 * rstd) * p0; *(f32x4*)(o + 4) = x1 + sig4(v1 * rstd) * p1; }
            }
            if constexpr (MODE == EP_X1 || MODE == EP_ACC) { rsum += __shfl_xor(rsum, 16); rsum += __shfl_xor(rsum, 32);
                if (fq == 0) __hip_atomic_fetch_add(ssq + row, rsum, __ATOMIC_RELAXED, __HIP_MEMORY_SCOPE_AGENT); }
            asm volatile("" ::: "memory");
        }
    }
};

struct Params { const void* in[24]; float* out; unsigned char* ws; float ropeinv[32]; };

__device__ __forceinline__ int win_map(int n) {
    if (n < 4096) return n;
    if (n < 5632) return 4112 + (n - 4096);
    if (n < 6144) return 5648 + (n - 5632);
    if (n < 8192) return 6224 + (n - 6144);
    if (n < 10240) return 8272 + (n - 8192);
    if (n < 10304) return 6160 + (n - 10240);
    if (n < 10312) return 4096 + (n - 10304);
    if (n < 10320) return 4104 + (n - 10312);
    return -1;
}
struct TrJob { int widx, K, N, nblk, item; };
__device__ __forceinline__ const float* opq(const void* p) { unsigned long long v = (unsigned long long)p; asm volatile("" : "+s"(v)); return (const float*)v; }
__device__ __forceinline__ const float* tr_src(const Params& P, int w) {
    const float* a0 = opq(P.in[4]); const float* a1 = opq(P.in[10]); const float* a2 = opq(P.in[15]); const float* a3 = opq(P.in[16]); const float* a4 = opq(P.in[17]);
    const float* a5 = opq(P.in[19]); const float* a6 = opq(P.in[20]); const float* a7 = opq(P.in[22]); const float* a8 = opq(P.in[23]);
    return w == 0 ? a0 : w == 1 ? a1 : w == 2 ? a2 : w == 3 ? a3 : w == 4 ? a4 : w == 5 ? a5 : w == 6 ? a6 : w == 7 ? a7 : a8; }
__device__ __forceinline__ size_t tr_dst_off(int w) { return w == 0 ? WS_WIN : w == 1 ? WS_WKV : w == 2 ? WS_WA : w == 3 ? (WS_WA + 2048) : w == 4 ? WS_WOUT : w == 5 ? WS_WUP : w == 6 ? WS_WDN : w == 7 ? WS_WPG : WS_WPLE; }
__device__ __forceinline__ void tr_load(const Params& P, const TrJob& J, int lane, f32x4 (&v)[8]) {
    const int kb = J.item / J.nblk, nb = J.item % J.nblk, k0 = 64 * kb, n0 = 32 * nb, q4 = lane & 7, kr = lane >> 3;
    int oc = n0 + 4 * q4; if (J.widx == 0) oc = win_map(oc);
    const float* W = tr_src(P, J.widx);
#pragma unroll
    for (int i = 0; i < 8; ++i) v[i] = (oc >= 0) ? *(const f32x4*)(W + (size_t)(k0 + 8 * i + kr) * J.N + oc) : (f32x4){0.f, 0.f, 0.f, 0.f};
}
__device__ __forceinline__ void tr_finish(const Params& P, const TrJob& J, int lane, const f32x4 (&v)[8], LAS float* scr) {
    const int kb = J.item / J.nblk, nb = J.item % J.nblk, k0 = 64 * kb, n0 = 32 * nb, q4 = lane & 7, kr = lane >> 3;
    const float* kg5 = opq(P.in[18]); const float* kg7 = opq(P.in[21]); const float* kgain = (J.widx == 5) ? kg5 : (J.widx == 7) ? kg7 : nullptr;
    bf16_t* WT = (bf16_t*)(P.ws + tr_dst_off(J.widx));
    const int ldk = (J.widx == 2 || J.widx == 3) ? 2048 : J.K;
#pragma unroll
    for (int i = 0; i < 8; ++i) { LAS float* d = scr + (8 * i + kr) * 33 + 4 * q4; const float kg = kgain ? kgain[k0 + 8 * i + kr] : 1.f; d[0] = v[i][0] * kg; d[1] = v[i][1] * kg; d[2] = v[i][2] * kg; d[3] = v[i][3] * kg; }
    LDS_WAIT();
    const int c = lane & 7;
#pragma unroll
    for (int j = 0; j < 4; ++j) { const int n = (lane >> 3) + 8 * j; const LAS float* sp = scr + (8 * c) * 33 + n;
        u32x4 o; o.x = pk2(sp[0 * 33], sp[1 * 33]); o.y = pk2(sp[2 * 33], sp[3 * 33]); o.z = pk2(sp[4 * 33], sp[5 * 33]); o.w = pk2(sp[6 * 33], sp[7 * 33]);
        *(u32x4*)(WT + (size_t)(n0 + n) * ldk + k0 + 8 * c) = o; }
    LDS_WAIT();
}
__device__ __forceinline__ void rmsnorm_row(const float* xrow, const float* gain, bf16_t* orow, int lane) {
    const f32x4* xr = (const f32x4*)xrow + lane; const f32x4* gr = (const f32x4*)gain + lane;
    f32x4 v[8]; float s = 0.f;
#pragma unroll
    for (int j = 0; j < 8; ++j) { v[j] = xr[64 * j]; s += (v[j][0] * v[j][0] + v[j][1] * v[j][1]) + (v[j][2] * v[j][2] + v[j][3] * v[j][3]); }
    const float rstd = rsqrtf(wave_sum(s) * (1.f / 2048.f) + EPS);
    u32x2* o8 = (u32x2*)orow + lane;
#pragma unroll
    for (int j = 0; j < 8; ++j) { const f32x4 g = gr[64 * j]; u32x2 w; w.x = pk2(v[j][0] * rstd * g[0], v[j][1] * rstd * g[1]); w.y = pk2(v[j][2] * rstd * g[2], v[j][3] * rstd * g[3]); o8[64 * j] = w; }
}
__device__ __forceinline__ void rmsnorm_rows_phase(const float* X, const float* gain, bf16_t* O, int gw, int NGW, int lane) {
    for (int m = gw; m < MROWS / 2; m += NGW) {
        const f32x4* x0 = (const f32x4*)(X + (size_t)m * DM) + lane; const f32x4* x1 = (const f32x4*)(X + (size_t)(m + MROWS / 2) * DM) + lane; const f32x4* gr = (const f32x4*)gain + lane;
        f32x4 a[8], b[8]; float sa = 0.f, sb = 0.f;
#pragma unroll
        for (int j = 0; j < 8; ++j) { a[j] = x0[64 * j]; b[j] = x1[64 * j]; }
#pragma unroll
        for (int j = 0; j < 8; ++j) { sa += (a[j][0] * a[j][0] + a[j][1] * a[j][1]) + (a[j][2] * a[j][2] + a[j][3] * a[j][3]); sb += (b[j][0] * b[j][0] + b[j][1] * b[j][1]) + (b[j][2] * b[j][2] + b[j][3] * b[j][3]); }
        const float ra = rsqrtf(wave_sum(sa) * (1.f / 2048.f) + EPS), rb = rsqrtf(wave_sum(sb) * (1.f / 2048.f) + EPS);
        u32x2* oa = (u32x2*)(O + (size_t)m * DM) + lane; u32x2* ob = (u32x2*)(O + (size_t)(m + MROWS / 2) * DM) + lane;
#pragma unroll
        for (int j = 0; j < 8; ++j) { const f32x4 g = gr[64 * j]; u32x2 w; w.x = pk2(a[j][0] * ra * g[0], a[j][1] * ra * g[1]); w.y = pk2(a[j][2] * ra * g[2], a[j][3] * ra * g[3]); oa[64 * j] = w;
            w.x = pk2(b[j][0] * rb * g[0], b[j][1] * rb * g[1]); w.y = pk2(b[j][2] * rb * g[2], b[j][3] * rb * g[3]); ob[64 * j] = w; }
    }
}

__device__ __forceinline__ TrJob tr_job(int it) {
    constexpr int I_IN = 32 * (LDP / 32), I_KV = 8 * 64, I_A = 16 * 64, I_B = 16 * 64, I_OUT = 32 * 64, I_UP = 32 * 256, I_DN = 128 * 64, I_PG = 32 * 64;
    int r = it;
    if (r < I_IN) return TrJob{0, 2048, D_IN, LDP / 32, r}; r -= I_IN;
    if (r < I_KV) return TrJob{1, 512, 2048, 64, r}; r -= I_KV;
    if (r < I_A) return TrJob{2, 1024, 2048, 64, r}; r -= I_A;
    if (r < I_B) return TrJob{3, 1024, 2048, 64, r}; r -= I_B;
    if (r < I_OUT) return TrJob{4, 2048, 2048, 64, r}; r -= I_OUT;
    if (r < I_UP) return TrJob{5, 2048, 8192, 256, r}; r -= I_UP;
    if (r < I_DN) return TrJob{6, 8192, 2048, 64, r}; r -= I_DN;
    if (r < I_PG) return TrJob{7, 2048, 2048, 64, r}; r -= I_PG;
    return TrJob{8, 256, 2048, 64, r};
}
constexpr int TR_IN_ITEMS = 32 * (LDP / 32);
constexpr int TR_ALL_ITEMS = 32 * (LDP / 32) + 8 * 64 + 16 * 64 + 16 * 64 + 32 * 64 + 32 * 256 + 128 * 64 + 32 * 64 + 4 * 64;
__device__ __forceinline__ void transpose_range(const Params& P, LAS float* scr, int lo, int hi, int gw, int NGW, int lane) {
    for (int it = lo + gw; it < hi; it += 2 * NGW) {
        const TrJob J0 = tr_job(it); f32x4 v0[8], v1[8]; tr_load(P, J0, lane, v0);
        const bool two = (it + NGW < hi);
        const TrJob J1 = tr_job(two ? it + NGW : it);
        if (two) tr_load(P, J1, lane, v1);
        tr_finish(P, J0, lane, v0, scr);
        if (two) tr_finish(P, J1, lane, v1, scr);
    }
}
__device__ __forceinline__ void p0_prologue(const Params& P, LAS unsigned char* lds, int gw, int NGW, int wave, int lane) {
    unsigned char* ws = P.ws;
    LAS float* scr = (LAS float*)(lds + wave * 16384);
    transpose_range(P, scr, 0, TR_IN_ITEMS, gw, NGW, lane);
    rmsnorm_rows_phase((const float*)P.in[0], (const float*)P.in[3], (bf16_t*)(ws + WS_ACT), gw, NGW, lane);
    { const f32x4* src = (const f32x4*)P.in[1]; u32x4* dst = (u32x4*)(ws + WS_PBF); const size_t n8 = (size_t)MROWS * PLE / 8;
      for (size_t i = (size_t)gw * 64 + lane; i < n8; i += (size_t)NGW * 64) { const f32x4 a = src[2 * i], b = src[2 * i + 1]; u32x4 w; w.x = pk2(a[0], a[1]); w.y = pk2(a[2], a[3]); w.z = pk2(b[0], b[1]); w.w = pk2(b[2], b[3]); dst[i] = w; } }
}

__device__ __forceinline__ void rope_cs(float pos, float inv, float& c, float& s) {
    const float a = pos * inv;
    double rev = (double)a * 0.15915494309189535; rev -= rint(rev);
    const float r = (float)rev; s = __builtin_amdgcn_sinf(r); c = __builtin_amdgcn_cosf(r);
}
__device__ __forceinline__ void unpack8(const u32x4 w, float (&f)[8]) { f[0] = bflo(w.x); f[1] = bfhi(w.x); f[2] = bflo(w.y); f[3] = bfhi(w.y); f[4] = bflo(w.z); f[5] = bfhi(w.z); f[6] = bflo(w.w); f[7] = bfhi(w.w); }
__device__ __forceinline__ u32x4 pack8(const float (&f)[8]) { u32x4 w; w.x = pk2(f[0], f[1]); w.y = pk2(f[2], f[3]); w.z = pk2(f[4], f[5]); w.w = pk2(f[6], f[7]); return w; }
__device__ __forceinline__ void p2_prep(const Params& P, int gw, int NGW, int lane) {
    unsigned char* ws = P.ws;
    bf16_t* proj = (bf16_t*)(ws + WS_PROJ);
    const int* positions = (const int*)P.in[2];
    const float* ckvn = (const float*)P.in[9]; const float* qng = (const float*)P.in[11]; const float* qrg = (const float*)P.in[12]; const float* kng = (const float*)P.in[13]; const float* krg = (const float*)P.in[14];
    const float* dt_bias = (const float*)P.in[6]; const float* a_log = (const float*)P.in[7];
    float* G = (float*)(ws + WS_G); float* BETA = (float*)(ws + WS_BETA);
    const float QSCALE = 0.07216878364870322f * LOG2E;
    {
        const int h = lane >> 3, seg = lane & 7;
        float gn[16], gr[8], inv8[8], gc8[8];
#pragma unroll
        for (int e = 0; e < 16; ++e) gn[e] = qng[16 * seg + e] * kng[16 * seg + e] * QSCALE;
#pragma unroll
        for (int e = 0; e < 8; ++e) { gr[e] = qrg[8 * seg + e]; inv8[e] = P.ropeinv[8 * (seg & 3) + e]; gc8[e] = ckvn[8 * lane + e]; }
        const float inv1 = P.ropeinv[lane & 31], kr_g = krg[lane];
        for (int m = gw; m < MROWS; m += NGW) {
            bf16_t* row = proj + (size_t)m * LDP;
            bf16_t* np = row + C_MQ + h * 192 + 16 * seg; bf16_t* rp = row + C_MQ + h * 192 + 128 + 8 * seg; bf16_t* cp = row + C_CKV + 8 * lane;
            const u32x4 wn0 = *(const u32x4*)np, wn1 = *(const u32x4*)(np + 8), wr = *(const u32x4*)rp, wc = *(const u32x4*)cp;
            const bf16_t wk = row[C_KR + lane]; const bf16_t wba = (lane < 16) ? row[C_BETA + lane] : (bf16_t)0;
            const float pos = (float)positions[m];
            float a[8], b[8]; unpack8(wn0, a); unpack8(wn1, b);
            float ss = 0.f;
#pragma unroll
            for (int e = 0; e < 8; ++e) ss += a[e] * a[e] + b[e] * b[e];
            ss += __shfl_xor(ss, 1); ss += __shfl_xor(ss, 2); ss += __shfl_xor(ss, 4);
            const float rstd = rsqrtf(ss * (1.f / 128.f) + EPS);
#pragma unroll
            for (int e = 0; e < 8; ++e) { a[e] = a[e] * rstd * gn[e]; b[e] = b[e] * rstd * gn[8 + e]; }
            *(u32x4*)np = pack8(a); *(u32x4*)(np + 8) = pack8(b);
            float x[8]; unpack8(wr, x);
            float s2 = 0.f;
#pragma unroll
            for (int e = 0; e < 8; ++e) s2 += x[e] * x[e];
            s2 += __shfl_xor(s2, 1); s2 += __shfl_xor(s2, 2); s2 += __shfl_xor(s2, 4);
            const float rs2 = rsqrtf(s2 * (1.f / 64.f) + EPS);
#pragma unroll
            for (int e = 0; e < 8; ++e) { const float xn = x[e] * rs2 * gr[e]; const float px = __shfl_xor(xn, 4); float cs, sn; rope_cs(pos, inv8[e], cs, sn);
                x[e] = ((seg < 4) ? (xn * cs - px * sn) : (xn * cs + px * sn)) * QSCALE; }
            *(u32x4*)rp = pack8(x);
            float cv[8]; unpack8(wc, cv);
            float s3 = 0.f;
#pragma unroll
            for (int e = 0; e < 8; ++e) s3 += cv[e] * cv[e];
            const float rs3 = rsqrtf(wave_sum(s3) * (1.f / 512.f) + EPS);
#pragma unroll
            for (int e = 0; e < 8; ++e) cv[e] = cv[e] * rs3 * gc8[e];
            *(u32x4*)cp = pack8(cv);
            { float xk = bf2f(wk); const float rs4 = rsqrtf(wave_sum(xk * xk) * (1.f / 64.f) + EPS); xk = xk * rs4 * kr_g;
              float cs, sn; rope_cs(pos, inv1, cs, sn);
              const float px = __shfl_xor(xk, 32); row[C_KR + lane] = f2bf((lane < 32) ? (xk * cs - px * sn) : (xk * cs + px * sn)); }
            if (lane < 8) BETA[(size_t)m * 8 + lane] = 1.f / (1.f + expf(-bf2f(wba)));
            else if (lane < 16) { const int hh = lane - 8; const float z = bf2f(wba) + dt_bias[hh]; const float sp = (z > 20.f) ? z : log1pf(expf(z)); G[(size_t)m * 8 + hh] = -expf(a_log[hh]) * sp; }
        }
    }
    const float* convw = (const float*)P.in[5];
    bf16_t* QA = (bf16_t*)P.out;
    for (int it = gw; it < (MROWS / 16) * 6; it += NGW) {
        const int run = it / 6, gg = it % 6, m0 = run * 16, s0 = m0 & 2047, c = gg * 512 + 8 * lane;
        float w0[8], w1[8], w2[8], w3[8];
#pragma unroll
        for (int e = 0; e < 8; e += 4) { *(f32x4*)(w0 + e) = *(const f32x4*)(convw + 0 * 3072 + c + e); *(f32x4*)(w1 + e) = *(const f32x4*)(convw + 1 * 3072 + c + e);
                                         *(f32x4*)(w2 + e) = *(const f32x4*)(convw + 2 * 3072 + c + e); *(f32x4*)(w3 + e) = *(const f32x4*)(convw + 3 * 3072 + c + e); }
        const bf16_t* src = proj + (size_t)m0 * LDP + c;
        float h1[8], h2[8], h3[8];
        if (s0 != 0) { unpack8(*(const u32x4*)(src - (size_t)1 * LDP), h1); unpack8(*(const u32x4*)(src - (size_t)2 * LDP), h2); unpack8(*(const u32x4*)(src - (size_t)3 * LDP), h3); }
        else {
#pragma unroll
            for (int e = 0; e < 8; ++e) { h1[e] = 0.f; h2[e] = 0.f; h3[e] = 0.f; } }
        bf16_t* dst = QA + (size_t)(gg >> 1) * ((size_t)MROWS * 1024) + (size_t)m0 * 1024 + (gg & 1) * 512 + 8 * lane;
        const float post = (gg < 2) ? 0.08838834764831845f : 1.f;
#pragma unroll
        for (int tb = 0; tb < 2; ++tb) {
            u32x4 raw[8];
#pragma unroll
            for (int q = 0; q < 8; ++q) raw[q] = *(const u32x4*)(src + (size_t)(8 * tb + q) * LDP);
#pragma unroll
            for (int q = 0; q < 8; ++q) {
                float cur[8], y[8]; unpack8(raw[q], cur);
                float ss = 0.f;
#pragma unroll
                for (int e = 0; e < 8; ++e) { y[e] = silu_f(w3[e] * cur[e] + w2[e] * h1[e] + w1[e] * h2[e] + w0[e] * h3[e]); ss += y[e] * y[e]; }
                if (gg < 4) { ss += __shfl_xor(ss, 1); ss += __shfl_xor(ss, 2); ss += __shfl_xor(ss, 4); ss += __shfl_xor(ss, 8); const float sc = rsqrtf(ss + EPS) * post;
#pragma unroll
                    for (int e = 0; e < 8; ++e) y[e] *= sc; }
                *(u32x4*)(dst + (size_t)(8 * tb + q) * 1024) = pack8(y);
#pragma unroll
                for (int e = 0; e < 8; ++e) { h3[e] = h2[e]; h2[e] = h1[e]; h1[e] = cur[e]; }
            }
        }
    }
}

constexpr int SOLVE_NOPS = 528, SOLVE_R = 8, SOLVE_D = 6;
struct SolveOps { unsigned char j[SOLVE_NOPS + SOLVE_R], q[SOLVE_NOPS + SOLVE_R]; };
constexpr SolveOps make_solve_ops() { SolveOps o{}; int t = 0; for (int j = 0; j < 63; ++j) for (int q = (j + 1) >> 2; q < 16; ++q) { o.j[t] = (unsigned char)j; o.q[t] = (unsigned char)q; ++t; } return o; }
constexpr SolveOps SOPS = make_solve_ops();
template <int T, int END> struct SolveStep {
    static __device__ __forceinline__ void run(f32x2 (&r)[32], f32x4 (&buf)[SOLVE_R], const LAS f32x4* Atv) {
        constexpr int TL = T + SOLVE_D;
        if constexpr (TL < END) buf[TL % SOLVE_R] = Atv[SOPS.j[TL] * 16 + SOPS.q[TL]];
        __builtin_amdgcn_sched_barrier(0);
        constexpr int j = SOPS.j[T], q = SOPS.q[T];
        const float xj = r[j >> 1][j & 1]; const f32x2 x2 = {xj, xj}; const f32x4 a = buf[T % SOLVE_R];
        r[2 * q] = r[2 * q] - (f32x2){a[0], a[1]} * x2; r[2 * q + 1] = r[2 * q + 1] - (f32x2){a[2], a[3]} * x2;
        __builtin_amdgcn_sched_barrier(0);
        SolveStep<T + 1, END>::run(r, buf, Atv);
    }
};
template <int END> struct SolveStep<END, END> { static __device__ __forceinline__ void run(f32x2 (&)[32], f32x4 (&)[SOLVE_R], const LAS f32x4*) {} };

__device__ __forceinline__ void delta_prep(const Params& P, LAS unsigned char* lds) {
    unsigned char* ws = P.ws;
    int tid = threadIdx.x; asm volatile("" : "+v"(tid));
    const int wave = __builtin_amdgcn_readfirstlane(tid >> 6), lane = tid & 63, sub = wave >> 2, tid_s = tid & 255, wv = wave & 3, fr = lane & 15, fq = lane >> 4;
    bf16_t* QA = (bf16_t*)P.out; bf16_t* KA = QA + (size_t)MROWS * 1024; bf16_t* VA = KA + (size_t)MROWS * 1024; bf16_t* WB = VA + (size_t)MROWS * 1024;
    const float* G = (const float*)(ws + WS_G); const float* BETA = (const float*)(ws + WS_BETA); bf16_t* QKM = (bf16_t*)(ws + WS_QKM); float* GL = (float*)(ws + WS_GL);
    LAS unsigned char* base = lds + sub * 61440;
    LAS bf16_t* Ks = (LAS bf16_t*)base; LAS bf16_t* Qs = (LAS bf16_t*)(base + 17408); LAS float* At = (LAS float*)(base + 34816);
    LAS float* gcs = (LAS float*)(base + 51200); LAS float* betas = (LAS float*)(base + 51456); LAS float* bes = (LAS float*)(base + 51712);
    LAS bf16_t* QKs = (LAS bf16_t*)(base + 51968);
    for (int unit = blockIdx.x; unit < 2048; unit += gridDim.x) {
        const int ch = unit * 2 + sub, n = ch & 31, bh = ch >> 5, h = bh & 7, b = bh >> 3, m0 = b * 2048 + n * 64;
#pragma unroll
        for (int i = 0; i < 4; ++i) { const int p = tid_s + 256 * i, row = p >> 4, c = p & 15; const size_t go = (size_t)(m0 + row) * 1024 + h * 128 + c * 8;
            *(LAS u32x4*)(Ks + row * 136 + c * 8) = *(const u32x4*)(KA + go); *(LAS u32x4*)(Qs + row * 136 + c * 8) = *(const u32x4*)(QA + go); }
        if (wv == 0) { float g = G[(size_t)(m0 + lane) * 8 + h] * LOG2E;
#pragma unroll
            for (int o = 1; o < 64; o <<= 1) { const float t = __shfl_up(g, o); if (lane >= o) g += t; }
            const float be = BETA[(size_t)(m0 + lane) * 8 + h];
            gcs[lane] = g; betas[lane] = be; bes[lane] = be * __builtin_amdgcn_exp2f(g); if (lane == 63) GL[ch] = __builtin_amdgcn_exp2f(g); }
        __syncthreads();
        { const int ti = wv; bf16x8 ak[4], aq[4];
#pragma unroll
          for (int ks = 0; ks < 4; ++ks) { ak[ks] = *(const LAS bf16x8*)(Ks + (16 * ti + fr) * 136 + 32 * ks + fq * 8); aq[ks] = *(const LAS bf16x8*)(Qs + (16 * ti + fr) * 136 + 32 * ks + fq * 8); }
          f32x4 gi, bi;
#pragma unroll
          for (int j = 0; j < 4; ++j) { gi[j] = gcs[16 * ti + fq * 4 + j]; bi[j] = betas[16 * ti + fq * 4 + j]; }
#pragma unroll
          for (int tj = 0; tj < 4; ++tj) {
              f32x4 ck = {0.f, 0.f, 0.f, 0.f}, cq = {0.f, 0.f, 0.f, 0.f};
              if (tj <= ti) {
#pragma unroll
                  for (int ks = 0; ks < 4; ++ks) { const bf16x8 bk = *(const LAS bf16x8*)(Ks + (16 * tj + fr) * 136 + 32 * ks + fq * 8);
                      ck = __builtin_amdgcn_mfma_f32_16x16x32_bf16(ak[ks], bk, ck, 0, 0, 0); cq = __builtin_amdgcn_mfma_f32_16x16x32_bf16(aq[ks], bk, cq, 0, 0, 0); } }
              const int jj = 16 * tj + fr; const float gj = gcs[jj]; f32x4 av; float qv[4];
#pragma unroll
              for (int j = 0; j < 4; ++j) { const int i = 16 * ti + fq * 4 + j; const float dec = (i >= jj) ? __builtin_amdgcn_exp2f(gi[j] - gj) : 0.f;
                  av[j] = (i > jj) ? bi[j] * ck[j] * dec : 0.f; qv[j] = cq[j] * dec; }
              *(LAS f32x4*)(At + jj * 64 + 16 * ti + fq * 4) = av;
#pragma unroll
              for (int j = 0; j < 4; ++j) QKs[(16 * ti + fq * 4 + j) * 72 + jj] = f2bf(qv[j]);
          } }
        u32x4 vreg[4];
        const float gl = gcs[63];
#pragma unroll
        for (int i = 0; i < 4; ++i) { const int p = tid_s + 256 * i, row = p >> 4, c = p & 15; const size_t go = (size_t)(m0 + row) * 1024 + h * 128 + c * 8;
            vreg[i] = *(const u32x4*)(VA + go);
            const u32x4 q = *(const LAS u32x4*)(Qs + row * 136 + c * 8); const float e = __builtin_amdgcn_exp2f(gcs[row]); u32x4 o;
            o.x = pk2(bflo(q.x) * e, bfhi(q.x) * e); o.y = pk2(bflo(q.y) * e, bfhi(q.y) * e); o.z = pk2(bflo(q.z) * e, bfhi(q.z) * e); o.w = pk2(bflo(q.w) * e, bfhi(q.w) * e);
            *(u32x4*)(QA + go) = o; }
#pragma unroll
        for (int i = 0; i < 4; ++i) { const int p = tid_s + 256 * i, dk = p & 127, j0 = (p >> 7) * 8; float v[8];
#pragma unroll
            for (int e = 0; e < 8; ++e) v[e] = bf2f(Ks[(j0 + e) * 136 + dk]) * __builtin_amdgcn_exp2f(gl - gcs[j0 + e]);
            u32x4 o; o.x = pk2(v[0], v[1]); o.y = pk2(v[2], v[3]); o.z = pk2(v[4], v[5]); o.w = pk2(v[6], v[7]);
            *(u32x4*)(KA + (size_t)(m0 + (dk >> 1)) * 1024 + h * 128 + (dk & 1) * 64 + j0) = o; }
        __syncthreads();
#pragma unroll
        for (int i = 0; i < 4; ++i) { const int p = tid_s + 256 * i, row = p >> 4, c = p & 15; *(LAS u32x4*)(Qs + row * 136 + c * 8) = vreg[i]; }
#pragma unroll
        for (int i = 0; i < 2; ++i) { const int p = tid_s + 256 * i, row = p >> 3, c8 = p & 7; *(u32x4*)(QKM + (size_t)ch * 4096 + row * 64 + c8 * 8) = *(const LAS u32x4*)(QKs + row * 72 + c8 * 8); }
        __syncthreads();
        { const int c = tid_s; LAS bf16_t* rp = Ks + (c >> 7) * 8704 + (c & 127); const LAS float* sp = (c >= 128) ? betas : bes;
          int zv = 0; asm volatile("" : "+v"(zv)); const LAS f32x4* Atv = (const LAS f32x4*)At + zv;
          f32x2 r[32];
#pragma unroll
          for (int i = 0; i < 64; ++i) r[i >> 1][i & 1] = bf2f(rp[i * 136]) * sp[i];
          f32x4 buf[SOLVE_R];
#pragma unroll
          for (int t = 0; t < SOLVE_D; ++t) buf[t] = Atv[SOPS.j[t] * 16 + SOPS.q[t]];
          SolveStep<0, SOLVE_NOPS>::run(r, buf, Atv);
#pragma unroll
          for (int i = 0; i < 64; ++i) rp[i * 136] = f2bf(r[i >> 1][i & 1]); }
        __syncthreads();
#pragma unroll
        for (int i = 0; i < 4; ++i) { const int p = tid_s + 256 * i, row = p >> 4, c = p & 15; const size_t go = (size_t)(m0 + row) * 1024 + h * 128 + c * 8;
            *(u32x4*)(WB + go) = *(const LAS u32x4*)(Ks + row * 136 + c * 8); *(u32x4*)(VA + go) = *(const LAS u32x4*)(Qs + row * 136 + c * 8); }
        __syncthreads();
    }
}

__device__ __forceinline__ void delta_scan(const Params& P, LAS unsigned char* lds) {
    unsigned char* ws = P.ws;
    int tid = threadIdx.x; asm volatile("" : "+v"(tid));
    const int wave = __builtin_amdgcn_readfirstlane(tid >> 6), lane = tid & 63, fr = lane & 15, fq = lane >> 4;
    const bf16_t* QA = (const bf16_t*)P.out; const bf16_t* KA = QA + (size_t)MROWS * 1024; const bf16_t* UA = KA + (size_t)MROWS * 1024; const bf16_t* WB = UA + (size_t)MROWS * 1024;
    const bf16_t* QKM = (const bf16_t*)(ws + WS_QKM); const float* GL = (const float*)(ws + WS_GL); bf16_t* proj = (bf16_t*)(ws + WS_PROJ);
    const float* ogain = (const float*)P.in[8];
    LAS bf16_t* Ws = (LAS bf16_t*)lds; LAS bf16_t* Qs = (LAS bf16_t*)(lds + 17408); LAS bf16_t* Kt = (LAS bf16_t*)(lds + 34816); LAS bf16_t* QKs = (LAS bf16_t*)(lds + 53248);
    LAS bf16_t* Us = (LAS bf16_t*)(lds + 62464); LAS bf16_t* St = (LAS bf16_t*)(lds + 79872); LAS bf16_t* VNt = (LAS bf16_t*)(lds + 114688); LAS float* SSQ = (LAS float*)(lds + 133120);
    const int it = wave >> 1, dvq = wave & 1;
    for (int unit = blockIdx.x; unit < 128; unit += gridDim.x) {
        const int bh = unit, h = bh & 7, b = bh >> 3;
        f32x4 sacc[8];
#pragma unroll
        for (int d = 0; d < 8; ++d) sacc[d] = (f32x4){0.f, 0.f, 0.f, 0.f};
        float og[4];
#pragma unroll
        for (int d = 0; d < 4; ++d) og[d] = ogain[16 * (4 * dvq + d) + fr];
        u32x4 rw[2], rq[2], rk[2], ru[2], rqk;
#define SCAN_LOAD(nn) do { const int m0_ = b * 2048 + (nn) * 64; const size_t ch_ = (size_t)bh * 32 + (nn); \
            _Pragma("unroll") for (int i = 0; i < 2; ++i) { const int p = tid + 512 * i, row = p >> 4, c = p & 15; const size_t go = (size_t)(m0_ + row) * 1024 + h * 128 + c * 8; rw[i] = *(const u32x4*)(WB + go); rq[i] = *(const u32x4*)(QA + go); ru[i] = *(const u32x4*)(UA + go); \
                const int dk = p >> 3, c8 = p & 7; rk[i] = *(const u32x4*)(KA + (size_t)(m0_ + (dk >> 1)) * 1024 + h * 128 + (dk & 1) * 64 + c8 * 8); } \
            { const int row = tid >> 3, c8 = tid & 7; rqk = *(const u32x4*)(QKM + ch_ * 4096 + row * 64 + c8 * 8); } } while (0)
#define SCAN_STORE() do { \
            _Pragma("unroll") for (int i = 0; i < 2; ++i) { const int p = tid + 512 * i, row = p >> 4, c = p & 15; *(LAS u32x4*)(Ws + row * 136 + c * 8) = rw[i]; *(LAS u32x4*)(Qs + row * 136 + c * 8) = rq[i]; *(LAS u32x4*)(Us + row * 136 + c * 8) = ru[i]; \
                const int dk = p >> 3, c8 = p & 7; *(LAS u32x4*)(Kt + dk * 72 + c8 * 8) = rk[i]; } \
            { const int row = tid >> 3, c8 = tid & 7; *(LAS u32x4*)(QKs + row * 72 + c8 * 8) = rqk; } } while (0)
        SCAN_LOAD(0);
        for (int n = 0; n < 32; ++n) {
            const int m0 = b * 2048 + n * 64;
            SCAN_STORE();
#pragma unroll
            for (int d = 0; d < 8; ++d) { u32x2 w; w.x = pk2(sacc[d][0], sacc[d][1]); w.y = pk2(sacc[d][2], sacc[d][3]); *(LAS u32x2*)(St + (16 * d + fr) * 136 + 16 * wave + fq * 4) = w; }
            const float gl = GL[bh * 32 + n];
            __syncthreads();
            if (n + 1 < 32) SCAN_LOAD(n + 1);
            bf16_t zr[4][4];
#pragma unroll
            for (int d = 0; d < 4; ++d)
#pragma unroll
                for (int j = 0; j < 4; ++j) zr[d][j] = proj[(size_t)(m0 + 16 * it + fq * 4 + j) * LDP + C_Z + h * 128 + 16 * (4 * dvq + d) + fr];
            f32x4 a1[4], a2[4];
#pragma unroll
            for (int d = 0; d < 4; ++d) { a1[d] = (f32x4){0.f, 0.f, 0.f, 0.f}; a2[d] = (f32x4){0.f, 0.f, 0.f, 0.f}; }
#pragma unroll
            for (int ks = 0; ks < 4; ++ks) { const bf16x8 wf = *(const LAS bf16x8*)(Ws + (16 * it + fr) * 136 + 32 * ks + fq * 8), qf = *(const LAS bf16x8*)(Qs + (16 * it + fr) * 136 + 32 * ks + fq * 8);
#pragma unroll
                for (int d = 0; d < 4; ++d) { const bf16x8 sf = *(const LAS bf16x8*)(St + (16 * (4 * dvq + d) + fr) * 136 + 32 * ks + fq * 8);
                    a1[d] = __builtin_amdgcn_mfma_f32_16x16x32_bf16(wf, sf, a1[d], 0, 0, 0); a2[d] = __builtin_amdgcn_mfma_f32_16x16x32_bf16(qf, sf, a2[d], 0, 0, 0); } }
#pragma unroll
            for (int d = 0; d < 4; ++d) { const int dv = 16 * (4 * dvq + d) + fr; float vn[4];
#pragma unroll
                for (int j = 0; j < 4; ++j) vn[j] = bf2f(Us[(16 * it + fq * 4 + j) * 136 + dv]) - a1[d][j];
                u32x2 w; w.x = pk2(vn[0], vn[1]); w.y = pk2(vn[2], vn[3]); *(LAS u32x2*)(VNt + dv * 72 + 16 * it + fq * 4) = w; }
            __syncthreads();
#pragma unroll
            for (int d = 0; d < 8; ++d) sacc[d] = sacc[d] * gl;
#pragma unroll
            for (int k2 = 0; k2 < 2; ++k2) { const bf16x8 qkf = *(const LAS bf16x8*)(QKs + (16 * it + fr) * 72 + 32 * k2 + fq * 8), kf = *(const LAS bf16x8*)(Kt + (16 * wave + fr) * 72 + 32 * k2 + fq * 8);
#pragma unroll
                for (int d = 0; d < 8; ++d) { const bf16x8 vf = *(const LAS bf16x8*)(VNt + (16 * d + fr) * 72 + 32 * k2 + fq * 8);
                    sacc[d] = __builtin_amdgcn_mfma_f32_16x16x32_bf16(kf, vf, sacc[d], 0, 0, 0);
                    if ((d >> 2) == dvq) a2[d & 3] = __builtin_amdgcn_mfma_f32_16x16x32_bf16(qkf, vf, a2[d & 3], 0, 0, 0); } }
            float ssq[4];
#pragma unroll
            for (int j = 0; j < 4; ++j) { float t = 0.f;
#pragma unroll
                for (int d = 0; d < 4; ++d) t += a2[d][j] * a2[d][j];
                t += __shfl_xor(t, 1); t += __shfl_xor(t, 2); t += __shfl_xor(t, 4); t += __shfl_xor(t, 8); ssq[j] = t; }
            if (fr == 0) {
#pragma unroll
                for (int j = 0; j < 4; ++j) SSQ[(16 * it + fq * 4 + j) * 2 + dvq] = ssq[j]; }
            __syncthreads();
#pragma unroll
            for (int j = 0; j < 4; ++j) { const int row = 16 * it + fq * 4 + j; const float rstd = rsqrtf((SSQ[row * 2] + SSQ[row * 2 + 1]) * (1.f / 128.f) + EPS);
#pragma unroll
                for (int d = 0; d < 4; ++d) proj[(size_t)(m0 + row) * LDP + C_Q + h * 128 + 16 * (4 * dvq + d) + fr] = f2bf(a2[d][j] * rstd * og[d] * silu_f(bf2f(zr[d][j]))); }
        }
        __syncthreads();
#undef SCAN_LOAD
#undef SCAN_STORE
    }
}

__device__ __forceinline__ void mla_attention(const Params& P, LAS unsigned char* lds) {
    unsigned char* ws = P.ws;
    int tid = threadIdx.x; asm volatile("" : "+v"(tid));
    const int wave = __builtin_amdgcn_readfirstlane(tid >> 6), lane = tid & 63, fr = lane & 15, fq = lane >> 4;
    bf16_t* proj = (bf16_t*)(ws + WS_PROJ); const bf16_t* KN = (const bf16_t*)(ws + WS_ACT); const bf16_t* VT = KN + (size_t)MROWS * 1024;
    const int kkey = tid >> 3, kseg = tid & 7, vdv = tid >> 2, vseg = tid & 3;
    unsigned* qctr = (unsigned*)(ws + WS_CTL + 128 * 1024);
    volatile LAS unsigned* qslot = (volatile LAS unsigned*)(lds + 139264);
    const bool stat = (gridDim.x == 256);
    for (int iter = 0;; ++iter) {
        int qi, bh;
        if (stat) { const bool sc = (int)blockIdx.x < 128; if (iter >= (sc ? 2 : 6)) break; bh = (int)blockIdx.x & 127;
            qi = sc ? (iter == 0 ? 7 : 4) : (iter == 0 ? 6 : iter == 1 ? 5 : iter == 2 ? 3 : iter == 3 ? 2 : iter == 4 ? 1 : 0); }
        else {
            if (tid == 0) qslot[0] = __hip_atomic_fetch_add(qctr, 1u, __ATOMIC_RELAXED, __HIP_MEMORY_SCOPE_AGENT);
            __syncthreads();
            const int L = (int)qslot[0];
            if (L >= 1024) break;
            qi = 7 - (L >> 7); bh = L & 127; }
        const int h = bh & 7, b = bh >> 3;
        const int q0 = qi * 256, ntiles = 4 * (qi + 1);
        bf16x8 qf[2][6];
#pragma unroll
        for (int m = 0; m < 2; ++m)
#pragma unroll
            for (int ks = 0; ks < 6; ++ks) qf[m][ks] = *(const bf16x8*)(proj + (size_t)(b * 2048 + q0 + 32 * wave + 16 * m + fr) * LDP + C_MQ + h * 192 + 32 * ks + fq * 8);
        f32x4 accO[2][8];
#pragma unroll
        for (int m = 0; m < 2; ++m)
#pragma unroll
            for (int d = 0; d < 8; ++d) accO[m][d] = (f32x4){0.f, 0.f, 0.f, 0.f};
        float mrow[2] = {-INFINITY, -INFINITY}, lsum[2] = {0.f, 0.f};
        u32x4 rk0, rk1, rkr, rv0, rv1;
#define ATT_LOAD(kt) do { const size_t krow = (size_t)(b * 2048 + (kt) * 64 + kkey); const bf16_t* kp = KN + krow * 1024 + h * 128 + 16 * kseg; rk0 = *(const u32x4*)kp; rk1 = *(const u32x4*)(kp + 8); \
            rkr = *(const u32x4*)(proj + krow * LDP + C_KR + 8 * kseg); const bf16_t* vp = VT + ((size_t)bh * 128 + vdv) * 2048 + (kt) * 64 + 16 * vseg; rv0 = *(const u32x4*)vp; rv1 = *(const u32x4*)(vp + 8); } while (0)
#define ATT_STORE(buf) do { LAS bf16_t* Kb = (LAS bf16_t*)(lds + (buf) * 25600); LAS bf16_t* Vb = (LAS bf16_t*)(lds + 51200 + (buf) * 18432); \
            float f[16]; f[0] = bflo(rk0.x); f[1] = bfhi(rk0.x); f[2] = bflo(rk0.y); f[3] = bfhi(rk0.y); f[4] = bflo(rk0.z); f[5] = bfhi(rk0.z); f[6] = bflo(rk0.w); f[7] = bfhi(rk0.w); \
            f[8] = bflo(rk1.x); f[9] = bfhi(rk1.x); f[10] = bflo(rk1.y); f[11] = bfhi(rk1.y); f[12] = bflo(rk1.z); f[13] = bfhi(rk1.z); f[14] = bflo(rk1.w); f[15] = bfhi(rk1.w); \
            float ss = 0.f; _Pragma("unroll") for (int e = 0; e < 16; ++e) ss += f[e] * f[e]; \
            ss += __shfl_xor(ss, 1); ss += __shfl_xor(ss, 2); ss += __shfl_xor(ss, 4); const float rs = rsqrtf(ss * (1.f / 128.f) + EPS); \
            u32x4 o0, o1; o0.x = pk2(f[0] * rs, f[1] * rs); o0.y = pk2(f[2] * rs, f[3] * rs); o0.z = pk2(f[4] * rs, f[5] * rs); o0.w = pk2(f[6] * rs, f[7] * rs); \
            o1.x = pk2(f[8] * rs, f[9] * rs); o1.y = pk2(f[10] * rs, f[11] * rs); o1.z = pk2(f[12] * rs, f[13] * rs); o1.w = pk2(f[14] * rs, f[15] * rs); \
            *(LAS u32x4*)(Kb + kkey * 200 + 16 * kseg) = o0; *(LAS u32x4*)(Kb + kkey * 200 + 16 * kseg + 8) = o1; *(LAS u32x4*)(Kb + kkey * 200 + 128 + 8 * kseg) = rkr; \
            *(LAS u32x4*)(Vb + vdv * 72 + 16 * vseg) = rv0; *(LAS u32x4*)(Vb + vdv * 72 + 16 * vseg + 8) = rv1; } while (0)
        ATT_LOAD(0); ATT_STORE(0);
        __syncthreads();
        for (int kt = 0; kt < ntiles; ++kt) {
            const bool more = (kt + 1 < ntiles);
            if (more) ATT_LOAD(kt + 1);
            const bool active = (kt < 4 * qi) || ((kt - 4 * qi) <= (wave >> 1));
            if (active) {
                const LAS bf16_t* Kb = (const LAS bf16_t*)(lds + (kt & 1) * 25600); const LAS bf16_t* Vb = (const LAS bf16_t*)(lds + 51200 + (kt & 1) * 18432);
                f32x4 accS[2][4];
#pragma unroll
                for (int m = 0; m < 2; ++m)
#pragma unroll
                    for (int n = 0; n < 4; ++n) accS[m][n] = (f32x4){0.f, 0.f, 0.f, 0.f};
                {
                  const LAS bf16_t* kbase = Kb + fr * 200 + fq * 8; bf16x8 kring[4];
#pragma unroll
                  for (int s0 = 0; s0 < 3; ++s0) kring[s0] = *(const LAS bf16x8*)(kbase + (16 * (s0 & 3)) * 200 + 32 * (s0 >> 2));
#pragma unroll
                  for (int s0 = 0; s0 < 24; ++s0) {
                      if (s0 + 3 < 24) kring[(s0 + 3) & 3] = *(const LAS bf16x8*)(kbase + (16 * ((s0 + 3) & 3)) * 200 + 32 * ((s0 + 3) >> 2));
                      __builtin_amdgcn_sched_barrier(0);
                      const int ks = s0 >> 2, n = s0 & 3;
                      accS[0][n] = __builtin_amdgcn_mfma_f32_16x16x32_bf16(kring[s0 & 3], qf[0][ks], accS[0][n], 0, 0, 0); accS[1][n] = __builtin_amdgcn_mfma_f32_16x16x32_bf16(kring[s0 & 3], qf[1][ks], accS[1][n], 0, 0, 0);
                      __builtin_amdgcn_sched_barrier(0);
                  } }
                bf16x8 pf[2][2];
#pragma unroll
                for (int m = 0; m < 2; ++m) {
                    float mx = accS[m][0][0];
#pragma unroll
                    for (int n = 0; n < 4; ++n)
#pragma unroll
                        for (int j = 0; j < 4; ++j) mx = fmaxf(mx, accS[m][n][j]);
                    mx = fmaxf(mx, __shfl_xor(mx, 16)); mx = fmaxf(mx, __shfl_xor(mx, 32));
                    const float mnew = fmaxf(mrow[m], mx), alpha = __builtin_amdgcn_exp2f(mrow[m] - mnew); mrow[m] = mnew;
                    float ps = 0.f; float p[4][4];
#pragma unroll
                    for (int n = 0; n < 4; ++n)
#pragma unroll
                        for (int j = 0; j < 4; ++j) { p[n][j] = __builtin_amdgcn_exp2f(accS[m][n][j] - mnew); ps += p[n][j]; }
                    lsum[m] = lsum[m] * alpha + ps;
                    if (__any(alpha != 1.f)) {
#pragma unroll
                        for (int d = 0; d < 8; ++d) accO[m][d] = accO[m][d] * alpha; }
#pragma unroll
                    for (int t = 0; t < 2; ++t) { u32x4 w; w.x = pk2(p[2 * t][0], p[2 * t][1]); w.y = pk2(p[2 * t][2], p[2 * t][3]); w.z = pk2(p[2 * t + 1][0], p[2 * t + 1][1]); w.w = pk2(p[2 * t + 1][2], p[2 * t + 1][3]);
                        pf[m][t] = __builtin_bit_cast(bf16x8, w); }
                }
                {
                  const LAS bf16_t* vbase = Vb + fr * 72 + fq * 4; u32x2 vlo[4], vhi[4];
#pragma unroll
                  for (int s0 = 0; s0 < 3; ++s0) { const LAS bf16_t* vp = vbase + (16 * (s0 & 7)) * 72 + 32 * (s0 >> 3); vlo[s0] = *(const LAS u32x2*)vp; vhi[s0] = *(const LAS u32x2*)(vp + 16); }
#pragma unroll
                  for (int s0 = 0; s0 < 16; ++s0) {
                      if (s0 + 3 < 16) { const LAS bf16_t* vp = vbase + (16 * ((s0 + 3) & 7)) * 72 + 32 * ((s0 + 3) >> 3); vlo[(s0 + 3) & 3] = *(const LAS u32x2*)vp; vhi[(s0 + 3) & 3] = *(const LAS u32x2*)(vp + 16); }
                      __builtin_amdgcn_sched_barrier(0);
                      const int t = s0 >> 3, d = s0 & 7; u32x4 w; w.x = vlo[s0 & 3].x; w.y = vlo[s0 & 3].y; w.z = vhi[s0 & 3].x; w.w = vhi[s0 & 3].y; const bf16x8 vf = __builtin_bit_cast(bf16x8, w);
                      accO[0][d] = __builtin_amdgcn_mfma_f32_16x16x32_bf16(vf, pf[0][t], accO[0][d], 0, 0, 0); accO[1][d] = __builtin_amdgcn_mfma_f32_16x16x32_bf16(vf, pf[1][t], accO[1][d], 0, 0, 0);
                      __builtin_amdgcn_sched_barrier(0);
                  } }
            }
            if (more) ATT_STORE((kt + 1) & 1);
            __syncthreads();
        }
#undef ATT_LOAD
#undef ATT_STORE
#pragma unroll
        for (int m = 0; m < 2; ++m) { float l = lsum[m]; l += __shfl_xor(l, 16); l += __shfl_xor(l, 32); const float il = 1.f / l;
            bf16_t* op = proj + (size_t)(b * 2048 + q0 + 32 * wave + 16 * m + fr) * LDP + C_K + h * 128 + fq * 4;
#pragma unroll
            for (int d = 0; d < 8; ++d) { u32x2 w; w.x = pk2(accO[m][d][0] * il, accO[m][d][1] * il); w.y = pk2(accO[m][d][2] * il, accO[m][d][3] * il); *(u32x2*)(op + 16 * d) = w; } }
    }
}

__device__ __forceinline__ void oa_finalize(const Params& P, int gw, int NGW, int lane) {
    bf16_t* proj = (bf16_t*)(P.ws + WS_PROJ); const float* gain = (const float*)P.in[8];
    const int h = lane >> 3, seg = lane & 7;
    float g[16];
#pragma unroll
    for (int e = 0; e < 16; ++e) g[e] = gain[16 * seg + e];
    for (int m = gw; m < MROWS; m += NGW) { bf16_t* op = proj + (size_t)m * LDP + C_Q + h * 128 + 16 * seg; const bf16_t* zp = proj + (size_t)m * LDP + C_Z + h * 128 + 16 * seg;
        const u32x4 o0 = *(const u32x4*)op, o1 = *(const u32x4*)(op + 8), z0 = *(const u32x4*)zp, z1 = *(const u32x4*)(zp + 8);
        float a[8], b[8], za[8], zb[8]; unpack8(o0, a); unpack8(o1, b); unpack8(z0, za); unpack8(z1, zb);
        float ss = 0.f;
#pragma unroll
        for (int e = 0; e < 8; ++e) ss += a[e] * a[e] + b[e] * b[e];
        ss += __shfl_xor(ss, 1); ss += __shfl_xor(ss, 2); ss += __shfl_xor(ss, 4);
        const float rstd = rsqrtf(ss * (1.f / 128.f) + EPS);
#pragma unroll
        for (int e = 0; e < 8; ++e) { a[e] = a[e] * rstd * g[e] * silu_f(za[e]); b[e] = b[e] * rstd * g[8 + e] * silu_f(zb[e]); }
        *(u32x4*)op = pack8(a); *(u32x4*)(op + 8) = pack8(b); }
}


#define XB_TMO      128
#define XB_XCNT(j)  (256  + 64 * (j))
#define XB_XSUB(j)  (1280 + 64 * (j))
#define XB_XGEN(j)  (2304 + 64 * (j))
#define XB_TOP      3328
#define XB_TOPGEN   3392
#define XCD_BAR_WORDS 3456
#define XB_SPIN_CAP (1u << 18)
__device__ __forceinline__ unsigned xb_ld(unsigned* p)              { return __hip_atomic_load(p, __ATOMIC_RELAXED, __HIP_MEMORY_SCOPE_AGENT); }
__device__ __forceinline__ unsigned xb_add(unsigned* p, unsigned v) { return __hip_atomic_fetch_add(p, v, __ATOMIC_RELAXED, __HIP_MEMORY_SCOPE_AGENT); }
__device__ __forceinline__ unsigned xb_xcc_id() { return (unsigned)__builtin_amdgcn_s_getreg((3 << 11) | 20) & 0xFu; }
#define XB_SPIN(cond, bar) do { unsigned _sp = 0; while (cond) { __builtin_amdgcn_s_sleep(1); \
    if ((++_sp & 255u) == 0u) { if (xb_ld(&(bar)[XB_TMO])) break; if (_sp > XB_SPIN_CAP) { atomicAdd(&(bar)[XB_TMO], 1u); break; } } } } while (0)
struct XcdBarrier { unsigned* bar; unsigned x; volatile LAS unsigned* st; };
__device__ __forceinline__ XcdBarrier xcd_barrier_post(unsigned* bar, volatile LAS unsigned* st) {
    XcdBarrier b; b.bar = bar; b.x = xb_xcc_id(); b.st = st;
    if (threadIdx.x == 0) (void)xb_add(&bar[XB_XCNT(b.x)], 1u);
    return b;
}
__device__ __forceinline__ void xcd_barrier_complete(unsigned* bar, unsigned x, unsigned& nloc, unsigned& nx) {
    const unsigned G = gridDim.x * gridDim.y * gridDim.z;
    unsigned sum, cnt, mine, sp = 0u;
    for (;;) {
        sum = 0u; cnt = 0u; mine = 0u;
#pragma unroll
        for (unsigned j = 0; j < 16; ++j) { const unsigned c = xb_ld(&bar[XB_XCNT(j)]); sum += c; cnt += (c > 0u) ? 1u : 0u; mine = (j == x) ? c : mine; }
        if (sum == G) break;
        __builtin_amdgcn_s_sleep(1);
        if ((++sp & 255u) == 0u) { if (xb_ld(&bar[XB_TMO])) break; if (sp > XB_SPIN_CAP) { atomicAdd(&bar[XB_TMO], 1u); break; } }
    }
    nloc = mine > 0u ? mine : 1u; nx = cnt > 0u ? cnt : 1u;
}
__device__ __forceinline__ void xcd_barrier(const XcdBarrier& b) {
    asm volatile("s_waitcnt vmcnt(0)" ::: "memory");
    __syncthreads();
    if (threadIdx.x == 0) {
        unsigned* bar = b.bar;
        __builtin_amdgcn_s_waitcnt(0);
        unsigned nloc = b.st[0], nx = b.st[1];
        if (nloc == 0u) { xcd_barrier_complete(bar, b.x, nloc, nx); b.st[0] = nloc; b.st[1] = nx; }
        const unsigned old = xb_add(&bar[XB_XSUB(b.x)], 1u);
        const unsigned gen = old / nloc;
        if (old + 1u == (gen + 1u) * nloc) {
            __builtin_amdgcn_fence(__ATOMIC_RELEASE, "agent");
            asm volatile("s_waitcnt vmcnt(0)" ::: "memory");
            const unsigned og = xb_add(&bar[XB_TOP], 1u);
            const unsigned tg = og / nx;
            if (og + 1u == (tg + 1u) * nx) xb_add(&bar[XB_TOPGEN], 1u);
            else XB_SPIN(xb_ld(&bar[XB_TOPGEN]) == tg, bar);
            __builtin_amdgcn_fence(__ATOMIC_ACQUIRE, "agent");
            xb_add(&bar[XB_XGEN(b.x)], 1u);
            asm volatile("s_waitcnt vmcnt(0)" ::: "memory");
        } else {
            XB_SPIN(xb_ld(&bar[XB_XGEN(b.x)]) == gen, bar);
            __builtin_amdgcn_fence(__ATOMIC_ACQUIRE, "agent");
            asm volatile("s_waitcnt vmcnt(0)" ::: "memory");
        }
    }
    __syncthreads();
}

__global__ void __launch_bounds__(512) fwd_megakernel(Params P) {
    extern __shared__ __attribute__((aligned(16))) unsigned char lds_raw[];
    LAS unsigned char* lds = (LAS unsigned char*)lds_raw;
    cg::grid_group grid = cg::this_grid();
    const int G = gridDim.x, NGW = G * 8;
#define PHASE_IDS() int tid_ = threadIdx.x; asm volatile("" : "+v"(tid_)); const int lane = tid_ & 63, wave = __builtin_amdgcn_readfirstlane(tid_ >> 6), gw = blockIdx.x * 8 + wave
    unsigned char* ws = P.ws;
    bf16_t* ACT = (bf16_t*)(ws + WS_ACT); bf16_t* PROJ = (bf16_t*)(ws + WS_PROJ);
    pg8::StaticOrder S;
    unsigned long long pt_acc = 0, pt_last = 0;
    volatile LAS unsigned* MISC = (volatile LAS unsigned*)(lds + 139264);
    if (threadIdx.x < 16) MISC[threadIdx.x] = 0u;
    __syncthreads();
    const XcdBarrier xbar = xcd_barrier_post((unsigned*)(ws + WS_CTL), MISC + 8);
#define GRID_BAR() xcd_barrier(xbar)

    PT_B(0);
    { PHASE_IDS(); p0_prologue(P, lds, gw, NGW, wave, lane); }
    if (P.ws == nullptr) grid.sync();
    GRID_BAR();
    PT_E(0);
    PT_B(1);
    { pg8::Gemm g{ACT, (const bf16_t*)(ws + WS_WIN), MROWS, LDP, 2048, 2048}; S.init(MROWS, LDP, G, blockIdx.x);
      Epi<EP_BF16> E{PROJ, nullptr, LDP, nullptr, nullptr, nullptr, nullptr}; pg8::gemm_phase(lds, g, S, E); }
    {
      const int nwg = (MROWS / 256) * (LDP / 256), rem = nwg % G; const bool is_short = (rem == 0) || ((int)blockIdx.x >= rem);
      const int nshort = (rem == 0) ? G : G - rem, sidx = (rem == 0) ? (int)blockIdx.x : (int)blockIdx.x - rem;
      if (is_short) { PHASE_IDS(); (void)gw; transpose_range(P, (LAS float*)(lds + wave * 16384), TR_IN_ITEMS, TR_ALL_ITEMS, sidx * 8 + wave, nshort * 8, lane); } }
    GRID_BAR();
    PT_E(1);
    PT_B(2);
    { PHASE_IDS(); p2_prep(P, gw, NGW, lane); }
    GRID_BAR();
    PT_E(2);
    PT_B(3);
    { pg8::Gemm g{PROJ + C_CKV, (const bf16_t*)(ws + WS_WKV), MROWS, 2048, 512, LDP}; S.init(MROWS, 2048, G, blockIdx.x);
      Epi<EP_KV> E{ACT, nullptr, 1024, nullptr, nullptr, ACT + (size_t)MROWS * 1024, nullptr}; pg8::gemm_phase(lds, g, S, E); }
    __syncthreads();
    PT_E(3);
    PT_B(4);
    delta_prep(P, lds);
    GRID_BAR();
    PT_E(4);
    PT_B(5);
    delta_scan(P, lds);
    __syncthreads();
    PT_E(5);
    PT_B(6);
    mla_attention(P, lds);
    GRID_BAR();
    PT_E(6);
    PT_B(8);
    { pg8::Gemm g{PROJ + C_Q, (const bf16_t*)(ws + WS_WA), MROWS, 2048, 2048, LDP}; S.init(MROWS, 2048, G, blockIdx.x);
      Epi<EP_YAB> E{ACT, nullptr, DM, PROJ, nullptr, nullptr, nullptr}; pg8::gemm_phase(lds, g, S, E); }
    GRID_BAR();
    PT_E(8);
    PT_B(9);
    { pg8::Gemm g{ACT, (const bf16_t*)(ws + WS_WOUT), MROWS, 2048, 2048, 2048}; S.init(MROWS, 2048, G, blockIdx.x);
      Epi<EP_X1> E{(bf16_t*)(ws + WS_XB), nullptr, DM, nullptr, (const float*)P.in[0], nullptr, (float*)(ws + WS_SSQ1)}; pg8::gemm_phase(lds, g, S, E); }
    GRID_BAR();
    PT_E(9);
    PT_B(11);
    { pg8::Gemm g{(const bf16_t*)(ws + WS_XB), (const bf16_t*)(ws + WS_WUP), MROWS, DFF, 2048, 2048}; S.init(MROWS, DFF, G, blockIdx.x);
      Epi<EP_RELU2> E{PROJ, nullptr, DFF, nullptr, nullptr, nullptr, (float*)(ws + WS_SSQ1)}; pg8::gemm_phase(lds, g, S, E); }
    { pg8::Gemm g{(const bf16_t*)(ws + WS_PBF), (const bf16_t*)(ws + WS_WPLE), MROWS, 2048, 256, 256}; S.init(MROWS, 2048, G, blockIdx.x);
      Epi<EP_BF16> E{ACT, nullptr, DM, nullptr, nullptr, nullptr, nullptr}; pg8::gemm_phase(lds, g, S, E); }
    GRID_BAR();
    PT_E(11);
    PT_B(12);
    { pg8::Gemm g{PROJ, (const bf16_t*)(ws + WS_WDN), MROWS, 2048, DFF, DFF}; S.init(MROWS, 2048, G, blockIdx.x);
      Epi<EP_ACC> E{(bf16_t*)(ws + WS_XB), nullptr, DM, nullptr, nullptr, nullptr, (float*)(ws + WS_SSQ2)}; pg8::gemm_phase(lds, g, S, E); }
    GRID_BAR();
    PT_E(12);
    PT_B(14);
    { pg8::Gemm g{(const bf16_t*)(ws + WS_XB), (const bf16_t*)(ws + WS_WPG), MROWS, 2048, 2048, 2048}; S.init(MROWS, 2048, G, blockIdx.x);
      Epi<EP_PLE> E{nullptr, P.out, DM, ACT, nullptr, (bf16_t*)(ws + WS_XB), (float*)(ws + WS_SSQ2)}; pg8::gemm_phase(lds, g, S, E); }
    PT_E(14);
    if (PROBE_MASK != 0u && blockIdx.x == 0) { const unsigned long long t_end = __builtin_amdgcn_s_memrealtime() + (unsigned long long)PROBE_MULT * pt_acc;
        while (__builtin_amdgcn_s_memrealtime() < t_end) __builtin_amdgcn_s_sleep(8); }
}

extern "C" void kernel_launch(void* const* d_in, const int* in_sizes, int n_in, void* d_out, int out_size, void* d_ws, size_t ws_size, hipStream_t stream) {
    static int grid = 0;
    if (grid == 0) {
        if (n_in != 24 || out_size != MROWS * DM || ws_size < WS_END) { fprintf(stderr, "kernel_launch: unexpected shapes: n_in %d out %d ws %zu (need %zu)\n", n_in, out_size, ws_size, (size_t)WS_END); grid = -1; return; }
        int dev = 0, cus = 0, per_cu = 0;
        if (hipGetDevice(&dev) != hipSuccess || hipDeviceGetAttribute(&cus, hipDeviceAttributeMultiprocessorCount, dev) != hipSuccess) { grid = -1; return; }
        if (hipFuncSetAttribute((const void*)fwd_megakernel, hipFuncAttributeMaxDynamicSharedMemorySize, LDS_BYTES) != hipSuccess) { fprintf(stderr, "kernel_launch: hipFuncSetAttribute failed\n"); grid = -1; return; }
        if (hipOccupancyMaxActiveBlocksPerMultiprocessor(&per_cu, (const void*)fwd_megakernel, 512, LDS_BYTES) != hipSuccess || per_cu < 1) { fprintf(stderr, "kernel_launch: occupancy query gave %d\n", per_cu); per_cu = 1; }
        (void)hipGetLastError();
        grid = cus * per_cu;
        fprintf(stderr, "kernel_launch: grid %d (cus %d x %d), ws %zu\n", grid, cus, per_cu, ws_size);
    }
    if (grid < 0) return;
    Params p{};
    for (int i = 0; i < 24; ++i) p.in[i] = d_in[i];
    p.out = (float*)d_out; p.ws = (unsigned char*)d_ws;
    for (int i = 0; i < 32; ++i) p.ropeinv[i] = (float)pow(10000.0, -(double)i / 32.0);
    if (hipMemsetAsync((char*)d_ws + WS_CTL, 0, CTL_BYTES, stream) != hipSuccess) { fprintf(stderr, "kernel_launch: hipMemsetAsync failed\n"); return; }
    void* args[] = {&p};
    hipError_t e = hipLaunchCooperativeKernel((const void*)fwd_megakernel, dim3(grid), dim3(512), args, LDS_BYTES, stream);
    if (e != hipSuccess) fprintf(stderr, "kernel_launch: cooperative launch failed: %s (grid %d)\n", hipGetErrorString(e), grid);
}
```

```cpp
#include <hip/hip_runtime.h>
#include <hip/hip_cooperative_groups.h>
#include <cstdio>
#include <cstdint>
#include <cmath>
namespace cg = cooperative_groups;
#ifndef PROBE_MASK
#define PROBE_MASK 0u
#endif
#define PROBE_MULT 3
#define PT_B(bit) do { if ((PROBE_MASK >> (bit)) & 1u) { __builtin_amdgcn_s_waitcnt(0); pt_last = __builtin_amdgcn_s_memrealtime(); } } while (0)
#define PT_E(bit) do { if ((PROBE_MASK >> (bit)) & 1u) { __builtin_amdgcn_s_waitcnt(0); pt_acc += __builtin_amdgcn_s_memrealtime() - pt_last; } } while (0)

#define LAS __attribute__((address_space(3)))
typedef unsigned short bf16_t;
typedef short bf16x8 __attribute__((ext_vector_type(8)));
typedef float f32x4 __attribute__((ext_vector_type(4)));
typedef float f32x2 __attribute__((ext_vector_type(2)));
typedef unsigned u32x4 __attribute__((ext_vector_type(4)));
typedef unsigned u32x2 __attribute__((ext_vector_type(2)));

constexpr int NB = 16, SEQ = 2048, MROWS = NB * SEQ, DM = 2048, LDP = 10496, DFF = 8192, PLE = 256;
constexpr int C_Q = 0, C_K = 1024, C_V = 2048, C_Z = 3072, C_MQ = 4096, C_CKV = 5632, C_GA = 6144, C_GB = 8192, C_KR = 10240, C_BETA = 10304, C_ALPHA = 10312;
constexpr int D_IN = 10320;
constexpr float EPS = 1e-6f;
constexpr float LOG2E = 1.4426950408889634f;
constexpr size_t MiB = 1u << 20;
constexpr size_t WS_WIN = 0, WS_WKV = 41 * MiB, WS_WA = 43 * MiB, WS_WB = 47 * MiB, WS_WOUT = 51 * MiB, WS_WUP = 59 * MiB, WS_WDN = 91 * MiB, WS_WPG = 123 * MiB,
                 WS_WPLE = 131 * MiB, WS_PBF = 132 * MiB, WS_G = 148 * MiB, WS_BETA = 149 * MiB, WS_QKM = 150 * MiB, WS_ACT = 182 * MiB, WS_PROJ = 310 * MiB,
                 WS_GL = 966 * MiB, WS_CTL = 967 * MiB, WS_END = 968 * MiB;
constexpr size_t CTL_BYTES = 1 * MiB;
constexpr size_t WS_SSQ1 = WS_CTL + 256 * 1024, WS_SSQ2 = WS_CTL + 512 * 1024;
constexpr size_t WS_XB = WS_PROJ + 512 * MiB;
constexpr int LDS_BYTES = 147456;

__device__ __forceinline__ float bf2f(bf16_t v) { return __uint_as_float((unsigned)v << 16); }
__device__ __forceinline__ float bflo(unsigned w) { return __uint_as_float(w << 16); }
__device__ __forceinline__ float bfhi(unsigned w) { return __uint_as_float(w & 0xffff0000u); }
__device__ __forceinline__ unsigned pk2(float lo, float hi) { unsigned r; asm("v_cvt_pk_bf16_f32 %0, %1, %2" : "=v"(r) : "v"(lo), "v"(hi)); return r; }
__device__ __forceinline__ bf16_t f2bf(float f) { return (bf16_t)(pk2(f, 0.f) & 0xffffu); }
__device__ __forceinline__ float wave_sum(float v) {
#pragma unroll
    for (int o = 1; o < 64; o <<= 1) v += __shfl_xor(v, o);
    return v;
}
__device__ __forceinline__ float fast_sigmoid(float x) { return __builtin_amdgcn_rcpf(1.f + __builtin_amdgcn_exp2f(-x * LOG2E)); }
__device__ __forceinline__ float silu_f(float x) { return x * fast_sigmoid(x); }
#define LDS_WAIT() asm volatile("s_waitcnt lgkmcnt(0)" ::: "memory")

namespace pg8 {
constexpr int BM = 256, BK = 64, HALF = 128, HTB = HALF * BK * 2, STAGE_BYTES = 8 * HTB, NXCD = 8, WGM = 8;
__host__ __device__ __forceinline__ int lds_byte(int r, int c) { const int st = (r >> 4) * 2 + (c >> 5), rr = r & 15, cc = c & 31, ob = rr * 64 + cc * 2; return st * 1024 + (ob ^ (((ob >> 9) & 1) << 5)); }
__host__ __device__ __forceinline__ void stage_rc(int b, int& R, int& C) { const int st = b / 1024, sb = b % 1024, swz = sb ^ (((sb >> 9) & 1) << 5); R = (st >> 1) * 16 + swz / 64; C = (st & 1) * 32 + (swz % 64) / 2; }
__host__ __device__ __forceinline__ int perm32(int rho) { const int n = rho >> 4, i = rho & 15; return 8 * (i >> 2) + 4 * n + (i & 3); }
struct Unit { int pm, pn; };
struct Gemm { const bf16_t* A; const bf16_t* Bt; int M, N, K, lda; };
struct StaticOrder {
    int nM, nN, nwg, G, c;
    __device__ void init(int M, int N, int G_, int c_) { nM = M / BM; nN = N / BM; nwg = nM * nN; G = G_; c = c_; }
    __device__ bool next(int i, Unit& u) const {
        const long L = (long)i * G + c; if (L >= nwg) return false;
        int wgid = (int)L; { const int q = nwg / NXCD, r = nwg % NXCD, xcd = wgid % NXCD, off = wgid / NXCD; wgid = (xcd < r ? xcd * (q + 1) : r * (q + 1) + (xcd - r) * q) + off; }
        const int nig = WGM * nN, gid = wgid / nig, fm = gid * WGM, gsz = (nM - fm) < WGM ? (nM - fm) : WGM;
        u.pm = fm + ((wgid % nig) % gsz); u.pn = (wgid % nig) / gsz; return true;
    }
};
template <class Epi>
__device__ __forceinline__ void gemm_phase(LAS unsigned char* lds, const Gemm g, const StaticOrder& S, const Epi& E) {
    int tid = threadIdx.x; asm volatile("" : "+v"(tid));
    const int wid = __builtin_amdgcn_readfirstlane(tid >> 6), lane = tid & 63, wr = wid >> 2, wc = wid & 3, fr = lane & 15, fq = lane >> 4;
    const int K = g.K, nt = K / BK, lda = g.lda;
    unsigned voffA[2], voffB[2];
#pragma unroll
    for (int i = 0; i < 2; ++i) { int R, C; stage_rc(tid * 16 + i * 8192, R, C); const int Rb = ((R & ~31) + perm32(R & 31));
        voffA[i] = (unsigned)(R * lda + C) * 2u; voffB[i] = (unsigned)(Rb * K + C) * 2u; }
    const size_t kstep = (size_t)(BK * 2);
    const size_t hstepA = (size_t)HALF * lda * 2, tstepA = 2 * hstepA, hstepB = (size_t)HALF * K * 2, tstepB = 2 * hstepB;
    const unsigned ldsw = (unsigned)wid * 1024u;
    const int aoff = lds_byte(wr * 64 + fr, fq * 8), boff = lds_byte(wc * 32 + fr, fq * 8);
#define PG8_SA(b, h) (((b) * 2 + (h)) * HTB)
#define PG8_SB(b, h) ((4 + (b) * 2 + (h)) * HTB)
#define PG8_STAGE(bufoff, gbase, voff) do { _Pragma("unroll") for (int _i = 0; _i < 2; ++_i) \
        __builtin_amdgcn_global_load_lds((const unsigned*)((const char*)(gbase) + (voff)[_i]), (LAS unsigned*)(lds + (bufoff) + ldsw + _i * 8192), 16, 0, 0); } while (0)
#define PG8_LDA(dst, b, h) do { _Pragma("unroll") for (int m = 0; m < 4; ++m) _Pragma("unroll") for (int k = 0; k < 2; ++k) dst[m][k] = *(const LAS bf16x8*)(lds + PG8_SA(b, h) + aoff + m * 2048 + k * 1024); } while (0)
#define PG8_LDB(dst, b, h) do { _Pragma("unroll") for (int n = 0; n < 2; ++n) _Pragma("unroll") for (int k = 0; k < 2; ++k) dst[n][k] = *(const LAS bf16x8*)(lds + PG8_SB(b, h) + boff + n * 2048 + k * 1024); } while (0)
#define PG8_MMA(ai, bj, At, Bt) do { __builtin_amdgcn_s_setprio(1); _Pragma("unroll") for (int m = 0; m < 4; ++m) _Pragma("unroll") for (int n = 0; n < 2; ++n) _Pragma("unroll") for (int k = 0; k < 2; ++k) { \
        if constexpr (Epi::SWAP1 && (bj) == 1) acc[ai][bj][m][n] = __builtin_amdgcn_mfma_f32_16x16x32_bf16(At[m][k], Bt[n][k], acc[ai][bj][m][n], 0, 0, 0); \
        else acc[ai][bj][m][n] = __builtin_amdgcn_mfma_f32_16x16x32_bf16(Bt[n][k], At[m][k], acc[ai][bj][m][n], 0, 0, 0); } __builtin_amdgcn_s_setprio(0); } while (0)
#define PG8_WAIT_V(n) asm volatile("s_waitcnt vmcnt(" #n ")" ::: "memory")
#define PG8_WAIT_L(n) asm volatile("s_waitcnt lgkmcnt(" #n ")" ::: "memory")
#define PG8_BAR __builtin_amdgcn_s_barrier()
#define PG8_SCHED __builtin_amdgcn_sched_barrier(0)
    Unit cur, nxt; int ui = 0;
    if (!S.next(0, cur)) return;
    f32x4 acc[2][2][4][2];
#pragma unroll
    for (int a = 0; a < 2; ++a)
#pragma unroll
        for (int b = 0; b < 2; ++b)
#pragma unroll
            for (int m = 0; m < 4; ++m)
#pragma unroll
                for (int n = 0; n < 2; ++n) acc[a][b][m][n] = (f32x4){0.f, 0.f, 0.f, 0.f};
    bf16x8 At[4][2], B0[2][2], B1[2][2];
    const char* cA = (const char*)g.A + (size_t)cur.pm * tstepA; const char* cB = (const char*)g.Bt + (size_t)cur.pn * tstepB;
    PG8_STAGE(PG8_SB(0, 0), cB, voffB); PG8_STAGE(PG8_SB(0, 1), cB + hstepB, voffB); PG8_STAGE(PG8_SA(0, 0), cA, voffA); PG8_STAGE(PG8_SA(0, 1), cA + hstepA, voffA);
    if (wr == 1) PG8_BAR;
    PG8_WAIT_V(2); PG8_BAR;
    PG8_STAGE(PG8_SB(1, 0), cB + kstep, voffB); PG8_STAGE(PG8_SA(1, 0), cA + kstep, voffA); PG8_STAGE(PG8_SB(1, 1), cB + hstepB + kstep, voffB);
    PG8_WAIT_V(6); PG8_BAR;
    for (;;) {
        const bool has_next = S.next(ui + 1, nxt);
        const char* nA = has_next ? (const char*)g.A + (size_t)nxt.pm * tstepA : cA; const char* nB = has_next ? (const char*)g.Bt + (size_t)nxt.pn * tstepB : cB;
        for (int t = 0; t < nt; t += 2) {
            if constexpr (Epi::MID_T > 0) { if (t == Epi::MID_T) E.mid(acc, cur, wr, wc, fr, fq); }
            const bool last = (t == nt - 2);
            const char* a1 = cA + (size_t)(t + 1) * kstep;
            const char* a2 = last ? nA : cA + (size_t)(t + 2) * kstep; const char* b2 = last ? nB : cB + (size_t)(t + 2) * kstep;
            const char* a3 = a2 + kstep; const char* b3 = b2 + kstep;
            PG8_LDB(B0, 0, 0); PG8_LDB(B1, 0, 1); PG8_SCHED; PG8_LDA(At, 0, 0); PG8_STAGE(PG8_SA(1, 1), a1 + hstepA, voffA);
            PG8_WAIT_V(8); PG8_WAIT_L(0); PG8_BAR; PG8_MMA(0, 0, At, B0); PG8_MMA(0, 1, At, B1); PG8_BAR; PG8_SCHED;
            PG8_LDA(At, 0, 1); PG8_STAGE(PG8_SB(0, 0), b2, voffB); PG8_STAGE(PG8_SB(0, 1), b2 + hstepB, voffB); PG8_STAGE(PG8_SA(0, 0), a2, voffA);
            PG8_WAIT_V(8); PG8_WAIT_L(0); PG8_BAR; PG8_MMA(1, 0, At, B0); PG8_MMA(1, 1, At, B1); PG8_BAR; PG8_SCHED;
            PG8_LDB(B0, 1, 0); PG8_LDB(B1, 1, 1); PG8_SCHED; PG8_LDA(At, 1, 0); PG8_STAGE(PG8_SA(0, 1), a2 + hstepA, voffA);
            PG8_WAIT_V(8); PG8_WAIT_L(0); PG8_BAR; PG8_MMA(0, 0, At, B0); PG8_MMA(0, 1, At, B1); PG8_BAR; PG8_SCHED;
            PG8_LDA(At, 1, 1); PG8_STAGE(PG8_SB(1, 0), b3, voffB); PG8_STAGE(PG8_SB(1, 1), b3 + hstepB, voffB); PG8_STAGE(PG8_SA(1, 0), a3, voffA);
            PG8_WAIT_V(8); PG8_WAIT_L(0); PG8_BAR; PG8_MMA(1, 0, At, B0); PG8_MMA(1, 1, At, B1); PG8_BAR; PG8_SCHED;
        }
        if (wr == 0) PG8_BAR;
        E(acc, cur, wr, wc, fr, fq);
        if (!has_next) break;
#pragma unroll
        for (int a = 0; a < 2; ++a)
#pragma unroll
            for (int b = 0; b < 2; ++b)
#pragma unroll
                for (int m = 0; m < 4; ++m)
#pragma unroll
                    for (int n = 0; n < 2; ++n) acc[a][b][m][n] = (f32x4){0.f, 0.f, 0.f, 0.f};
        cur = nxt; cA = nA; cB = nB; ++ui;
        if (wr == 1) PG8_BAR;
    }
    PG8_WAIT_V(0);
    PG8_BAR;
#undef PG8_SA
#undef PG8_SB
#undef PG8_STAGE
#undef PG8_LDA
#undef PG8_LDB
#undef PG8_MMA
#undef PG8_WAIT_V
#undef PG8_WAIT_L
#undef PG8_BAR
#undef PG8_SCHED
}
}

enum { EP_BF16 = 0, EP_KV, EP_YA, EP_YB, EP_X1, EP_RELU2, EP_ACC, EP_F32, EP_PLE, EP_YAB };
__device__ __forceinline__ void store8bf(bf16_t* p, f32x4 a, f32x4 b) { u32x4 w; w.x = pk2(a[0], a[1]); w.y = pk2(a[2], a[3]); w.z = pk2(b[0], b[1]); w.w = pk2(b[2], b[3]); *(u32x4*)p = w; }
__device__ __forceinline__ void load8bf(const bf16_t* p, f32x4& a, f32x4& b) { const u32x4 w = *(const u32x4*)p; a = (f32x4){bflo(w.x), bfhi(w.x), bflo(w.y), bfhi(w.y)}; b = (f32x4){bflo(w.z), bfhi(w.z), bflo(w.w), bfhi(w.w)}; }
__device__ __forceinline__ f32x4 sig4(f32x4 v) { return (f32x4){fast_sigmoid(v[0]), fast_sigmoid(v[1]), fast_sigmoid(v[2]), fast_sigmoid(v[3])}; }
template <int MODE> struct Epi {
    static constexpr bool SWAP1 = (MODE == EP_KV);
    static constexpr int MID_T = (MODE == EP_YAB) ? 16 : 0;
    bf16_t* ob; float* of; int ldc; const bf16_t* gate; const float* res; bf16_t* vt; float* ssq;
    __device__ __forceinline__ void mid(f32x4 (&acc)[2][2][4][2], const pg8::Unit& u, int wr, int wc, int fr, int fq) const {
        int rowb = u.pm * 256 + wr * 64 + fr, col0 = u.pn * 256 + wc * 32 + 8 * fq;
        asm volatile("" : "+v"(rowb), "+v"(col0));
        u32x4 ga[2], gb[2];
        ga[0] = *(const u32x4*)(gate + (size_t)rowb * LDP + C_GA + col0); gb[0] = *(const u32x4*)(gate + (size_t)rowb * LDP + C_GB + col0);
#pragma unroll
        for (int st = 0; st < 16; ++st) {
            const int it = st >> 1, bj = st & 1, ai = it >> 2, m = it & 3;
            if (st + 1 < 16) { const int itn = (st + 1) >> 1, bjn = (st + 1) & 1; const size_t off = (size_t)(rowb + (itn >> 2) * 128 + (itn & 3) * 16) * LDP + col0 + bjn * 128;
                ga[(st + 1) & 1] = *(const u32x4*)(gate + off + C_GA); gb[(st + 1) & 1] = *(const u32x4*)(gate + off + C_GB); }
            f32x4 a0, a1, b0, b1; up8(ga[st & 1], a0, a1); up8(gb[st & 1], b0, b1);
#pragma unroll
            for (int e = 0; e < 4; ++e) {
                acc[ai][bj][m][0][e] *= (1.f + __builtin_amdgcn_exp2f(-b0[e] * LOG2E)) * __builtin_amdgcn_rcpf(1.f + __builtin_amdgcn_exp2f(-a0[e] * LOG2E));
                acc[ai][bj][m][1][e] *= (1.f + __builtin_amdgcn_exp2f(-b1[e] * LOG2E)) * __builtin_amdgcn_rcpf(1.f + __builtin_amdgcn_exp2f(-a1[e] * LOG2E)); }
            asm volatile("" ::: "memory");
        }
    }
    struct Pre { f32x4 f[2][2]; u32x4 g[2]; u32x4 y[2]; };
    __device__ __forceinline__ void preload(Pre& p, int row, int col0) const {
#pragma unroll
        for (int bj = 0; bj < 2; ++bj) { const int col = col0 + bj * 128;
            if constexpr (MODE == EP_YA) p.g[bj] = *(const u32x4*)(gate + (size_t)row * LDP + C_GA + col);
            else if constexpr (MODE == EP_YAB) p.g[bj] = *(const u32x4*)(gate + (size_t)row * LDP + C_GB + col);
            else if constexpr (MODE == EP_YB) { p.g[bj] = *(const u32x4*)(gate + (size_t)row * LDP + C_GB + col); p.y[bj] = *(const u32x4*)(ob + (size_t)row * DM + col); }
            else if constexpr (MODE == EP_X1) { const float* r = res + (size_t)row * DM + col; p.f[bj][0] = *(const f32x4*)r; p.f[bj][1] = *(const f32x4*)(r + 4); }
            else if constexpr (MODE == EP_ACC) p.y[bj] = *(const u32x4*)(ob + (size_t)row * DM + col);
            else if constexpr (MODE == EP_PLE) { p.y[bj] = *(const u32x4*)(vt + (size_t)row * DM + col); p.g[bj] = *(const u32x4*)(gate + (size_t)row * DM + col); }
        }
    }
    static __device__ __forceinline__ void up8(const u32x4 w, f32x4& a, f32x4& b) { a = (f32x4){bflo(w.x), bfhi(w.x), bflo(w.y), bfhi(w.y)}; b = (f32x4){bflo(w.z), bfhi(w.z), bflo(w.w), bfhi(w.w)}; }
    __device__ __forceinline__ void operator()(const f32x4 (&acc)[2][2][4][2], const pg8::Unit& u, int wr, int wc, int fr, int fq) const {
        const int rowb = u.pm * 256 + wr * 64 + fr, col0 = u.pn * 256 + wc * 32 + 8 * fq;
        float rs[8];
        if constexpr (MODE == EP_RELU2 || MODE == EP_PLE) {
#pragma unroll
            for (int it = 0; it < 8; ++it) rs[it] = ssq[rowb + (it >> 2) * 128 + (it & 3) * 16];
#pragma unroll
            for (int it = 0; it < 8; ++it) rs[it] = rsqrtf(rs[it] * (1.f / 2048.f) + EPS);
        }
        Pre pre[2];
        preload(pre[0], rowb, col0);
#pragma unroll
        for (int it = 0; it < 8; ++it) {
            const int ai = it >> 2, m = it & 3, row = rowb + ai * 128 + m * 16;
            if (it + 1 < 8) preload(pre[(it + 1) & 1], rowb + ((it + 1) >> 2) * 128 + ((it + 1) & 3) * 16, col0);
            const Pre& pp = pre[it & 1];
            float rsum = 0.f; const float rstd = (MODE == EP_RELU2 || MODE == EP_PLE) ? rs[it] : 1.f;
#pragma unroll
            for (int bj = 0; bj < 2; ++bj) {
                const int col = col0 + bj * 128;
                f32x4 v0 = acc[ai][bj][m][0], v1 = acc[ai][bj][m][1];
                if constexpr (MODE == EP_BF16) { store8bf(ob + (size_t)row * ldc + col, v0, v1); }
                else if constexpr (MODE == EP_RELU2) {
#pragma unroll
                    for (int e = 0; e < 4; ++e) { const float a = fmaxf(v0[e] * rstd, 0.f), b = fmaxf(v1[e] * rstd, 0.f); v0[e] = a * a; v1[e] = b * b; }
                    store8bf(ob + (size_t)row * ldc + col, v0, v1); }
                else if constexpr (MODE == EP_KV) {
                    if (bj == 0) store8bf(ob + (size_t)row * 1024 + u.pn * 128 + wc * 32 + 8 * fq, v0, v1);
                    else {
                        const int r0 = u.pm * 256 + ai * 128 + wr * 64 + m * 16 + 4 * fq, b = r0 >> 11, s = r0 & 2047;
                        bf16_t* base = vt + ((size_t)((b * 8 + u.pn) * 128 + wc * 32)) * 2048 + s;
                        u32x2 w0, w1; w0.x = pk2(v0[0], v0[1]); w0.y = pk2(v0[2], v0[3]); w1.x = pk2(v1[0], v1[1]); w1.y = pk2(v1[2], v1[3]);
                        *(u32x2*)(base + (size_t)pg8::perm32(fr) * 2048) = w0; *(u32x2*)(base + (size_t)pg8::perm32(16 + fr) * 2048) = w1; } }
                else if constexpr (MODE == EP_YA || MODE == EP_YAB) { f32x4 g0, g1; up8(pp.g[bj], g0, g1); store8bf(ob + (size_t)row * DM + col, sig4(g0) * v0, sig4(g1) * v1); }
                else if constexpr (MODE == EP_YB) { f32x4 g0, g1, a0, a1; up8(pp.g[bj], g0, g1); up8(pp.y[bj], a0, a1); store8bf(ob + (size_t)row * DM + col, a0 + sig4(g0) * v0, a1 + sig4(g1) * v1); }
                else if constexpr (MODE == EP_X1 || MODE == EP_ACC) { f32x4 r0, r1;
                    if constexpr (MODE == EP_X1) { r0 = pp.f[bj][0]; r1 = pp.f[bj][1]; } else up8(pp.y[bj], r0, r1);
                    const f32x4 x0 = r0 + v0, x1 = r1 + v1;
                    store8bf(ob + (size_t)row * DM + col, x0, x1);
                    rsum += (x0[0] * x0[0] + x0[1] * x0[1]) + (x0[2] * x0[2] + x0[3] * x0[3]) + (x1[0] * x1[0] + x1[1] * x1[1]) + (x1[2] * x1[2] + x1[3] * x1[3]); }
                else if constexpr (MODE == EP_F32) { float* o = of + (size_t)row * DM + col; *(f32x4*)o = v0; *(f32x4*)(o + 4) = v1; }
                else if constexpr (MODE == EP_PLE) { f32x4 p0, p1, x0, x1; up8(pp.g[bj], p0, p1); up8(pp.y[bj], x0, x1); float* o = of + (size_t)row * DM + col;
                    *(f32x4*)o = x0 + sig4(v0 * rstd) * p0; *(f32x4*)(o + 4) = x1 + sig4(v1 * rstd) * p1; }
            }
            if constexpr (MODE == EP_X1 || MODE == EP_ACC) { rsum += __shfl_xor(rsum, 16); rsum += __shfl_xor(rsum, 32);
                if (fq == 0) __hip_atomic_fetch_add(ssq + row, rsum, __ATOMIC_RELAXED, __HIP_MEMORY_SCOPE_AGENT); }
            asm volatile("" ::: "memory");
        }
    }
};

struct Params { const void* in[24]; float* out; unsigned char* ws; float ropeinv[32]; };

__device__ __forceinline__ int win_map(int n) {
    if (n < 4096) return n;
    if (n < 5632) return 4112 + (n - 4096);
    if (n < 6144) return 5648 + (n - 5632);
    if (n < 8192) return 6224 + (n - 6144);
    if (n < 10240) return 8272 + (n - 8192);
    if (n < 10304) return 6160 + (n - 10240);
    if (n < 10312) return 4096 + (n - 10304);
    if (n < 10320) return 4104 + (n - 10312);
    return -1;
}
struct TrJob { int widx, K, N, nblk, item; };
__device__ __forceinline__ const float* opq(const void* p) { unsigned long long v = (unsigned long long)p; asm volatile("" : "+s"(v)); return (const float*)v; }
__device__ __forceinline__ const float* tr_src(const Params& P, int w) {
    const float* a0 = opq(P.in[4]); const float* a1 = opq(P.in[10]); const float* a2 = opq(P.in[15]); const float* a3 = opq(P.in[16]); const float* a4 = opq(P.in[17]);
    const float* a5 = opq(P.in[19]); const float* a6 = opq(P.in[20]); const float* a7 = opq(P.in[22]); const float* a8 = opq(P.in[23]);
    return w == 0 ? a0 : w == 1 ? a1 : w == 2 ? a2 : w == 3 ? a3 : w == 4 ? a4 : w == 5 ? a5 : w == 6 ? a6 : w == 7 ? a7 : a8; }
__device__ __forceinline__ size_t tr_dst_off(int w) { return w == 0 ? WS_WIN : w == 1 ? WS_WKV : w == 2 ? WS_WA : w == 3 ? (WS_WA + 2048) : w == 4 ? WS_WOUT : w == 5 ? WS_WUP : w == 6 ? WS_WDN : w == 7 ? WS_WPG : WS_WPLE; }
__device__ __forceinline__ void tr_load(const Params& P, const TrJob& J, int lane, f32x4 (&v)[8]) {
    const int kb = J.item / J.nblk, nb = J.item % J.nblk, k0 = 64 * kb, n0 = 32 * nb, q4 = lane & 7, kr = lane >> 3;
    int oc = n0 + 4 * q4; if (J.widx == 0) oc = win_map(oc);
    const float* W = tr_src(P, J.widx);
#pragma unroll
    for (int i = 0; i < 8; ++i) v[i] = (oc >= 0) ? *(const f32x4*)(W + (size_t)(k0 + 8 * i + kr) * J.N + oc) : (f32x4){0.f, 0.f, 0.f, 0.f};
}
__device__ __forceinline__ void tr_finish(const Params& P, const TrJob& J, int lane, const f32x4 (&v)[8], LAS float* scr) {
    const int kb = J.item / J.nblk, nb = J.item % J.nblk, k0 = 64 * kb, n0 = 32 * nb, q4 = lane & 7, kr = lane >> 3;
    const float* kg5 = opq(P.in[18]); const float* kg7 = opq(P.in[21]); const float* kgain = (J.widx == 5) ? kg5 : (J.widx == 7) ? kg7 : nullptr;
    bf16_t* WT = (bf16_t*)(P.ws + tr_dst_off(J.widx));
    const int ldk = (J.widx == 2 || J.widx == 3) ? 2048 : J.K;
#pragma unroll
    for (int i = 0; i < 8; ++i) { LAS float* d = scr + (8 * i + kr) * 33 + 4 * q4; const float kg = kgain ? kgain[k0 + 8 * i + kr] : 1.f; d[0] = v[i][0] * kg; d[1] = v[i][1] * kg; d[2] = v[i][2] * kg; d[3] = v[i][3] * kg; }
    LDS_WAIT();
    const int c = lane & 7;
#pragma unroll
    for (int j = 0; j < 4; ++j) { const int n = (lane >> 3) + 8 * j; const LAS float* sp = scr + (8 * c) * 33 + n;
        u32x4 o; o.x = pk2(sp[0 * 33], sp[1 * 33]); o.y = pk2(sp[2 * 33], sp[3 * 33]); o.z = pk2(sp[4 * 33], sp[5 * 33]); o.w = pk2(sp[6 * 33], sp[7 * 33]);
        *(u32x4*)(WT + (size_t)(n0 + n) * ldk + k0 + 8 * c) = o; }
    LDS_WAIT();
}
__device__ __forceinline__ void rmsnorm_row(const float* xrow, const float* gain, bf16_t* orow, int lane) {
    const f32x4* xr = (const f32x4*)xrow + lane; const f32x4* gr = (const f32x4*)gain + lane;
    f32x4 v[8]; float s = 0.f;
#pragma unroll
    for (int j = 0; j < 8; ++j) { v[j] = xr[64 * j]; s += (v[j][0] * v[j][0] + v[j][1] * v[j][1]) + (v[j][2] * v[j][2] + v[j][3] * v[j][3]); }
    const float rstd = rsqrtf(wave_sum(s) * (1.f / 2048.f) + EPS);
    u32x2* o8 = (u32x2*)orow + lane;
#pragma unroll
    for (int j = 0; j < 8; ++j) { const f32x4 g = gr[64 * j]; u32x2 w; w.x = pk2(v[j][0] * rstd * g[0], v[j][1] * rstd * g[1]); w.y = pk2(v[j][2] * rstd * g[2], v[j][3] * rstd * g[3]); o8[64 * j] = w; }
}
__device__ __forceinline__ void rmsnorm_rows_phase(const float* X, const float* gain, bf16_t* O, int gw, int NGW, int lane) {
    for (int m = gw; m < MROWS / 2; m += NGW) {
        const f32x4* x0 = (const f32x4*)(X + (size_t)m * DM) + lane; const f32x4* x1 = (const f32x4*)(X + (size_t)(m + MROWS / 2) * DM) + lane; const f32x4* gr = (const f32x4*)gain + lane;
        f32x4 a[8], b[8]; float sa = 0.f, sb = 0.f;
#pragma unroll
        for (int j = 0; j < 8; ++j) { a[j] = x0[64 * j]; b[j] = x1[64 * j]; }
#pragma unroll
        for (int j = 0; j < 8; ++j) { sa += (a[j][0] * a[j][0] + a[j][1] * a[j][1]) + (a[j][2] * a[j][2] + a[j][3] * a[j][3]); sb += (b[j][0] * b[j][0] + b[j][1] * b[j][1]) + (b[j][2] * b[j][2] + b[j][3] * b[j][3]); }
        const float ra = rsqrtf(wave_sum(sa) * (1.f / 2048.f) + EPS), rb = rsqrtf(wave_sum(sb) * (1.f / 2048.f) + EPS);
        u32x2* oa = (u32x2*)(O + (size_t)m * DM) + lane; u32x2* ob = (u32x2*)(O + (size_t)(m + MROWS / 2) * DM) + lane;
#pragma unroll
        for (int j = 0; j < 8; ++j) { const f32x4 g = gr[64 * j]; u32x2 w; w.x = pk2(a[j][0] * ra * g[0], a[j][1] * ra * g[1]); w.y = pk2(a[j][2] * ra * g[2], a[j][3] * ra * g[3]); oa[64 * j] = w;
            w.x = pk2(b[j][0] * rb * g[0], b[j][1] * rb * g[1]); w.y = pk2(b[j][2] * rb * g[2], b[j][3] * rb * g[3]); ob[64 * j] = w; }
    }
}

__device__ __forceinline__ TrJob tr_job(int it) {
    constexpr int I_IN = 32 * (LDP / 32), I_KV = 8 * 64, I_A = 16 * 64, I_B = 16 * 64, I_OUT = 32 * 64, I_UP = 32 * 256, I_DN = 128 * 64, I_PG = 32 * 64;
    int r = it;
    if (r < I_IN) return TrJob{0, 2048, D_IN, LDP / 32, r}; r -= I_IN;
    if (r < I_KV) return TrJob{1, 512, 2048, 64, r}; r -= I_KV;
    if (r < I_A) return TrJob{2, 1024, 2048, 64, r}; r -= I_A;
    if (r < I_B) return TrJob{3, 1024, 2048, 64, r}; r -= I_B;
    if (r < I_OUT) return TrJob{4, 2048, 2048, 64, r}; r -= I_OUT;
    if (r < I_UP) return TrJob{5, 2048, 8192, 256, r}; r -= I_UP;
    if (r < I_DN) return TrJob{6, 8192, 2048, 64, r}; r -= I_DN;
    if (r < I_PG) return TrJob{7, 2048, 2048, 64, r}; r -= I_PG;
    return TrJob{8, 256, 2048, 64, r};
}
constexpr int TR_IN_ITEMS = 32 * (LDP / 32);
constexpr int TR_ALL_ITEMS = 32 * (LDP / 32) + 8 * 64 + 16 * 64 + 16 * 64 + 32 * 64 + 32 * 256 + 128 * 64 + 32 * 64 + 4 * 64;
__device__ __forceinline__ void transpose_range(const Params& P, LAS float* scr, int lo, int hi, int gw, int NGW, int lane) {
    for (int it = lo + gw; it < hi; it += 2 * NGW) {
        const TrJob J0 = tr_job(it); f32x4 v0[8], v1[8]; tr_load(P, J0, lane, v0);
        const bool two = (it + NGW < hi);
        const TrJob J1 = tr_job(two ? it + NGW : it);
        if (two) tr_load(P, J1, lane, v1);
        tr_finish(P, J0, lane, v0, scr);
        if (two) tr_finish(P, J1, lane, v1, scr);
    }
}
__device__ __forceinline__ void p0_prologue(const Params& P, LAS unsigned char* lds, int gw, int NGW, int wave, int lane) {
    unsigned char* ws = P.ws;
    LAS float* scr = (LAS float*)(lds + wave * 16384);
    transpose_range(P, scr, 0, TR_IN_ITEMS, gw, NGW, lane);
    rmsnorm_rows_phase((const float*)P.in[0], (const float*)P.in[3], (bf16_t*)(ws + WS_ACT), gw, NGW, lane);
    { const f32x4* src = (const f32x4*)P.in[1]; u32x4* dst = (u32x4*)(ws + WS_PBF); const size_t n8 = (size_t)MROWS * PLE / 8;
      for (size_t i = (size_t)gw * 64 + lane; i < n8; i += (size_t)NGW * 64) { const f32x4 a = src[2 * i], b = src[2 * i + 1]; u32x4 w; w.x = pk2(a[0], a[1]); w.y = pk2(a[2], a[3]); w.z = pk2(b[0], b[1]); w.w = pk2(b[2], b[3]); dst[i] = w; } }
}

__device__ __forceinline__ void rope_cs(float pos, float inv, float& c, float& s) {
    const float a = pos * inv;
    double rev = (double)a * 0.15915494309189535; rev -= rint(rev);
    const float r = (float)rev; s = __builtin_amdgcn_sinf(r); c = __builtin_amdgcn_cosf(r);
}
__device__ __forceinline__ void unpack8(const u32x4 w, float (&f)[8]) { f[0] = bflo(w.x); f[1] = bfhi(w.x); f[2] = bflo(w.y); f[3] = bfhi(w.y); f[4] = bflo(w.z); f[5] = bfhi(w.z); f[6] = bflo(w.w); f[7] = bfhi(w.w); }
__device__ __forceinline__ u32x4 pack8(const float (&f)[8]) { u32x4 w; w.x = pk2(f[0], f[1]); w.y = pk2(f[2], f[3]); w.z = pk2(f[4], f[5]); w.w = pk2(f[6], f[7]); return w; }
__device__ __forceinline__ void p2_prep(const Params& P, int gw, int NGW, int lane) {
    unsigned char* ws = P.ws;
    bf16_t* proj = (bf16_t*)(ws + WS_PROJ);
    const int* positions = (const int*)P.in[2];
    const float* ckvn = (const float*)P.in[9]; const float* qng = (const float*)P.in[11]; const float* qrg = (const float*)P.in[12]; const float* kng = (const float*)P.in[13]; const float* krg = (const float*)P.in[14];
    const float* dt_bias = (const float*)P.in[6]; const float* a_log = (const float*)P.in[7];
    float* G = (float*)(ws + WS_G); float* BETA = (float*)(ws + WS_BETA);
    const float QSCALE = 0.07216878364870322f * LOG2E;
    {
        const int h = lane >> 3, seg = lane & 7;
        float gn[16], gr[8], inv8[8], gc8[8];
#pragma unroll
        for (int e = 0; e < 16; ++e) gn[e] = qng[16 * seg + e] * kng[16 * seg + e] * QSCALE;
#pragma unroll
        for (int e = 0; e < 8; ++e) { gr[e] = qrg[8 * seg + e]; inv8[e] = P.ropeinv[8 * (seg & 3) + e]; gc8[e] = ckvn[8 * lane + e]; }
        const float inv1 = P.ropeinv[lane & 31], kr_g = krg[lane];
        for (int m = gw; m < MROWS; m += NGW) {
            bf16_t* row = proj + (size_t)m * LDP;
            bf16_t* np = row + C_MQ + h * 192 + 16 * seg; bf16_t* rp = row + C_MQ + h * 192 + 128 + 8 * seg; bf16_t* cp = row + C_CKV + 8 * lane;
            const u32x4 wn0 = *(const u32x4*)np, wn1 = *(const u32x4*)(np + 8), wr = *(const u32x4*)rp, wc = *(const u32x4*)cp;
            const bf16_t wk = row[C_KR + lane]; const bf16_t wba = (lane < 16) ? row[C_BETA + lane] : (bf16_t)0;
            const float pos = (float)positions[m];
            float a[8], b[8]; unpack8(wn0, a); unpack8(wn1, b);
            float ss = 0.f;
#pragma unroll
            for (int e = 0; e < 8; ++e) ss += a[e] * a[e] + b[e] * b[e];
            ss += __shfl_xor(ss, 1); ss += __shfl_xor(ss, 2); ss += __shfl_xor(ss, 4);
            const float rstd = rsqrtf(ss * (1.f / 128.f) + EPS);
#pragma unroll
            for (int e = 0; e < 8; ++e) { a[e] = a[e] * rstd * gn[e]; b[e] = b[e] * rstd * gn[8 + e]; }
            *(u32x4*)np = pack8(a); *(u32x4*)(np + 8) = pack8(b);
            float x[8]; unpack8(wr, x);
            float s2 = 0.f;
#pragma unroll
            for (int e = 0; e < 8; ++e) s2 += x[e] * x[e];
            s2 += __shfl_xor(s2, 1); s2 += __shfl_xor(s2, 2); s2 += __shfl_xor(s2, 4);
            const float rs2 = rsqrtf(s2 * (1.f / 64.f) + EPS);
#pragma unroll
            for (int e = 0; e < 8; ++e) { const float xn = x[e] * rs2 * gr[e]; const float px = __shfl_xor(xn, 4); float cs, sn; rope_cs(pos, inv8[e], cs, sn);
                x[e] = ((seg < 4) ? (xn * cs - px * sn) : (xn * cs + px * sn)) * QSCALE; }
            *(u32x4*)rp = pack8(x);
            float cv[8]; unpack8(wc, cv);
            float s3 = 0.f;
#pragma unroll
            for (int e = 0; e < 8; ++e) s3 += cv[e] * cv[e];
            const float rs3 = rsqrtf(wave_sum(s3) * (1.f / 512.f) + EPS);
#pragma unroll
            for (int e = 0; e < 8; ++e) cv[e] = cv[e] * rs3 * gc8[e];
            *(u32x4*)cp = pack8(cv);
            { float xk = bf2f(wk); const float rs4 = rsqrtf(wave_sum(xk * xk) * (1.f / 64.f) + EPS); xk = xk * rs4 * kr_g;
              float cs, sn; rope_cs(pos, inv1, cs, sn);
              const float px = __shfl_xor(xk, 32); row[C_KR + lane] = f2bf((lane < 32) ? (xk * cs - px * sn) : (xk * cs + px * sn)); }
            if (lane < 8) BETA[(size_t)m * 8 + lane] = 1.f / (1.f + expf(-bf2f(wba)));
            else if (lane < 16) { const int hh = lane - 8; const float z = bf2f(wba) + dt_bias[hh]; const float sp = (z > 20.f) ? z : log1pf(expf(z)); G[(size_t)m * 8 + hh] = -expf(a_log[hh]) * sp; }
        }
    }
    const float* convw = (const float*)P.in[5];
    bf16_t* QA = (bf16_t*)P.out;
    for (int it = gw; it < (MROWS / 32) * 6; it += NGW) {
        const int run = it / 6, gg = it % 6, m0 = run * 32, s0 = m0 & 2047, c = gg * 512 + 8 * lane;
        float w0[8], w1[8], w2[8], w3[8];
#pragma unroll
        for (int e = 0; e < 8; e += 4) { *(f32x4*)(w0 + e) = *(const f32x4*)(convw + 0 * 3072 + c + e); *(f32x4*)(w1 + e) = *(const f32x4*)(convw + 1 * 3072 + c + e);
                                         *(f32x4*)(w2 + e) = *(const f32x4*)(convw + 2 * 3072 + c + e); *(f32x4*)(w3 + e) = *(const f32x4*)(convw + 3 * 3072 + c + e); }
        const bf16_t* src = proj + (size_t)m0 * LDP + c;
        float h1[8], h2[8], h3[8];
        if (s0 != 0) { unpack8(*(const u32x4*)(src - (size_t)1 * LDP), h1); unpack8(*(const u32x4*)(src - (size_t)2 * LDP), h2); unpack8(*(const u32x4*)(src - (size_t)3 * LDP), h3); }
        else {
#pragma unroll
            for (int e = 0; e < 8; ++e) { h1[e] = 0.f; h2[e] = 0.f; h3[e] = 0.f; } }
        bf16_t* dst = QA + (size_t)(gg >> 1) * ((size_t)MROWS * 1024) + (size_t)m0 * 1024 + (gg & 1) * 512 + 8 * lane;
        const float post = (gg < 2) ? 0.08838834764831845f : 1.f;
#pragma unroll
        for (int tb = 0; tb < 4; ++tb) {
            u32x4 raw[8];
#pragma unroll
            for (int q = 0; q < 8; ++q) raw[q] = *(const u32x4*)(src + (size_t)(8 * tb + q) * LDP);
#pragma unroll
            for (int q = 0; q < 8; ++q) {
                float cur[8], y[8]; unpack8(raw[q], cur);
                float ss = 0.f;
#pragma unroll
                for (int e = 0; e < 8; ++e) { y[e] = silu_f(w3[e] * cur[e] + w2[e] * h1[e] + w1[e] * h2[e] + w0[e] * h3[e]); ss += y[e] * y[e]; }
                if (gg < 4) { ss += __shfl_xor(ss, 1); ss += __shfl_xor(ss, 2); ss += __shfl_xor(ss, 4); ss += __shfl_xor(ss, 8); const float sc = rsqrtf(ss + EPS) * post;
#pragma unroll
                    for (int e = 0; e < 8; ++e) y[e] *= sc; }
                *(u32x4*)(dst + (size_t)(8 * tb + q) * 1024) = pack8(y);
#pragma unroll
                for (int e = 0; e < 8; ++e) { h3[e] = h2[e]; h2[e] = h1[e]; h1[e] = cur[e]; }
            }
        }
    }
}

constexpr int SOLVE_NOPS = 528, SOLVE_R = 8, SOLVE_D = 6;
struct SolveOps { unsigned char j[SOLVE_NOPS + SOLVE_R], q[SOLVE_NOPS + SOLVE_R]; };
constexpr SolveOps make_solve_ops() { SolveOps o{}; int t = 0; for (int j = 0; j < 63; ++j) for (int q = (j + 1) >> 2; q < 16; ++q) { o.j[t] = (unsigned char)j; o.q[t] = (unsigned char)q; ++t; } return o; }
constexpr SolveOps SOPS = make_solve_ops();
template <int T, int END> struct SolveStep {
    static __device__ __forceinline__ void run(f32x2 (&r)[32], f32x4 (&buf)[SOLVE_R], const LAS f32x4* Atv) {
        constexpr int TL = T + SOLVE_D;
        if constexpr (TL < END) buf[TL % SOLVE_R] = Atv[SOPS.j[TL] * 16 + SOPS.q[TL]];
        __builtin_amdgcn_sched_barrier(0);
        constexpr int j = SOPS.j[T], q = SOPS.q[T];
        const float xj = r[j >> 1][j & 1]; const f32x2 x2 = {xj, xj}; const f32x4 a = buf[T % SOLVE_R];
        r[2 * q] = r[2 * q] - (f32x2){a[0], a[1]} * x2; r[2 * q + 1] = r[2 * q + 1] - (f32x2){a[2], a[3]} * x2;
        __builtin_amdgcn_sched_barrier(0);
        SolveStep<T + 1, END>::run(r, buf, Atv);
    }
};
template <int END> struct SolveStep<END, END> { static __device__ __forceinline__ void run(f32x2 (&)[32], f32x4 (&)[SOLVE_R], const LAS f32x4*) {} };

__device__ __forceinline__ void delta_prep(const Params& P, LAS unsigned char* lds) {
    unsigned char* ws = P.ws;
    int tid = threadIdx.x; asm volatile("" : "+v"(tid));
    const int wave = __builtin_amdgcn_readfirstlane(tid >> 6), lane = tid & 63, sub = wave >> 2, tid_s = tid & 255, wv = wave & 3, fr = lane & 15, fq = lane >> 4;
    bf16_t* QA = (bf16_t*)P.out; bf16_t* KA = QA + (size_t)MROWS * 1024; bf16_t* VA = KA + (size_t)MROWS * 1024; bf16_t* WB = VA + (size_t)MROWS * 1024;
    const float* G = (const float*)(ws + WS_G); const float* BETA = (const float*)(ws + WS_BETA); bf16_t* QKM = (bf16_t*)(ws + WS_QKM); float* GL = (float*)(ws + WS_GL);
    LAS unsigned char* base = lds + sub * 61440;
    LAS bf16_t* Ks = (LAS bf16_t*)base; LAS bf16_t* Qs = (LAS bf16_t*)(base + 17408); LAS float* At = (LAS float*)(base + 34816);
    LAS float* gcs = (LAS float*)(base + 51200); LAS float* betas = (LAS float*)(base + 51456); LAS float* bes = (LAS float*)(base + 51712);
    LAS bf16_t* QKs = (LAS bf16_t*)(base + 51968);
    for (int unit = blockIdx.x; unit < 2048; unit += gridDim.x) {
        const int ch = unit * 2 + sub, n = ch & 31, bh = ch >> 5, h = bh & 7, b = bh >> 3, m0 = b * 2048 + n * 64;
#pragma unroll
        for (int i = 0; i < 4; ++i) { const int p = tid_s + 256 * i, row = p >> 4, c = p & 15; const size_t go = (size_t)(m0 + row) * 1024 + h * 128 + c * 8;
            *(LAS u32x4*)(Ks + row * 136 + c * 8) = *(const u32x4*)(KA + go); *(LAS u32x4*)(Qs + row * 136 + c * 8) = *(const u32x4*)(QA + go); }
        if (wv == 0) { float g = G[(size_t)(m0 + lane) * 8 + h] * LOG2E;
#pragma unroll
            for (int o = 1; o < 64; o <<= 1) { const float t = __shfl_up(g, o); if (lane >= o) g += t; }
            const float be = BETA[(size_t)(m0 + lane) * 8 + h];
            gcs[lane] = g; betas[lane] = be; bes[lane] = be * __builtin_amdgcn_exp2f(g); if (lane == 63) GL[ch] = __builtin_amdgcn_exp2f(g); }
        __syncthreads();
        { const int ti = wv; bf16x8 ak[4], aq[4];
#pragma unroll
          for (int ks = 0; ks < 4; ++ks) { ak[ks] = *(const LAS bf16x8*)(Ks + (16 * ti + fr) * 136 + 32 * ks + fq * 8); aq[ks] = *(const LAS bf16x8*)(Qs + (16 * ti + fr) * 136 + 32 * ks + fq * 8); }
          f32x4 gi, bi;
#pragma unroll
          for (int j = 0; j < 4; ++j) { gi[j] = gcs[16 * ti + fq * 4 + j]; bi[j] = betas[16 * ti + fq * 4 + j]; }
#pragma unroll
          for (int tj = 0; tj < 4; ++tj) {
              f32x4 ck = {0.f, 0.f, 0.f, 0.f}, cq = {0.f, 0.f, 0.f, 0.f};
              if (tj <= ti) {
#pragma unroll
                  for (int ks = 0; ks < 4; ++ks) { const bf16x8 bk = *(const LAS bf16x8*)(Ks + (16 * tj + fr) * 136 + 32 * ks + fq * 8);
                      ck = __builtin_amdgcn_mfma_f32_16x16x32_bf16(ak[ks], bk, ck, 0, 0, 0); cq = __builtin_amdgcn_mfma_f32_16x16x32_bf16(aq[ks], bk, cq, 0, 0, 0); } }
              const int jj = 16 * tj + fr; const float gj = gcs[jj]; f32x4 av; float qv[4];
#pragma unroll
              for (int j = 0; j < 4; ++j) { const int i = 16 * ti + fq * 4 + j; const float dec = (i >= jj) ? __builtin_amdgcn_exp2f(gi[j] - gj) : 0.f;
                  av[j] = (i > jj) ? bi[j] * ck[j] * dec : 0.f; qv[j] = cq[j] * dec; }
              *(LAS f32x4*)(At + jj * 64 + 16 * ti + fq * 4) = av;
#pragma unroll
              for (int j = 0; j < 4; ++j) QKs[(16 * ti + fq * 4 + j) * 72 + jj] = f2bf(qv[j]);
          } }
        u32x4 vreg[4];
        const float gl = gcs[63];
#pragma unroll
        for (int i = 0; i < 4; ++i) { const int p = tid_s + 256 * i, row = p >> 4, c = p & 15; const size_t go = (size_t)(m0 + row) * 1024 + h * 128 + c * 8;
            vreg[i] = *(const u32x4*)(VA + go);
            const u32x4 q = *(const LAS u32x4*)(Qs + row * 136 + c * 8); const float e = __builtin_amdgcn_exp2f(gcs[row]); u32x4 o;
            o.x = pk2(bflo(q.x) * e, bfhi(q.x) * e); o.y = pk2(bflo(q.y) * e, bfhi(q.y) * e); o.z = pk2(bflo(q.z) * e, bfhi(q.z) * e); o.w = pk2(bflo(q.w) * e, bfhi(q.w) * e);
            *(u32x4*)(QA + go) = o; }
#pragma unroll
        for (int i = 0; i < 4; ++i) { const int p = tid_s + 256 * i, dk = p & 127, j0 = (p >> 7) * 8; float v[8];
#pragma unroll
            for (int e = 0; e < 8; ++e) v[e] = bf2f(Ks[(j0 + e) * 136 + dk]) * __builtin_amdgcn_exp2f(gl - gcs[j0 + e]);
            u32x4 o; o.x = pk2(v[0], v[1]); o.y = pk2(v[2], v[3]); o.z = pk2(v[4], v[5]); o.w = pk2(v[6], v[7]);
            *(u32x4*)(KA + (size_t)(m0 + (dk >> 1)) * 1024 + h * 128 + (dk & 1) * 64 + j0) = o; }
        __syncthreads();
#pragma unroll
        for (int i = 0; i < 4; ++i) { const int p = tid_s + 256 * i, row = p >> 4, c = p & 15; *(LAS u32x4*)(Qs + row * 136 + c * 8) = vreg[i]; }
#pragma unroll
        for (int i = 0; i < 2; ++i) { const int p = tid_s + 256 * i, row = p >> 3, c8 = p & 7; *(u32x4*)(QKM + (size_t)ch * 4096 + row * 64 + c8 * 8) = *(const LAS u32x4*)(QKs + row * 72 + c8 * 8); }
        __syncthreads();
        { const int c = tid_s; LAS bf16_t* rp = Ks + (c >> 7) * 8704 + (c & 127); const LAS float* sp = (c >= 128) ? betas : bes;
          int zv = 0; asm volatile("" : "+v"(zv)); const LAS f32x4* Atv = (const LAS f32x4*)At + zv;
          f32x2 r[32];
#pragma unroll
          for (int i = 0; i < 64; ++i) r[i >> 1][i & 1] = bf2f(rp[i * 136]) * sp[i];
          f32x4 buf[SOLVE_R];
#pragma unroll
          for (int t = 0; t < SOLVE_D; ++t) buf[t] = Atv[SOPS.j[t] * 16 + SOPS.q[t]];
          SolveStep<0, SOLVE_NOPS>::run(r, buf, Atv);
#pragma unroll
          for (int i = 0; i < 64; ++i) rp[i * 136] = f2bf(r[i >> 1][i & 1]); }
        __syncthreads();
#pragma unroll
        for (int i = 0; i < 4; ++i) { const int p = tid_s + 256 * i, row = p >> 4, c = p & 15; const size_t go = (size_t)(m0 + row) * 1024 + h * 128 + c * 8;
            *(u32x4*)(WB + go) = *(const LAS u32x4*)(Ks + row * 136 + c * 8); *(u32x4*)(VA + go) = *(const LAS u32x4*)(Qs + row * 136 + c * 8); }
        __syncthreads();
    }
}

__device__ __forceinline__ void delta_scan(const Params& P, LAS unsigned char* lds) {
    unsigned char* ws = P.ws;
    int tid = threadIdx.x; asm volatile("" : "+v"(tid));
    const int wave = __builtin_amdgcn_readfirstlane(tid >> 6), lane = tid & 63, fr = lane & 15, fq = lane >> 4;
    const bf16_t* QA = (const bf16_t*)P.out; const bf16_t* KA = QA + (size_t)MROWS * 1024; const bf16_t* UA = KA + (size_t)MROWS * 1024; const bf16_t* WB = UA + (size_t)MROWS * 1024;
    const bf16_t* QKM = (const bf16_t*)(ws + WS_QKM); const float* GL = (const float*)(ws + WS_GL); bf16_t* proj = (bf16_t*)(ws + WS_PROJ);
    const float* ogain = (const float*)P.in[8];
    LAS bf16_t* Ws = (LAS bf16_t*)lds; LAS bf16_t* Qs = (LAS bf16_t*)(lds + 17408); LAS bf16_t* Kt = (LAS bf16_t*)(lds + 34816); LAS bf16_t* QKs = (LAS bf16_t*)(lds + 53248);
    LAS bf16_t* Us = (LAS bf16_t*)(lds + 62464); LAS bf16_t* St = (LAS bf16_t*)(lds + 79872); LAS bf16_t* VNt = (LAS bf16_t*)(lds + 114688); LAS float* SSQ = (LAS float*)(lds + 133120);
    const int it = wave >> 1, dvq = wave & 1;
    for (int unit = blockIdx.x; unit < 128; unit += gridDim.x) {
        const int bh = unit, h = bh & 7, b = bh >> 3;
        f32x4 sacc[8];
#pragma unroll
        for (int d = 0; d < 8; ++d) sacc[d] = (f32x4){0.f, 0.f, 0.f, 0.f};
        float og[4];
#pragma unroll
        for (int d = 0; d < 4; ++d) og[d] = ogain[16 * (4 * dvq + d) + fr];
        u32x4 rw[2], rq[2], rk[2], ru[2], rqk;
#define SCAN_LOAD(nn) do { const int m0_ = b * 2048 + (nn) * 64; const size_t ch_ = (size_t)bh * 32 + (nn); \
            _Pragma("unroll") for (int i = 0; i < 2; ++i) { const int p = tid + 512 * i, row = p >> 4, c = p & 15; const size_t go = (size_t)(m0_ + row) * 1024 + h * 128 + c * 8; rw[i] = *(const u32x4*)(WB + go); rq[i] = *(const u32x4*)(QA + go); ru[i] = *(const u32x4*)(UA + go); \
                const int dk = p >> 3, c8 = p & 7; rk[i] = *(const u32x4*)(KA + (size_t)(m0_ + (dk >> 1)) * 1024 + h * 128 + (dk & 1) * 64 + c8 * 8); } \
            { const int row = tid >> 3, c8 = tid & 7; rqk = *(const u32x4*)(QKM + ch_ * 4096 + row * 64 + c8 * 8); } } while (0)
#define SCAN_STORE() do { \
            _Pragma("unroll") for (int i = 0; i < 2; ++i) { const int p = tid + 512 * i, row = p >> 4, c = p & 15; *(LAS u32x4*)(Ws + row * 136 + c * 8) = rw[i]; *(LAS u32x4*)(Qs + row * 136 + c * 8) = rq[i]; *(LAS u32x4*)(Us + row * 136 + c * 8) = ru[i]; \
                const int dk = p >> 3, c8 = p & 7; *(LAS u32x4*)(Kt + dk * 72 + c8 * 8) = rk[i]; } \
            { const int row = tid >> 3, c8 = tid & 7; *(LAS u32x4*)(QKs + row * 72 + c8 * 8) = rqk; } } while (0)
        SCAN_LOAD(0);
        for (int n = 0; n < 32; ++n) {
            const int m0 = b * 2048 + n * 64;
            SCAN_STORE();
#pragma unroll
            for (int d = 0; d < 8; ++d) { u32x2 w; w.x = pk2(sacc[d][0], sacc[d][1]); w.y = pk2(sacc[d][2], sacc[d][3]); *(LAS u32x2*)(St + (16 * d + fr) * 136 + 16 * wave + fq * 4) = w; }
            const float gl = GL[bh * 32 + n];
            __syncthreads();
            if (n + 1 < 32) SCAN_LOAD(n + 1);
            bf16_t zr[4][4];
#pragma unroll
            for (int d = 0; d < 4; ++d)
#pragma unroll
                for (int j = 0; j < 4; ++j) zr[d][j] = proj[(size_t)(m0 + 16 * it + fq * 4 + j) * LDP + C_Z + h * 128 + 16 * (4 * dvq + d) + fr];
            f32x4 a1[4], a2[4];
#pragma unroll
            for (int d = 0; d < 4; ++d) { a1[d] = (f32x4){0.f, 0.f, 0.f, 0.f}; a2[d] = (f32x4){0.f, 0.f, 0.f, 0.f}; }
#pragma unroll
            for (int ks = 0; ks < 4; ++ks) { const bf16x8 wf = *(const LAS bf16x8*)(Ws + (16 * it + fr) * 136 + 32 * ks + fq * 8), qf = *(const LAS bf16x8*)(Qs + (16 * it + fr) * 136 + 32 * ks + fq * 8);
#pragma unroll
                for (int d = 0; d < 4; ++d) { const bf16x8 sf = *(const LAS bf16x8*)(St + (16 * (4 * dvq + d) + fr) * 136 + 32 * ks + fq * 8);
                    a1[d] = __builtin_amdgcn_mfma_f32_16x16x32_bf16(wf, sf, a1[d], 0, 0, 0); a2[d] = __builtin_amdgcn_mfma_f32_16x16x32_bf16(qf, sf, a2[d], 0, 0, 0); } }
#pragma unroll
            for (int d = 0; d < 4; ++d) { const int dv = 16 * (4 * dvq + d) + fr; float vn[4];
#pragma unroll
                for (int j = 0; j < 4; ++j) vn[j] = bf2f(Us[(16 * it + fq * 4 + j) * 136 + dv]) - a1[d][j];
                u32x2 w; w.x = pk2(vn[0], vn[1]); w.y = pk2(vn[2], vn[3]); *(LAS u32x2*)(VNt + dv * 72 + 16 * it + fq * 4) = w; }
            __syncthreads();
#pragma unroll
            for (int d = 0; d < 8; ++d) sacc[d] = sacc[d] * gl;
#pragma unroll
            for (int k2 = 0; k2 < 2; ++k2) { const bf16x8 qkf = *(const LAS bf16x8*)(QKs + (16 * it + fr) * 72 + 32 * k2 + fq * 8), kf = *(const LAS bf16x8*)(Kt + (16 * wave + fr) * 72 + 32 * k2 + fq * 8);
#pragma unroll
                for (int d = 0; d < 8; ++d) { const bf16x8 vf = *(const LAS bf16x8*)(VNt + (16 * d + fr) * 72 + 32 * k2 + fq * 8);
                    sacc[d] = __builtin_amdgcn_mfma_f32_16x16x32_bf16(kf, vf, sacc[d], 0, 0, 0);
                    if ((d >> 2) == dvq) a2[d & 3] = __builtin_amdgcn_mfma_f32_16x16x32_bf16(qkf, vf, a2[d & 3], 0, 0, 0); } }
            float ssq[4];
#pragma unroll
            for (int j = 0; j < 4; ++j) { float t = 0.f;
#pragma unroll
                for (int d = 0; d < 4; ++d) t += a2[d][j] * a2[d][j];
                t += __shfl_xor(t, 1); t += __shfl_xor(t, 2); t += __shfl_xor(t, 4); t += __shfl_xor(t, 8); ssq[j] = t; }
            if (fr == 0) {
#pragma unroll
                for (int j = 0; j < 4; ++j) SSQ[(16 * it + fq * 4 + j) * 2 + dvq] = ssq[j]; }
            __syncthreads();
#pragma unroll
            for (int j = 0; j < 4; ++j) { const int row = 16 * it + fq * 4 + j; const float rstd = rsqrtf((SSQ[row * 2] + SSQ[row * 2 + 1]) * (1.f / 128.f) + EPS);
#pragma unroll
                for (int d = 0; d < 4; ++d) proj[(size_t)(m0 + row) * LDP + C_Q + h * 128 + 16 * (4 * dvq + d) + fr] = f2bf(a2[d][j] * rstd * og[d] * silu_f(bf2f(zr[d][j]))); }
        }
        __syncthreads();
#undef SCAN_LOAD
#undef SCAN_STORE
    }
}

__device__ __forceinline__ void mla_attention(const Params& P, LAS unsigned char* lds) {
    unsigned char* ws = P.ws;
    int tid = threadIdx.x; asm volatile("" : "+v"(tid));
    const int wave = __builtin_amdgcn_readfirstlane(tid >> 6), lane = tid & 63, fr = lane & 15, fq = lane >> 4;
    bf16_t* proj = (bf16_t*)(ws + WS_PROJ); const bf16_t* KN = (const bf16_t*)(ws + WS_ACT); const bf16_t* VT = KN + (size_t)MROWS * 1024;
    const int kkey = tid >> 3, kseg = tid & 7, vdv = tid >> 2, vseg = tid & 3;
    unsigned* qctr = (unsigned*)(ws + WS_CTL + 128 * 1024);
    volatile LAS unsigned* qslot = (volatile LAS unsigned*)(lds + 139264);
    const bool stat = (gridDim.x == 256);
    for (int iter = 0;; ++iter) {
        int qi, bh;
        if (stat) { const bool sc = (int)blockIdx.x < 128; if (iter >= (sc ? 2 : 6)) break; bh = (int)blockIdx.x & 127;
            qi = sc ? (iter == 0 ? 7 : 4) : (iter == 0 ? 6 : iter == 1 ? 5 : iter == 2 ? 3 : iter == 3 ? 2 : iter == 4 ? 1 : 0); }
        else {
            if (tid == 0) qslot[0] = __hip_atomic_fetch_add(qctr, 1u, __ATOMIC_RELAXED, __HIP_MEMORY_SCOPE_AGENT);
            __syncthreads();
            const int L = (int)qslot[0];
            if (L >= 1024) break;
            qi = 7 - (L >> 7); bh = L & 127; }
        const int h = bh & 7, b = bh >> 3;
        const int q0 = qi * 256, ntiles = 4 * (qi + 1);
        bf16x8 qf[2][6];
#pragma unroll
        for (int m = 0; m < 2; ++m)
#pragma unroll
            for (int ks = 0; ks < 6; ++ks) qf[m][ks] = *(const bf16x8*)(proj + (size_t)(b * 2048 + q0 + 32 * wave + 16 * m + fr) * LDP + C_MQ + h * 192 + 32 * ks + fq * 8);
        f32x4 accO[2][8];
#pragma unroll
        for (int m = 0; m < 2; ++m)
#pragma unroll
            for (int d = 0; d < 8; ++d) accO[m][d] = (f32x4){0.f, 0.f, 0.f, 0.f};
        float mrow[2] = {-INFINITY, -INFINITY};
        f32x4 accL[2] = {(f32x4){0.f, 0.f, 0.f, 0.f}, (f32x4){0.f, 0.f, 0.f, 0.f}};
        const bf16x8 ones8 = {0x3F80, 0x3F80, 0x3F80, 0x3F80, 0x3F80, 0x3F80, 0x3F80, 0x3F80};
        u32x4 rk0, rk1, rkr, rv0, rv1;
#define ATT_LOAD(kt) do { const size_t krow = (size_t)(b * 2048 + (kt) * 64 + kkey); const bf16_t* kp = KN + krow * 1024 + h * 128 + 16 * kseg; rk0 = *(const u32x4*)kp; rk1 = *(const u32x4*)(kp + 8); \
            rkr = *(const u32x4*)(proj + krow * LDP + C_KR + 8 * kseg); const bf16_t* vp = VT + ((size_t)bh * 128 + vdv) * 2048 + (kt) * 64 + 16 * vseg; rv0 = *(const u32x4*)vp; rv1 = *(const u32x4*)(vp + 8); } while (0)
#define ATT_STORE(buf) do { LAS bf16_t* Kb = (LAS bf16_t*)(lds + (buf) * 25600); LAS bf16_t* Vb = (LAS bf16_t*)(lds + 51200 + (buf) * 18432); \
            float f[16]; f[0] = bflo(rk0.x); f[1] = bfhi(rk0.x); f[2] = bflo(rk0.y); f[3] = bfhi(rk0.y); f[4] = bflo(rk0.z); f[5] = bfhi(rk0.z); f[6] = bflo(rk0.w); f[7] = bfhi(rk0.w); \
            f[8] = bflo(rk1.x); f[9] = bfhi(rk1.x); f[10] = bflo(rk1.y); f[11] = bfhi(rk1.y); f[12] = bflo(rk1.z); f[13] = bfhi(rk1.z); f[14] = bflo(rk1.w); f[15] = bfhi(rk1.w); \
            float ss = 0.f; _Pragma("unroll") for (int e = 0; e < 16; ++e) ss += f[e] * f[e]; \
            ss += __shfl_xor(ss, 1); ss += __shfl_xor(ss, 2); ss += __shfl_xor(ss, 4); const float rs = rsqrtf(ss * (1.f / 128.f) + EPS); \
            u32x4 o0, o1; o0.x = pk2(f[0] * rs, f[1] * rs); o0.y = pk2(f[2] * rs, f[3] * rs); o0.z = pk2(f[4] * rs, f[5] * rs); o0.w = pk2(f[6] * rs, f[7] * rs); \
            o1.x = pk2(f[8] * rs, f[9] * rs); o1.y = pk2(f[10] * rs, f[11] * rs); o1.z = pk2(f[12] * rs, f[13] * rs); o1.w = pk2(f[14] * rs, f[15] * rs); \
            *(LAS u32x4*)(Kb + kkey * 200 + 16 * kseg) = o0; *(LAS u32x4*)(Kb + kkey * 200 + 16 * kseg + 8) = o1; *(LAS u32x4*)(Kb + kkey * 200 + 128 + 8 * kseg) = rkr; \
            *(LAS u32x4*)(Vb + vdv * 72 + 16 * vseg) = rv0; *(LAS u32x4*)(Vb + vdv * 72 + 16 * vseg + 8) = rv1; } while (0)
        ATT_LOAD(0); ATT_STORE(0);
        __syncthreads();
        for (int kt = 0; kt < ntiles; ++kt) {
            const bool more = (kt + 1 < ntiles);
            if (more) ATT_LOAD(kt + 1);
            const bool active = (kt < 4 * qi) || ((kt - 4 * qi) <= (wave >> 1));
            if (active) {
                const LAS bf16_t* Kb = (const LAS bf16_t*)(lds + (kt & 1) * 25600); const LAS bf16_t* Vb = (const LAS bf16_t*)(lds + 51200 + (kt & 1) * 18432);
                f32x4 accS[2][4];
#pragma unroll
                for (int m = 0; m < 2; ++m)
#pragma unroll
                    for (int n = 0; n < 4; ++n) accS[m][n] = (f32x4){0.f, 0.f, 0.f, 0.f};
                {
                  const LAS bf16_t* kbase = Kb + fr * 200 + fq * 8; bf16x8 kring[4];
#pragma unroll
                  for (int s0 = 0; s0 < 3; ++s0) kring[s0] = *(const LAS bf16x8*)(kbase + (16 * (s0 & 3)) * 200 + 32 * (s0 >> 2));
#pragma unroll
                  for (int s0 = 0; s0 < 24; ++s0) {
                      if (s0 + 3 < 24) kring[(s0 + 3) & 3] = *(const LAS bf16x8*)(kbase + (16 * ((s0 + 3) & 3)) * 200 + 32 * ((s0 + 3) >> 2));
                      __builtin_amdgcn_sched_barrier(0);
                      const int ks = s0 >> 2, n = s0 & 3;
                      accS[0][n] = __builtin_amdgcn_mfma_f32_16x16x32_bf16(kring[s0 & 3], qf[0][ks], accS[0][n], 0, 0, 0); accS[1][n] = __builtin_amdgcn_mfma_f32_16x16x32_bf16(kring[s0 & 3], qf[1][ks], accS[1][n], 0, 0, 0);
                      __builtin_amdgcn_sched_barrier(0);
                  } }
                bf16x8 pf[2][2];
#pragma unroll
                for (int m = 0; m < 2; ++m) {
                    float mx = accS[m][0][0];
#pragma unroll
                    for (int n = 0; n < 4; ++n)
#pragma unroll
                        for (int j = 0; j < 4; ++j) mx = fmaxf(mx, accS[m][n][j]);
                    mx = fmaxf(mx, __shfl_xor(mx, 16)); mx = fmaxf(mx, __shfl_xor(mx, 32));
                    const float mnew = fmaxf(mrow[m], mx), alpha = __builtin_amdgcn_exp2f(mrow[m] - mnew); mrow[m] = mnew;
                    float p[4][4];
#pragma unroll
                    for (int n = 0; n < 4; ++n)
#pragma unroll
                        for (int j = 0; j < 4; ++j) p[n][j] = __builtin_amdgcn_exp2f(accS[m][n][j] - mnew);
                    if (__any(alpha != 1.f)) {
                        accL[m] = accL[m] * alpha;
#pragma unroll
                        for (int d = 0; d < 8; ++d) accO[m][d] = accO[m][d] * alpha; }
#pragma unroll
                    for (int t = 0; t < 2; ++t) { u32x4 w; w.x = pk2(p[2 * t][0], p[2 * t][1]); w.y = pk2(p[2 * t][2], p[2 * t][3]); w.z = pk2(p[2 * t + 1][0], p[2 * t + 1][1]); w.w = pk2(p[2 * t + 1][2], p[2 * t + 1][3]);
                        pf[m][t] = __builtin_bit_cast(bf16x8, w); }
                }
#pragma unroll
                for (int t = 0; t < 2; ++t) { accL[0] = __builtin_amdgcn_mfma_f32_16x16x32_bf16(ones8, pf[0][t], accL[0], 0, 0, 0); accL[1] = __builtin_amdgcn_mfma_f32_16x16x32_bf16(ones8, pf[1][t], accL[1], 0, 0, 0); }
                {
                  const LAS bf16_t* vbase = Vb + fr * 72 + fq * 4; u32x2 vlo[4], vhi[4];
#pragma unroll
                  for (int s0 = 0; s0 < 3; ++s0) { const LAS bf16_t* vp = vbase + (16 * (s0 & 7)) * 72 + 32 * (s0 >> 3); vlo[s0] = *(const LAS u32x2*)vp; vhi[s0] = *(const LAS u32x2*)(vp + 16); }
#pragma unroll
                  for (int s0 = 0; s0 < 16; ++s0) {
                      if (s0 + 3 < 16) { const LAS bf16_t* vp = vbase + (16 * ((s0 + 3) & 7)) * 72 + 32 * ((s0 + 3) >> 3); vlo[(s0 + 3) & 3] = *(const LAS u32x2*)vp; vhi[(s0 + 3) & 3] = *(const LAS u32x2*)(vp + 16); }
                      __builtin_amdgcn_sched_barrier(0);
                      const int t = s0 >> 3, d = s0 & 7; u32x4 w; w.x = vlo[s0 & 3].x; w.y = vlo[s0 & 3].y; w.z = vhi[s0 & 3].x; w.w = vhi[s0 & 3].y; const bf16x8 vf = __builtin_bit_cast(bf16x8, w);
                      accO[0][d] = __builtin_amdgcn_mfma_f32_16x16x32_bf16(vf, pf[0][t], accO[0][d], 0, 0, 0); accO[1][d] = __builtin_amdgcn_mfma_f32_16x16x32_bf16(vf, pf[1][t], accO[1][d], 0, 0, 0);
                      __builtin_amdgcn_sched_barrier(0);
                  } }
            }
            if (more) ATT_STORE((kt + 1) & 1);
            __syncthreads();
        }
#undef ATT_LOAD
#undef ATT_STORE
#pragma unroll
        for (int m = 0; m < 2; ++m) { const float il = 1.f / accL[m][0];
            bf16_t* op = proj + (size_t)(b * 2048 + q0 + 32 * wave + 16 * m + fr) * LDP + C_K + h * 128 + fq * 4;
#pragma unroll
            for (int d = 0; d < 8; ++d) { u32x2 w; w.x = pk2(accO[m][d][0] * il, accO[m][d][1] * il); w.y = pk2(accO[m][d][2] * il, accO[m][d][3] * il); *(u32x2*)(op + 16 * d) = w; } }
    }
}

__device__ __forceinline__ void oa_finalize(const Params& P, int gw, int NGW, int lane) {
    bf16_t* proj = (bf16_t*)(P.ws + WS_PROJ); const float* gain = (const float*)P.in[8];
    const int h = lane >> 3, seg = lane & 7;
    float g[16];
#pragma unroll
    for (int e = 0; e < 16; ++e) g[e] = gain[16 * seg + e];
    for (int m = gw; m < MROWS; m += NGW) { bf16_t* op = proj + (size_t)m * LDP + C_Q + h * 128 + 16 * seg; const bf16_t* zp = proj + (size_t)m * LDP + C_Z + h * 128 + 16 * seg;
        const u32x4 o0 = *(const u32x4*)op, o1 = *(const u32x4*)(op + 8), z0 = *(const u32x4*)zp, z1 = *(const u32x4*)(zp + 8);
        float a[8], b[8], za[8], zb[8]; unpack8(o0, a); unpack8(o1, b); unpack8(z0, za); unpack8(z1, zb);
        float ss = 0.f;
#pragma unroll
        for (int e = 0; e < 8; ++e) ss += a[e] * a[e] + b[e] * b[e];
        ss += __shfl_xor(ss, 1); ss += __shfl_xor(ss, 2); ss += __shfl_xor(ss, 4);
        const float rstd = rsqrtf(ss * (1.f / 128.f) + EPS);
#pragma unroll
        for (int e = 0; e < 8; ++e) { a[e] = a[e] * rstd * g[e] * silu_f(za[e]); b[e] = b[e] * rstd * g[8 + e] * silu_f(zb[e]); }
        *(u32x4*)op = pack8(a); *(u32x4*)(op + 8) = pack8(b); }
}


#define XB_TMO      128
#define XB_XCNT(j)  (256  + 64 * (j))
#define XB_XSUB(j)  (1280 + 64 * (j))
#define XB_XGEN(j)  (2304 + 64 * (j))
#define XB_TOP      3328
#define XB_TOPGEN   3392
#define XCD_BAR_WORDS 3456
#define XB_SPIN_CAP (1u << 18)
__device__ __forceinline__ unsigned xb_ld(unsigned* p)              { return __hip_atomic_load(p, __ATOMIC_RELAXED, __HIP_MEMORY_SCOPE_AGENT); }
__device__ __forceinline__ unsigned xb_add(unsigned* p, unsigned v) { return __hip_atomic_fetch_add(p, v, __ATOMIC_RELAXED, __HIP_MEMORY_SCOPE_AGENT); }
__device__ __forceinline__ unsigned xb_xcc_id() { return (unsigned)__builtin_amdgcn_s_getreg((3 << 11) | 20) & 0xFu; }
#define XB_SPIN(cond, bar) do { unsigned _sp = 0; while (cond) { __builtin_amdgcn_s_sleep(1); \
    if ((++_sp & 255u) == 0u) { if (xb_ld(&(bar)[XB_TMO])) break; if (_sp > XB_SPIN_CAP) { atomicAdd(&(bar)[XB_TMO], 1u); break; } } } } while (0)
struct XcdBarrier { unsigned* bar; unsigned x; volatile LAS unsigned* st; };
__device__ __forceinline__ XcdBarrier xcd_barrier_post(unsigned* bar, volatile LAS unsigned* st) {
    XcdBarrier b; b.bar = bar; b.x = xb_xcc_id(); b.st = st;
    if (threadIdx.x == 0) (void)xb_add(&bar[XB_XCNT(b.x)], 1u);
    return b;
}
__device__ __forceinline__ void xcd_barrier_complete(unsigned* bar, unsigned x, unsigned& nloc, unsigned& nx) {
    const unsigned G = gridDim.x * gridDim.y * gridDim.z;
    unsigned sum, cnt, mine, sp = 0u;
    for (;;) {
        sum = 0u; cnt = 0u; mine = 0u;
#pragma unroll
        for (unsigned j = 0; j < 16; ++j) { const unsigned c = xb_ld(&bar[XB_XCNT(j)]); sum += c; cnt += (c > 0u) ? 1u : 0u; mine = (j == x) ? c : mine; }
        if (sum == G) break;
        __builtin_amdgcn_s_sleep(1);
        if ((++sp & 255u) == 0u) { if (xb_ld(&bar[XB_TMO])) break; if (sp > XB_SPIN_CAP) { atomicAdd(&bar[XB_TMO], 1u); break; } }
    }
    nloc = mine > 0u ? mine : 1u; nx = cnt > 0u ? cnt : 1u;
}
__device__ __forceinline__ void xcd_barrier(const XcdBarrier& b) {
    asm volatile("s_waitcnt vmcnt(0)" ::: "memory");
    __syncthreads();
    if (threadIdx.x == 0) {
        unsigned* bar = b.bar;
        __builtin_amdgcn_s_waitcnt(0);
        unsigned nloc = b.st[0], nx = b.st[1];
        if (nloc == 0u) { xcd_barrier_complete(bar, b.x, nloc, nx); b.st[0] = nloc; b.st[1] = nx; }
        const unsigned old = xb_add(&bar[XB_XSUB(b.x)], 1u);
        const unsigned gen = old / nloc;
        if (old + 1u == (gen + 1u) * nloc) {
            __builtin_amdgcn_fence(__ATOMIC_RELEASE, "agent");
            asm volatile("s_waitcnt vmcnt(0)" ::: "memory");
            const unsigned og = xb_add(&bar[XB_TOP], 1u);
            const unsigned tg = og / nx;
            if (og + 1u == (tg + 1u) * nx) xb_add(&bar[XB_TOPGEN], 1u);
            else XB_SPIN(xb_ld(&bar[XB_TOPGEN]) == tg, bar);
            __builtin_amdgcn_fence(__ATOMIC_ACQUIRE, "agent");
            xb_add(&bar[XB_XGEN(b.x)], 1u);
            asm volatile("s_waitcnt vmcnt(0)" ::: "memory");
        } else {
            XB_SPIN(xb_ld(&bar[XB_XGEN(b.x)]) == gen, bar);
            __builtin_amdgcn_fence(__ATOMIC_ACQUIRE, "agent");
            asm volatile("s_waitcnt vmcnt(0)" ::: "memory");
        }
    }
    __syncthreads();
}

__global__ void __launch_bounds__(512) fwd_megakernel(Params P) {
    extern __shared__ __attribute__((aligned(16))) unsigned char lds_raw[];
    LAS unsigned char* lds = (LAS unsigned char*)lds_raw;
    cg::grid_group grid = cg::this_grid();
    const int G = gridDim.x, NGW = G * 8;
#define PHASE_IDS() int tid_ = threadIdx.x; asm volatile("" : "+v"(tid_)); const int lane = tid_ & 63, wave = __builtin_amdgcn_readfirstlane(tid_ >> 6), gw = blockIdx.x * 8 + wave
    unsigned char* ws = P.ws;
    bf16_t* ACT = (bf16_t*)(ws + WS_ACT); bf16_t* PROJ = (bf16_t*)(ws + WS_PROJ);
    pg8::StaticOrder S;
    unsigned long long pt_acc = 0, pt_last = 0;
    volatile LAS unsigned* MISC = (volatile LAS unsigned*)(lds + 139264);
    if (threadIdx.x < 16) MISC[threadIdx.x] = 0u;
    __syncthreads();
    const XcdBarrier xbar = xcd_barrier_post((unsigned*)(ws + WS_CTL), MISC + 8);
#define GRID_BAR() xcd_barrier(xbar)

    PT_B(0);
    { PHASE_IDS(); p0_prologue(P, lds, gw, NGW, wave, lane); }
    if (P.ws == nullptr) grid.sync();
    GRID_BAR();
    PT_E(0);
    PT_B(1);
    { pg8::Gemm g{ACT, (const bf16_t*)(ws + WS_WIN), MROWS, LDP, 2048, 2048}; S.init(MROWS, LDP, G, blockIdx.x);
      Epi<EP_BF16> E{PROJ, nullptr, LDP, nullptr, nullptr, nullptr, nullptr}; pg8::gemm_phase(lds, g, S, E); }
    {
      const int nwg = (MROWS / 256) * (LDP / 256), rem = nwg % G; const bool is_short = (rem == 0) || ((int)blockIdx.x >= rem);
      const int nshort = (rem == 0) ? G : G - rem, sidx = (rem == 0) ? (int)blockIdx.x : (int)blockIdx.x - rem;
      if (is_short) { PHASE_IDS(); (void)gw; transpose_range(P, (LAS float*)(lds + wave * 16384), TR_IN_ITEMS, TR_ALL_ITEMS, sidx * 8 + wave, nshort * 8, lane); } }
    GRID_BAR();
    PT_E(1);
    PT_B(2);
    { PHASE_IDS(); p2_prep(P, gw, NGW, lane); }
    GRID_BAR();
    PT_E(2);
    PT_B(3);
    { pg8::Gemm g{PROJ + C_CKV, (const bf16_t*)(ws + WS_WKV), MROWS, 2048, 512, LDP}; S.init(MROWS, 2048, G, blockIdx.x);
      Epi<EP_KV> E{ACT, nullptr, 1024, nullptr, nullptr, ACT + (size_t)MROWS * 1024, nullptr}; pg8::gemm_phase(lds, g, S, E); }
    __syncthreads();
    PT_E(3);
    PT_B(4);
    delta_prep(P, lds);
    GRID_BAR();
    PT_E(4);
    PT_B(5);
    delta_scan(P, lds);
    __syncthreads();
    PT_E(5);
    PT_B(6);
    mla_attention(P, lds);
    GRID_BAR();
    PT_E(6);
    PT_B(8);
    { pg8::Gemm g{PROJ + C_Q, (const bf16_t*)(ws + WS_WA), MROWS, 2048, 2048, LDP}; S.init(MROWS, 2048, G, blockIdx.x);
      Epi<EP_YAB> E{ACT, nullptr, DM, PROJ, nullptr, nullptr, nullptr}; pg8::gemm_phase(lds, g, S, E); }
    GRID_BAR();
    PT_E(8);
    PT_B(9);
    { pg8::Gemm g{ACT, (const bf16_t*)(ws + WS_WOUT), MROWS, 2048, 2048, 2048}; S.init(MROWS, 2048, G, blockIdx.x);
      Epi<EP_X1> E{(bf16_t*)(ws + WS_XB), nullptr, DM, nullptr, (const float*)P.in[0], nullptr, (float*)(ws + WS_SSQ1)}; pg8::gemm_phase(lds, g, S, E); }
    GRID_BAR();
    PT_E(9);
    PT_B(11);
    { pg8::Gemm g{(const bf16_t*)(ws + WS_XB), (const bf16_t*)(ws + WS_WUP), MROWS, DFF, 2048, 2048}; S.init(MROWS, DFF, G, blockIdx.x);
      Epi<EP_RELU2> E{PROJ, nullptr, DFF, nullptr, nullptr, nullptr, (float*)(ws + WS_SSQ1)}; pg8::gemm_phase(lds, g, S, E); }
    { pg8::Gemm g{(const bf16_t*)(ws + WS_PBF), (const bf16_t*)(ws + WS_WPLE), MROWS, 2048, 256, 256}; S.init(MROWS, 2048, G, blockIdx.x);
      Epi<EP_BF16> E{ACT, nullptr, DM, nullptr, nullptr, nullptr, nullptr}; pg8::gemm_phase(lds, g, S, E); }
    GRID_BAR();
    PT_E(11);
    PT_B(12);
    { pg8::Gemm g{PROJ, (const bf16_t*)(ws + WS_WDN), MROWS, 2048, DFF, DFF}; S.init(MROWS, 2048, G, blockIdx.x);
      Epi<EP_ACC> E{(bf16_t*)(ws + WS_XB), nullptr, DM, nullptr, nullptr, nullptr, (float*)(ws + WS_SSQ2)}; pg8::gemm_phase(lds, g, S, E); }
    GRID_BAR();
    PT_E(12);
    PT_B(14);
    { pg8::Gemm g{(const bf16_t*)(ws + WS_XB), (const bf16_t*)(ws + WS_WPG), MROWS, 2048, 2048, 2048}; S.init(MROWS, 2048, G, blockIdx.x);
      Epi<EP_PLE> E{nullptr, P.out, DM, ACT, nullptr, (bf16_t*)(ws + WS_XB), (float*)(ws + WS_SSQ2)}; pg8::gemm_phase(lds, g, S, E); }
    PT_E(14);
    if (PROBE_MASK != 0u && blockIdx.x == 0) { const unsigned long long t_end = __builtin_amdgcn_s_memrealtime() + (unsigned long long)PROBE_MULT * pt_acc;
        while (__builtin_amdgcn_s_memrealtime() < t_end) __builtin_amdgcn_s_sleep(8); }
}

extern "C" void kernel_launch(void* const* d_in, const int* in_sizes, int n_in, void* d_out, int out_size, void* d_ws, size_t ws_size, hipStream_t stream) {
    static int grid = 0;
    if (grid == 0) {
        if (n_in != 24 || out_size != MROWS * DM || ws_size < WS_END) { fprintf(stderr, "kernel_launch: unexpected shapes: n_in %d out %d ws %zu (need %zu)\n", n_in, out_size, ws_size, (size_t)WS_END); grid = -1; return; }
        int dev = 0, cus = 0, per_cu = 0;
        if (hipGetDevice(&dev) != hipSuccess || hipDeviceGetAttribute(&cus, hipDeviceAttributeMultiprocessorCount, dev) != hipSuccess) { grid = -1; return; }
        if (hipFuncSetAttribute((const void*)fwd_megakernel, hipFuncAttributeMaxDynamicSharedMemorySize, LDS_BYTES) != hipSuccess) { fprintf(stderr, "kernel_launch: hipFuncSetAttribute failed\n"); grid = -1; return; }
        if (hipOccupancyMaxActiveBlocksPerMultiprocessor(&per_cu, (const void*)fwd_megakernel, 512, LDS_BYTES) != hipSuccess || per_cu < 1) { fprintf(stderr, "kernel_launch: occupancy query gave %d\n", per_cu); per_cu = 1; }
        (void)hipGetLastError();
        grid = cus * per_cu;
        fprintf(stderr, "kernel_launch: grid %d (cus %d x %d), ws %zu\n", grid, cus, per_cu, ws_size);
    }
    if (grid < 0) return;
    Params p{};
    for (int i = 0; i < 24; ++i) p.in[i] = d_in[i];
    p.out = (float*)d_out; p.ws = (unsigned char*)d_ws;
    for (int i = 0; i < 32; ++i) p.ropeinv[i] = (float)pow(10000.0, -(double)i / 32.0);
    if (hipMemsetAsync((char*)d_ws + WS_CTL, 0, CTL_BYTES, stream) != hipSuccess) { fprintf(stderr, "kernel_launch: hipMemsetAsync failed\n"); return; }
    void* args[] = {&p};
    hipError_t e = hipLaunchCooperativeKernel((const void*)fwd_megakernel, dim3(grid), dim3(512), args, LDS_BYTES, stream);
    if (e != hipSuccess) fprintf(stderr, "kernel_launch: cooperative launch failed: %s (grid %d)\n", hipGetErrorString(e), grid);
}
```

```cpp
#include <hip/hip_runtime.h>
#include <hip/hip_cooperative_groups.h>
#include <cstdio>
#include <cstdint>
#include <cmath>
namespace cg = cooperative_groups;
#ifndef PROBE_MASK
#define PROBE_MASK 0u
#endif
#define PROBE_MULT 3
#define PT_B(bit) do { if ((PROBE_MASK >> (bit)) & 1u) { __builtin_amdgcn_s_waitcnt(0); pt_last = __builtin_amdgcn_s_memrealtime(); } } while (0)
#define PT_E(bit) do { if ((PROBE_MASK >> (bit)) & 1u) { __builtin_amdgcn_s_waitcnt(0); pt_acc += __builtin_amdgcn_s_memrealtime() - pt_last; } } while (0)

#define LAS __attribute__((address_space(3)))
typedef unsigned short bf16_t;
typedef short bf16x8 __attribute__((ext_vector_type(8)));
typedef float f32x4 __attribute__((ext_vector_type(4)));
typedef float f32x2 __attribute__((ext_vector_type(2)));
typedef unsigned u32x4 __attribute__((ext_vector_type(4)));
typedef unsigned u32x2 __attribute__((ext_vector_type(2)));

constexpr int NB = 16, SEQ = 2048, MROWS = NB * SEQ, DM = 2048, LDP = 10496, DFF = 8192, PLE = 256;
constexpr int C_Q = 0, C_K = 1024, C_V = 2048, C_Z = 3072, C_MQ = 4096, C_CKV = 5632, C_GA = 6144, C_GB = 8192, C_KR = 10240, C_BETA = 10304, C_ALPHA = 10312;
constexpr int D_IN = 10320;
constexpr float EPS = 1e-6f;
constexpr float LOG2E = 1.4426950408889634f;
constexpr size_t MiB = 1u << 20;
constexpr size_t WS_WIN = 0, WS_WKV = 41 * MiB, WS_WA = 43 * MiB, WS_WB = 47 * MiB, WS_WOUT = 51 * MiB, WS_WUP = 59 * MiB, WS_WDN = 91 * MiB, WS_WPG = 123 * MiB,
                 WS_WPLE = 131 * MiB, WS_PBF = 132 * MiB, WS_G = 148 * MiB, WS_BETA = 149 * MiB, WS_QKM = 150 * MiB, WS_ACT = 182 * MiB, WS_PROJ = 310 * MiB,
                 WS_GL = 966 * MiB, WS_CTL = 967 * MiB, WS_END = 968 * MiB;
constexpr size_t CTL_BYTES = 1 * MiB;
constexpr size_t WS_SSQ1 = WS_CTL + 256 * 1024, WS_SSQ2 = WS_CTL + 512 * 1024;
constexpr size_t WS_XB = WS_PROJ + 512 * MiB;
constexpr int LDS_BYTES = 147456;

__device__ __forceinline__ float bf2f(bf16_t v) { return __uint_as_float((unsigned)v << 16); }
__device__ __forceinline__ float bflo(unsigned w) { return __uint_as_float(w << 16); }
__device__ __forceinline__ float bfhi(unsigned w) { return __uint_as_float(w & 0xffff0000u); }
__device__ __forceinline__ unsigned pk2(float lo, float hi) { unsigned r; asm("v_cvt_pk_bf16_f32 %0, %1, %2" : "=v"(r) : "v"(lo), "v"(hi)); return r; }
__device__ __forceinline__ bf16_t f2bf(float f) { return (bf16_t)(pk2(f, 0.f) & 0xffffu); }
__device__ __forceinline__ float wave_sum(float v) {
#pragma unroll
    for (int o = 1; o < 64; o <<= 1) v += __shfl_xor(v, o);
    return v;
}
__device__ __forceinline__ float fast_sigmoid(float x) { return __builtin_amdgcn_rcpf(1.f + __builtin_amdgcn_exp2f(-x * LOG2E)); }
__device__ __forceinline__ float silu_f(float x) { return x * fast_sigmoid(x); }
#define LDS_WAIT() asm volatile("s_waitcnt lgkmcnt(0)" ::: "memory")

namespace pg8 {
constexpr int BM = 256, BK = 64, HALF = 128, HTB = HALF * BK * 2, STAGE_BYTES = 8 * HTB, NXCD = 8, WGM = 8;
__host__ __device__ __forceinline__ int lds_byte(int r, int c) { const int st = (r >> 4) * 2 + (c >> 5), rr = r & 15, cc = c & 31, ob = rr * 64 + cc * 2; return st * 1024 + (ob ^ (((ob >> 9) & 1) << 5)); }
__host__ __device__ __forceinline__ void stage_rc(int b, int& R, int& C) { const int st = b / 1024, sb = b % 1024, swz = sb ^ (((sb >> 9) & 1) << 5); R = (st >> 1) * 16 + swz / 64; C = (st & 1) * 32 + (swz % 64) / 2; }
__host__ __device__ __forceinline__ int perm32(int rho) { const int n = rho >> 4, i = rho & 15; return 8 * (i >> 2) + 4 * n + (i & 3); }
struct Unit { int pm, pn; };
struct Gemm { const bf16_t* A; const bf16_t* Bt; int M, N, K, lda; };
struct StaticOrder {
    int nM, nN, nwg, G, c;
    __device__ void init(int M, int N, int G_, int c_) { nM = M / BM; nN = N / BM; nwg = nM * nN; G = G_; c = c_; }
    __device__ bool next(int i, Unit& u) const {
        const long L = (long)i * G + c; if (L >= nwg) return false;
        int wgid = (int)L; { const int q = nwg / NXCD, r = nwg % NXCD, xcd = wgid % NXCD, off = wgid / NXCD; wgid = (xcd < r ? xcd * (q + 1) : r * (q + 1) + (xcd - r) * q) + off; }
        const int nig = WGM * nN, gid = wgid / nig, fm = gid * WGM, gsz = (nM - fm) < WGM ? (nM - fm) : WGM;
        u.pm = fm + ((wgid % nig) % gsz); u.pn = (wgid % nig) / gsz; return true;
    }
};
template <class Epi>
__device__ __forceinline__ void gemm_phase(LAS unsigned char* lds, const Gemm g, const StaticOrder& S, const Epi& E) {
    int tid = threadIdx.x; asm volatile("" : "+v"(tid));
    const int wid = __builtin_amdgcn_readfirstlane(tid >> 6), lane = tid & 63, wr = wid >> 2, wc = wid & 3, fr = lane & 15, fq = lane >> 4;
    const int K = g.K, nt = K / BK, lda = g.lda;
    unsigned voffA[2], voffB[2];
#pragma unroll
    for (int i = 0; i < 2; ++i) { int R, C; stage_rc(tid * 16 + i * 8192, R, C); const int Rb = ((R & ~31) + perm32(R & 31));
        voffA[i] = (unsigned)(R * lda + C) * 2u; voffB[i] = (unsigned)(Rb * K + C) * 2u; }
    const size_t kstep = (size_t)(BK * 2);
    const size_t hstepA = (size_t)HALF * lda * 2, tstepA = 2 * hstepA, hstepB = (size_t)HALF * K * 2, tstepB = 2 * hstepB;
    const unsigned ldsw = (unsigned)wid * 1024u;
    const int aoff = lds_byte(wr * 64 + fr, fq * 8), boff = lds_byte(wc * 32 + fr, fq * 8);
#define PG8_SA(b, h) (((b) * 2 + (h)) * HTB)
#define PG8_SB(b, h) ((4 + (b) * 2 + (h)) * HTB)
#define PG8_STAGE(bufoff, gbase, voff) do { _Pragma("unroll") for (int _i = 0; _i < 2; ++_i) \
        __builtin_amdgcn_global_load_lds((const unsigned*)((const char*)(gbase) + (voff)[_i]), (LAS unsigned*)(lds + (bufoff) + ldsw + _i * 8192), 16, 0, 0); } while (0)
#define PG8_LDA(dst, b, h) do { _Pragma("unroll") for (int m = 0; m < 4; ++m) _Pragma("unroll") for (int k = 0; k < 2; ++k) dst[m][k] = *(const LAS bf16x8*)(lds + PG8_SA(b, h) + aoff + m * 2048 + k * 1024); } while (0)
#define PG8_LDB(dst, b, h) do { _Pragma("unroll") for (int n = 0; n < 2; ++n) _Pragma("unroll") for (int k = 0; k < 2; ++k) dst[n][k] = *(const LAS bf16x8*)(lds + PG8_SB(b, h) + boff + n * 2048 + k * 1024); } while (0)
#define PG8_MMA(ai, bj, At, Bt) do { __builtin_amdgcn_s_setprio(1); _Pragma("unroll") for (int m = 0; m < 4; ++m) _Pragma("unroll") for (int n = 0; n < 2; ++n) _Pragma("unroll") for (int k = 0; k < 2; ++k) { \
        if constexpr (Epi::SWAP1 && (bj) == 1) acc[ai][bj][m][n] = __builtin_amdgcn_mfma_f32_16x16x32_bf16(At[m][k], Bt[n][k], acc[ai][bj][m][n], 0, 0, 0); \
        else acc[ai][bj][m][n] = __builtin_amdgcn_mfma_f32_16x16x32_bf16(Bt[n][k], At[m][k], acc[ai][bj][m][n], 0, 0, 0); } __builtin_amdgcn_s_setprio(0); } while (0)
#define PG8_WAIT_V(n) asm volatile("s_waitcnt vmcnt(" #n ")" ::: "memory")
#define PG8_WAIT_L(n) asm volatile("s_waitcnt lgkmcnt(" #n ")" ::: "memory")
#define PG8_BAR __builtin_amdgcn_s_barrier()
#define PG8_SCHED __builtin_amdgcn_sched_barrier(0)
    Unit cur, nxt; int ui = 0;
    if (!S.next(0, cur)) return;
    f32x4 acc[2][2][4][2];
#pragma unroll
    for (int a = 0; a < 2; ++a)
#pragma unroll
        for (int b = 0; b < 2; ++b)
#pragma unroll
            for (int m = 0; m < 4; ++m)
#pragma unroll
                for (int n = 0; n < 2; ++n) acc[a][b][m][n] = (f32x4){0.f, 0.f, 0.f, 0.f};
    bf16x8 At[4][2], B0[2][2], B1[2][2];
    const char* cA = (const char*)g.A + (size_t)cur.pm * tstepA; const char* cB = (const char*)g.Bt + (size_t)cur.pn * tstepB;
    PG8_STAGE(PG8_SB(0, 0), cB, voffB); PG8_STAGE(PG8_SB(0, 1), cB + hstepB, voffB); PG8_STAGE(PG8_SA(0, 0), cA, voffA); PG8_STAGE(PG8_SA(0, 1), cA + hstepA, voffA);
    if (wr == 1) PG8_BAR;
    PG8_WAIT_V(2); PG8_BAR;
    PG8_STAGE(PG8_SB(1, 0), cB + kstep, voffB); PG8_STAGE(PG8_SA(1, 0), cA + kstep, voffA); PG8_STAGE(PG8_SB(1, 1), cB + hstepB + kstep, voffB);
    PG8_WAIT_V(6); PG8_BAR;
    for (;;) {
        const bool has_next = S.next(ui + 1, nxt);
        const char* nA = has_next ? (const char*)g.A + (size_t)nxt.pm * tstepA : cA; const char* nB = has_next ? (const char*)g.Bt + (size_t)nxt.pn * tstepB : cB;
        for (int t = 0; t < nt; t += 2) {
            if constexpr (Epi::MID_T > 0) { if (t == Epi::MID_T) E.mid(acc, cur, wr, wc, fr, fq); }
            const bool last = (t == nt - 2);
            const char* a1 = cA + (size_t)(t + 1) * kstep;
            const char* a2 = last ? nA : cA + (size_t)(t + 2) * kstep; const char* b2 = last ? nB : cB + (size_t)(t + 2) * kstep;
            const char* a3 = a2 + kstep; const char* b3 = b2 + kstep;
            PG8_LDB(B0, 0, 0); PG8_LDB(B1, 0, 1); PG8_SCHED; PG8_LDA(At, 0, 0); PG8_STAGE(PG8_SA(1, 1), a1 + hstepA, voffA);
            PG8_WAIT_V(8); PG8_WAIT_L(0); PG8_BAR; PG8_MMA(0, 0, At, B0); PG8_MMA(0, 1, At, B1); PG8_BAR; PG8_SCHED;
            PG8_LDA(At, 0, 1); PG8_STAGE(PG8_SB(0, 0), b2, voffB); PG8_STAGE(PG8_SB(0, 1), b2 + hstepB, voffB); PG8_STAGE(PG8_SA(0, 0), a2, voffA);
            PG8_WAIT_V(8); PG8_WAIT_L(0); PG8_BAR; PG8_MMA(1, 0, At, B0); PG8_MMA(1, 1, At, B1); PG8_BAR; PG8_SCHED;
            PG8_LDB(B0, 1, 0); PG8_LDB(B1, 1, 1); PG8_SCHED; PG8_LDA(At, 1, 0); PG8_STAGE(PG8_SA(0, 1), a2 + hstepA, voffA);
            PG8_WAIT_V(8); PG8_WAIT_L(0); PG8_BAR; PG8_MMA(0, 0, At, B0); PG8_MMA(0, 1, At, B1); PG8_BAR; PG8_SCHED;
            PG8_LDA(At, 1, 1); PG8_STAGE(PG8_SB(1, 0), b3, voffB); PG8_STAGE(PG8_SB(1, 1), b3 + hstepB, voffB); PG8_STAGE(PG8_SA(1, 0), a3, voffA);
            PG8_WAIT_V(8); PG8_WAIT_L(0); PG8_BAR; PG8_MMA(1, 0, At, B0); PG8_MMA(1, 1, At, B1); PG8_BAR; PG8_SCHED;
        }
        if (wr == 0) PG8_BAR;
        E(acc, cur, wr, wc, fr, fq);
        if (!has_next) break;
#pragma unroll
        for (int a = 0; a < 2; ++a)
#pragma unroll
            for (int b = 0; b < 2; ++b)
#pragma unroll
                for (int m = 0; m < 4; ++m)
#pragma unroll
                    for (int n = 0; n < 2; ++n) acc[a][b][m][n] = (f32x4){0.f, 0.f, 0.f, 0.f};
        cur = nxt; cA = nA; cB = nB; ++ui;
        if (wr == 1) PG8_BAR;
    }
    PG8_WAIT_V(0);
    PG8_BAR;
#undef PG8_SA
#undef PG8_SB
#undef PG8_STAGE
#undef PG8_LDA
#undef PG8_LDB
#undef PG8_MMA
#undef PG8_WAIT_V
#undef PG8_WAIT_L
#undef PG8_BAR
#undef PG8_SCHED
}
}

enum { EP_BF16 = 0, EP_KV, EP_YA, EP_YB, EP_X1, EP_RELU2, EP_ACC, EP_F32, EP_PLE, EP_YAB };
__device__ __forceinline__ void store8bf(bf16_t* p, f32x4 a, f32x4 b) { u32x4 w; w.x = pk2(a[0], a[1]); w.y = pk2(a[2], a[3]); w.z = pk2(b[0], b[1]); w.w = pk2(b[2], b[3]); *(u32x4*)p = w; }
__device__ __forceinline__ void load8bf(const bf16_t* p, f32x4& a, f32x4& b) { const u32x4 w = *(const u32x4*)p; a = (f32x4){bflo(w.x), bfhi(w.x), bflo(w.y), bfhi(w.y)}; b = (f32x4){bflo(w.z), bfhi(w.z), bflo(w.w), bfhi(w.w)}; }
__device__ __forceinline__ f32x4 sig4(f32x4 v) { return (f32x4){fast_sigmoid(v[0]), fast_sigmoid(v[1]), fast_sigmoid(v[2]), fast_sigmoid(v[3])}; }
template <int MODE> struct Epi {
    static constexpr bool SWAP1 = (MODE == EP_KV);
    static constexpr int MID_T = (MODE == EP_YAB) ? 16 : 0;
    bf16_t* ob; float* of; int ldc; const bf16_t* gate; const float* res; bf16_t* vt; float* ssq;
    __device__ __forceinline__ void mid(f32x4 (&acc)[2][2][4][2], const pg8::Unit& u, int wr, int wc, int fr, int fq) const {
        int rowb = u.pm * 256 + wr * 64 + fr, col0 = u.pn * 256 + wc * 32 + 8 * fq;
        asm volatile("" : "+v"(rowb), "+v"(col0));
        u32x4 ga[2], gb[2];
        ga[0] = *(const u32x4*)(gate + (size_t)rowb * LDP + C_GA + col0); gb[0] = *(const u32x4*)(gate + (size_t)rowb * LDP + C_GB + col0);
#pragma unroll
        for (int st = 0; st < 16; ++st) {
            const int it = st >> 1, bj = st & 1, ai = it >> 2, m = it & 3;
            if (st + 1 < 16) { const int itn = (st + 1) >> 1, bjn = (st + 1) & 1; const size_t off = (size_t)(rowb + (itn >> 2) * 128 + (itn & 3) * 16) * LDP + col0 + bjn * 128;
                ga[(st + 1) & 1] = *(const u32x4*)(gate + off + C_GA); gb[(st + 1) & 1] = *(const u32x4*)(gate + off + C_GB); }
            f32x4 a0, a1, b0, b1; up8(ga[st & 1], a0, a1); up8(gb[st & 1], b0, b1);
#pragma unroll
            for (int e = 0; e < 4; ++e) {
                acc[ai][bj][m][0][e] *= (1.f + __builtin_amdgcn_exp2f(-b0[e] * LOG2E)) * __builtin_amdgcn_rcpf(1.f + __builtin_amdgcn_exp2f(-a0[e] * LOG2E));
                acc[ai][bj][m][1][e] *= (1.f + __builtin_amdgcn_exp2f(-b1[e] * LOG2E)) * __builtin_amdgcn_rcpf(1.f + __builtin_amdgcn_exp2f(-a1[e] * LOG2E)); }
            asm volatile("" ::: "memory");
        }
    }
    struct Pre { f32x4 f[2][2]; u32x4 g[2]; u32x4 y[2]; };
    __device__ __forceinline__ void preload(Pre& p, int row, int col0) const {
#pragma unroll
        for (int bj = 0; bj < 2; ++bj) { const int col = col0 + bj * 128;
            if constexpr (MODE == EP_YA) p.g[bj] = *(const u32x4*)(gate + (size_t)row * LDP + C_GA + col);
            else if constexpr (MODE == EP_YAB) p.g[bj] = *(const u32x4*)(gate + (size_t)row * LDP + C_GB + col);
            else if constexpr (MODE == EP_YB) { p.g[bj] = *(const u32x4*)(gate + (size_t)row * LDP + C_GB + col); p.y[bj] = *(const u32x4*)(ob + (size_t)row * DM + col); }
            else if constexpr (MODE == EP_X1) { const float* r = res + (size_t)row * DM + col; p.f[bj][0] = *(const f32x4*)r; p.f[bj][1] = *(const f32x4*)(r + 4); }
            else if constexpr (MODE == EP_ACC) p.y[bj] = *(const u32x4*)(ob + (size_t)row * DM + col);
            else if constexpr (MODE == EP_PLE) { p.y[bj] = *(const u32x4*)(vt + (size_t)row * DM + col); p.g[bj] = *(const u32x4*)(gate + (size_t)row * DM + col); }
        }
    }
    static __device__ __forceinline__ void up8(const u32x4 w, f32x4& a, f32x4& b) { a = (f32x4){bflo(w.x), bfhi(w.x), bflo(w.y), bfhi(w.y)}; b = (f32x4){bflo(w.z), bfhi(w.z), bflo(w.w), bfhi(w.w)}; }
    __device__ __forceinline__ void operator()(const f32x4 (&acc)[2][2][4][2], const pg8::Unit& u, int wr, int wc, int fr, int fq) const {
        const int rowb = u.pm * 256 + wr * 64 + fr, col0 = u.pn * 256 + wc * 32 + 8 * fq;
        float rs[8];
        if constexpr (MODE == EP_RELU2 || MODE == EP_PLE) {
#pragma unroll
            for (int it = 0; it < 8; ++it) rs[it] = ssq[rowb + (it >> 2) * 128 + (it & 3) * 16];
#pragma unroll
            for (int it = 0; it < 8; ++it) rs[it] = rsqrtf(rs[it] * (1.f / 2048.f) + EPS);
        }
        Pre pre[2];
        preload(pre[0], rowb, col0);
#pragma unroll
        for (int it = 0; it < 8; ++it) {
            const int ai = it >> 2, m = it & 3, row = rowb + ai * 128 + m * 16;
            if (it + 1 < 8) preload(pre[(it + 1) & 1], rowb + ((it + 1) >> 2) * 128 + ((it + 1) & 3) * 16, col0);
            const Pre& pp = pre[it & 1];
            float rsum = 0.f; const float rstd = (MODE == EP_RELU2 || MODE == EP_PLE) ? rs[it] : 1.f;
#pragma unroll
            for (int bj = 0; bj < 2; ++bj) {
                const int col = col0 + bj * 128;
                f32x4 v0 = acc[ai][bj][m][0], v1 = acc[ai][bj][m][1];
                if constexpr (MODE == EP_BF16) { store8bf(ob + (size_t)row * ldc + col, v0, v1); }
                else if constexpr (MODE == EP_RELU2) {
#pragma unroll
                    for (int e = 0; e < 4; ++e) { const float a = fmaxf(v0[e] * rstd, 0.f), b = fmaxf(v1[e] * rstd, 0.f); v0[e] = a * a; v1[e] = b * b; }
                    store8bf(ob + (size_t)row * ldc + col, v0, v1); }
                else if constexpr (MODE == EP_KV) {
                    if (bj == 0) store8bf(ob + (size_t)row * 1024 + u.pn * 128 + wc * 32 + 8 * fq, v0, v1);
                    else {
                        const int r0 = u.pm * 256 + ai * 128 + wr * 64 + m * 16 + 4 * fq, b = r0 >> 11, s = r0 & 2047;
                        bf16_t* base = vt + ((size_t)((b * 8 + u.pn) * 128 + wc * 32)) * 2048 + s;
                        u32x2 w0, w1; w0.x = pk2(v0[0], v0[1]); w0.y = pk2(v0[2], v0[3]); w1.x = pk2(v1[0], v1[1]); w1.y = pk2(v1[2], v1[3]);
                        *(u32x2*)(base + (size_t)pg8::perm32(fr) * 2048) = w0; *(u32x2*)(base + (size_t)pg8::perm32(16 + fr) * 2048) = w1; } }
                else if constexpr (MODE == EP_YA || MODE == EP_YAB) { f32x4 g0, g1; up8(pp.g[bj], g0, g1); store8bf(ob + (size_t)row * DM + col, sig4(g0) * v0, sig4(g1) * v1); }
                else if constexpr (MODE == EP_YB) { f32x4 g0, g1, a0, a1; up8(pp.g[bj], g0, g1); up8(pp.y[bj], a0, a1); store8bf(ob + (size_t)row * DM + col, a0 + sig4(g0) * v0, a1 + sig4(g1) * v1); }
                else if constexpr (MODE == EP_X1 || MODE == EP_ACC) { f32x4 r0, r1;
                    if constexpr (MODE == EP_X1) { r0 = pp.f[bj][0]; r1 = pp.f[bj][1]; } else up8(pp.y[bj], r0, r1);
                    const f32x4 x0 = r0 + v0, x1 = r1 + v1;
                    store8bf(ob + (size_t)row * DM + col, x0, x1);
                    rsum += (x0[0] * x0[0] + x0[1] * x0[1]) + (x0[2] * x0[2] + x0[3] * x0[3]) + (x1[0] * x1[0] + x1[1] * x1[1]) + (x1[2] * x1[2] + x1[3] * x1[3]); }
                else if constexpr (MODE == EP_F32) { float* o = of + (size_t)row * DM + col; *(f32x4*)o = v0; *(f32x4*)(o + 4) = v1; }
                else if constexpr (MODE == EP_PLE) { f32x4 p0, p1, x0, x1; up8(pp.g[bj], p0, p1); up8(pp.y[bj], x0, x1); float* o = of + (size_t)row * DM + col;
                    *(f32x4*)o = x0 + sig4(v0 * rstd) * p0; *(f32x4*)(o + 4) = x1 + sig4(v1 * rstd) * p1; }
            }
            if constexpr (MODE == EP_X1 || MODE == EP_ACC) { rsum += __shfl_xor(rsum, 16); rsum += __shfl_xor(rsum, 32);
                if (fq == 0) __hip_atomic_fetch_add(ssq + row, rsum, __ATOMIC_RELAXED, __HIP_MEMORY_SCOPE_AGENT); }
            asm volatile("" ::: "memory");
        }
    }
};

struct Params { const void* in[24]; float* out; unsigned char* ws; float ropeinv[32]; };

__device__ __forceinline__ int win_map(int n) {
    if (n < 4096) return n;
    if (n < 5632) return 4112 + (n - 4096);
    if (n < 6144) return 5648 + (n - 5632);
    if (n < 8192) return 6224 + (n - 6144);
    if (n < 10240) return 8272 + (n - 8192);
    if (n < 10304) return 6160 + (n - 10240);
    if (n < 10312) return 4096 + (n - 10304);
    if (n < 10320) return 4104 + (n - 10312);
    return -1;
}
struct TrJob { int widx, K, N, nblk, item; };
__device__ __forceinline__ const float* opq(const void* p) { unsigned long long v = (unsigned long long)p; asm volatile("" : "+s"(v)); return (const float*)v; }
__device__ __forceinline__ const float* tr_src(const Params& P, int w) {
    const float* a0 = opq(P.in[4]); const float* a1 = opq(P.in[10]); const float* a2 = opq(P.in[15]); const float* a3 = opq(P.in[16]); const float* a4 = opq(P.in[17]);
    const float* a5 = opq(P.in[19]); const float* a6 = opq(P.in[20]); const float* a7 = opq(P.in[22]); const float* a8 = opq(P.in[23]);
    return w == 0 ? a0 : w == 1 ? a1 : w == 2 ? a2 : w == 3 ? a3 : w == 4 ? a4 : w == 5 ? a5 : w == 6 ? a6 : w == 7 ? a7 : a8; }
__device__ __forceinline__ size_t tr_dst_off(int w) { return w == 0 ? WS_WIN : w == 1 ? WS_WKV : w == 2 ? WS_WA : w == 3 ? (WS_WA + 2048) : w == 4 ? WS_WOUT : w == 5 ? WS_WUP : w == 6 ? WS_WDN : w == 7 ? WS_WPG : WS_WPLE; }
__device__ __forceinline__ void tr_load(const Params& P, const TrJob& J, int lane, f32x4 (&v)[8]) {
    const int kb = J.item / J.nblk, nb = J.item % J.nblk, k0 = 64 * kb, n0 = 32 * nb, q4 = lane & 7, kr = lane >> 3;
    int oc = n0 + 4 * q4; if (J.widx == 0) oc = win_map(oc);
    const float* W = tr_src(P, J.widx);
#pragma unroll
    for (int i = 0; i < 8; ++i) v[i] = (oc >= 0) ? *(const f32x4*)(W + (size_t)(k0 + 8 * i + kr) * J.N + oc) : (f32x4){0.f, 0.f, 0.f, 0.f};
}
__device__ __forceinline__ void tr_finish(const Params& P, const TrJob& J, int lane, const f32x4 (&v)[8], LAS float* scr) {
    const int kb = J.item / J.nblk, nb = J.item % J.nblk, k0 = 64 * kb, n0 = 32 * nb, q4 = lane & 7, kr = lane >> 3;
    const float* kg5 = opq(P.in[18]); const float* kg7 = opq(P.in[21]); const float* kgain = (J.widx == 5) ? kg5 : (J.widx == 7) ? kg7 : nullptr;
    bf16_t* WT = (bf16_t*)(P.ws + tr_dst_off(J.widx));
    const int ldk = (J.widx == 2 || J.widx == 3) ? 2048 : J.K;
#pragma unroll
    for (int i = 0; i < 8; ++i) { LAS float* d = scr + (8 * i + kr) * 33 + 4 * q4; const float kg = kgain ? kgain[k0 + 8 * i + kr] : 1.f; d[0] = v[i][0] * kg; d[1] = v[i][1] * kg; d[2] = v[i][2] * kg; d[3] = v[i][3] * kg; }
    LDS_WAIT();
    const int c = lane & 7;
#pragma unroll
    for (int j = 0; j < 4; ++j) { const int n = (lane >> 3) + 8 * j; const LAS float* sp = scr + (8 * c) * 33 + n;
        u32x4 o; o.x = pk2(sp[0 * 33], sp[1 * 33]); o.y = pk2(sp[2 * 33], sp[3 * 33]); o.z = pk2(sp[4 * 33], sp[5 * 33]); o.w = pk2(sp[6 * 33], sp[7 * 33]);
        *(u32x4*)(WT + (size_t)(n0 + n) * ldk + k0 + 8 * c) = o; }
    LDS_WAIT();
}
__device__ __forceinline__ void rmsnorm_row(const float* xrow, const float* gain, bf16_t* orow, int lane) {
    const f32x4* xr = (const f32x4*)xrow + lane; const f32x4* gr = (const f32x4*)gain + lane;
    f32x4 v[8]; float s = 0.f;
#pragma unroll
    for (int j = 0; j < 8; ++j) { v[j] = xr[64 * j]; s += (v[j][0] * v[j][0] + v[j][1] * v[j][1]) + (v[j][2] * v[j][2] + v[j][3] * v[j][3]); }
    const float rstd = rsqrtf(wave_sum(s) * (1.f / 2048.f) + EPS);
    u32x2* o8 = (u32x2*)orow + lane;
#pragma unroll
    for (int j = 0; j < 8; ++j) { const f32x4 g = gr[64 * j]; u32x2 w; w.x = pk2(v[j][0] * rstd * g[0], v[j][1] * rstd * g[1]); w.y = pk2(v[j][2] * rstd * g[2], v[j][3] * rstd * g[3]); o8[64 * j] = w; }
}
__device__ __forceinline__ void rmsnorm_rows_phase(const float* X, const float* gain, bf16_t* O, int gw, int NGW, int lane) {
    for (int m = gw; m < MROWS / 2; m += NGW) {
        const f32x4* x0 = (const f32x4*)(X + (size_t)m * DM) + lane; const f32x4* x1 = (const f32x4*)(X + (size_t)(m + MROWS / 2) * DM) + lane; const f32x4* gr = (const f32x4*)gain + lane;
        f32x4 a[8], b[8]; float sa = 0.f, sb = 0.f;
#pragma unroll
        for (int j = 0; j < 8; ++j) { a[j] = x0[64 * j]; b[j] = x1[64 * j]; }
#pragma unroll
        for (int j = 0; j < 8; ++j) { sa += (a[j][0] * a[j][0] + a[j][1] * a[j][1]) + (a[j][2] * a[j][2] + a[j][3] * a[j][3]); sb += (b[j][0] * b[j][0] + b[j][1] * b[j][1]) + (b[j][2] * b[j][2] + b[j][3] * b[j][3]); }
        const float ra = rsqrtf(wave_sum(sa) * (1.f / 2048.f) + EPS), rb = rsqrtf(wave_sum(sb) * (1.f / 2048.f) + EPS);
        u32x2* oa = (u32x2*)(O + (size_t)m * DM) + lane; u32x2* ob = (u32x2*)(O + (size_t)(m + MROWS / 2) * DM) + lane;
#pragma unroll
        for (int j = 0; j < 8; ++j) { const f32x4 g = gr[64 * j]; u32x2 w; w.x = pk2(a[j][0] * ra * g[0], a[j][1] * ra * g[1]); w.y = pk2(a[j][2] * ra * g[2], a[j][3] * ra * g[3]); oa[64 * j] = w;
            w.x = pk2(b[j][0] * rb * g[0], b[j][1] * rb * g[1]); w.y = pk2(b[j][2] * rb * g[2], b[j][3] * rb * g[3]); ob[64 * j] = w; }
    }
}

__device__ __forceinline__ TrJob tr_job(int it) {
    constexpr int I_IN = 32 * (LDP / 32), I_KV = 8 * 64, I_A = 16 * 64, I_B = 16 * 64, I_OUT = 32 * 64, I_UP = 32 * 256, I_DN = 128 * 64, I_PG = 32 * 64;
    int r = it;
    if (r < I_IN) return TrJob{0, 2048, D_IN, LDP / 32, r}; r -= I_IN;
    if (r < I_KV) return TrJob{1, 512, 2048, 64, r}; r -= I_KV;
    if (r < I_A) return TrJob{2, 1024, 2048, 64, r}; r -= I_A;
    if (r < I_B) return TrJob{3, 1024, 2048, 64, r}; r -= I_B;
    if (r < I_OUT) return TrJob{4, 2048, 2048, 64, r}; r -= I_OUT;
    if (r < I_UP) return TrJob{5, 2048, 8192, 256, r}; r -= I_UP;
    if (r < I_DN) return TrJob{6, 8192, 2048, 64, r}; r -= I_DN;
    if (r < I_PG) return TrJob{7, 2048, 2048, 64, r}; r -= I_PG;
    return TrJob{8, 256, 2048, 64, r};
}
constexpr int TR_IN_ITEMS = 32 * (LDP / 32);
constexpr int TR_ALL_ITEMS = 32 * (LDP / 32) + 8 * 64 + 16 * 64 + 16 * 64 + 32 * 64 + 32 * 256 + 128 * 64 + 32 * 64 + 4 * 64;
__device__ __forceinline__ void transpose_range(const Params& P, LAS float* scr, int lo, int hi, int gw, int NGW, int lane) {
    for (int it = lo + gw; it < hi; it += 2 * NGW) {
        const TrJob J0 = tr_job(it); f32x4 v0[8], v1[8]; tr_load(P, J0, lane, v0);
        const bool two = (it + NGW < hi);
        const TrJob J1 = tr_job(two ? it + NGW : it);
        if (two) tr_load(P, J1, lane, v1);
        tr_finish(P, J0, lane, v0, scr);
        if (two) tr_finish(P, J1, lane, v1, scr);
    }
}
__device__ __forceinline__ void p0_prologue(const Params& P, LAS unsigned char* lds, int gw, int NGW, int wave, int lane) {
    unsigned char* ws = P.ws;
    LAS float* scr = (LAS float*)(lds + wave * 16384);
    transpose_range(P, scr, 0, TR_IN_ITEMS, gw, NGW, lane);
    rmsnorm_rows_phase((const float*)P.in[0], (const float*)P.in[3], (bf16_t*)(ws + WS_ACT), gw, NGW, lane);
    { const f32x4* src = (const f32x4*)P.in[1]; u32x4* dst = (u32x4*)(ws + WS_PBF); const size_t n8 = (size_t)MROWS * PLE / 8;
      for (size_t i = (size_t)gw * 64 + lane; i < n8; i += (size_t)NGW * 64) { const f32x4 a = src[2 * i], b = src[2 * i + 1]; u32x4 w; w.x = pk2(a[0], a[1]); w.y = pk2(a[2], a[3]); w.z = pk2(b[0], b[1]); w.w = pk2(b[2], b[3]); dst[i] = w; } }
}

__device__ __forceinline__ void rope_cs(float pos, float inv, float& c, float& s) {
    const float a = pos * inv;
    double rev = (double)a * 0.15915494309189535; rev -= rint(rev);
    const float r = (float)rev; s = __builtin_amdgcn_sinf(r); c = __builtin_amdgcn_cosf(r);
}
__device__ __forceinline__ void unpack8(const u32x4 w, float (&f)[8]) { f[0] = bflo(w.x); f[1] = bfhi(w.x); f[2] = bflo(w.y); f[3] = bfhi(w.y); f[4] = bflo(w.z); f[5] = bfhi(w.z); f[6] = bflo(w.w); f[7] = bfhi(w.w); }
__device__ __forceinline__ u32x4 pack8(const float (&f)[8]) { u32x4 w; w.x = pk2(f[0], f[1]); w.y = pk2(f[2], f[3]); w.z = pk2(f[4], f[5]); w.w = pk2(f[6], f[7]); return w; }
__device__ __forceinline__ void p2_prep(const Params& P, int gw, int NGW, int lane) {
    unsigned char* ws = P.ws;
    bf16_t* proj = (bf16_t*)(ws + WS_PROJ);
    const int* positions = (const int*)P.in[2];
    const float* ckvn = (const float*)P.in[9]; const float* qng = (const float*)P.in[11]; const float* qrg = (const float*)P.in[12]; const float* kng = (const float*)P.in[13]; const float* krg = (const float*)P.in[14];
    const float* dt_bias = (const float*)P.in[6]; const float* a_log = (const float*)P.in[7];
    float* G = (float*)(ws + WS_G); float* BETA = (float*)(ws + WS_BETA);
    const float QSCALE = 0.07216878364870322f * LOG2E;
    {
        const int h = lane >> 3, seg = lane & 7;
        float gn[16], gr[8], inv8[8], gc8[8];
#pragma unroll
        for (int e = 0; e < 16; ++e) gn[e] = qng[16 * seg + e] * kng[16 * seg + e] * QSCALE;
#pragma unroll
        for (int e = 0; e < 8; ++e) { gr[e] = qrg[8 * seg + e]; inv8[e] = P.ropeinv[8 * (seg & 3) + e]; gc8[e] = ckvn[8 * lane + e]; }
        const float inv1 = P.ropeinv[lane & 31], kr_g = krg[lane];
        for (int m = gw; m < MROWS; m += NGW) {
            bf16_t* row = proj + (size_t)m * LDP;
            bf16_t* np = row + C_MQ + h * 192 + 16 * seg; bf16_t* rp = row + C_MQ + h * 192 + 128 + 8 * seg; bf16_t* cp = row + C_CKV + 8 * lane;
            const u32x4 wn0 = *(const u32x4*)np, wn1 = *(const u32x4*)(np + 8), wr = *(const u32x4*)rp, wc = *(const u32x4*)cp;
            const bf16_t wk = row[C_KR + lane]; const bf16_t wba = (lane < 16) ? row[C_BETA + lane] : (bf16_t)0;
            const float pos = (float)positions[m];
            float a[8], b[8]; unpack8(wn0, a); unpack8(wn1, b);
            float ss = 0.f;
#pragma unroll
            for (int e = 0; e < 8; ++e) ss += a[e] * a[e] + b[e] * b[e];
            ss += __shfl_xor(ss, 1); ss += __shfl_xor(ss, 2); ss += __shfl_xor(ss, 4);
            const float rstd = rsqrtf(ss * (1.f / 128.f) + EPS);
#pragma unroll
            for (int e = 0; e < 8; ++e) { a[e] = a[e] * rstd * gn[e]; b[e] = b[e] * rstd * gn[8 + e]; }
            *(u32x4*)np = pack8(a); *(u32x4*)(np + 8) = pack8(b);
            float x[8]; unpack8(wr, x);
            float s2 = 0.f;
#pragma unroll
            for (int e = 0; e < 8; ++e) s2 += x[e] * x[e];
            s2 += __shfl_xor(s2, 1); s2 += __shfl_xor(s2, 2); s2 += __shfl_xor(s2, 4);
            const float rs2 = rsqrtf(s2 * (1.f / 64.f) + EPS);
#pragma unroll
            for (int e = 0; e < 8; ++e) { const float xn = x[e] * rs2 * gr[e]; const float px = __shfl_xor(xn, 4); float cs, sn; rope_cs(pos, inv8[e], cs, sn);
                x[e] = ((seg < 4) ? (xn * cs - px * sn) : (xn * cs + px * sn)) * QSCALE; }
            *(u32x4*)rp = pack8(x);
            float cv[8]; unpack8(wc, cv);
            float s3 = 0.f;
#pragma unroll
            for (int e = 0; e < 8; ++e) s3 += cv[e] * cv[e];
            const float rs3 = rsqrtf(wave_sum(s3) * (1.f / 512.f) + EPS);
#pragma unroll
            for (int e = 0; e < 8; ++e) cv[e] = cv[e] * rs3 * gc8[e];
            *(u32x4*)cp = pack8(cv);
            { float xk = bf2f(wk); const float rs4 = rsqrtf(wave_sum(xk * xk) * (1.f / 64.f) + EPS); xk = xk * rs4 * kr_g;
              float cs, sn; rope_cs(pos, inv1, cs, sn);
              const float px = __shfl_xor(xk, 32); row[C_KR + lane] = f2bf((lane < 32) ? (xk * cs - px * sn) : (xk * cs + px * sn)); }
            if (lane < 8) BETA[(size_t)m * 8 + lane] = 1.f / (1.f + expf(-bf2f(wba)));
            else if (lane < 16) { const int hh = lane - 8; const float z = bf2f(wba) + dt_bias[hh]; const float sp = (z > 20.f) ? z : log1pf(expf(z)); G[(size_t)m * 8 + hh] = -expf(a_log[hh]) * sp; }
        }
    }
    const float* convw = (const float*)P.in[5];
    bf16_t* QA = (bf16_t*)P.out;
    for (int it = gw; it < (MROWS / 32) * 6; it += NGW) {
        const int run = it / 6, gg = it % 6, m0 = run * 32, s0 = m0 & 2047, c = gg * 512 + 8 * lane;
        float w0[8], w1[8], w2[8], w3[8];
#pragma unroll
        for (int e = 0; e < 8; e += 4) { *(f32x4*)(w0 + e) = *(const f32x4*)(convw + 0 * 3072 + c + e); *(f32x4*)(w1 + e) = *(const f32x4*)(convw + 1 * 3072 + c + e);
                                         *(f32x4*)(w2 + e) = *(const f32x4*)(convw + 2 * 3072 + c + e); *(f32x4*)(w3 + e) = *(const f32x4*)(convw + 3 * 3072 + c + e); }
        const bf16_t* src = proj + (size_t)m0 * LDP + c;
        float h1[8], h2[8], h3[8];
        if (s0 != 0) { unpack8(*(const u32x4*)(src - (size_t)1 * LDP), h1); unpack8(*(const u32x4*)(src - (size_t)2 * LDP), h2); unpack8(*(const u32x4*)(src - (size_t)3 * LDP), h3); }
        else {
#pragma unroll
            for (int e = 0; e < 8; ++e) { h1[e] = 0.f; h2[e] = 0.f; h3[e] = 0.f; } }
        bf16_t* dst = QA + (size_t)(gg >> 1) * ((size_t)MROWS * 1024) + (size_t)m0 * 1024 + (gg & 1) * 512 + 8 * lane;
        const float post = (gg < 2) ? 0.08838834764831845f : 1.f;
#pragma unroll
        for (int tb = 0; tb < 4; ++tb) {
            u32x4 raw[8];
#pragma unroll
            for (int q = 0; q < 8; ++q) raw[q] = *(const u32x4*)(src + (size_t)(8 * tb + q) * LDP);
#pragma unroll
            for (int q = 0; q < 8; ++q) {
                float cur[8], y[8]; unpack8(raw[q], cur);
                float ss = 0.f;
#pragma unroll
                for (int e = 0; e < 8; ++e) { y[e] = silu_f(w3[e] * cur[e] + w2[e] * h1[e] + w1[e] * h2[e] + w0[e] * h3[e]); ss += y[e] * y[e]; }
                if (gg < 4) { ss += __shfl_xor(ss, 1); ss += __shfl_xor(ss, 2); ss += __shfl_xor(ss, 4); ss += __shfl_xor(ss, 8); const float sc = rsqrtf(ss + EPS) * post;
#pragma unroll
                    for (int e = 0; e < 8; ++e) y[e] *= sc; }
                *(u32x4*)(dst + (size_t)(8 * tb + q) * 1024) = pack8(y);
#pragma unroll
                for (int e = 0; e < 8; ++e) { h3[e] = h2[e]; h2[e] = h1[e]; h1[e] = cur[e]; }
            }
        }
    }
}

constexpr int SOLVE_NOPS = 528, SOLVE_R = 8, SOLVE_D = 6;
struct SolveOps { unsigned char j[SOLVE_NOPS + SOLVE_R], q[SOLVE_NOPS + SOLVE_R]; };
constexpr SolveOps make_solve_ops() { SolveOps o{}; int t = 0; for (int j = 0; j < 63; ++j) for (int q = (j + 1) >> 2; q < 16; ++q) { o.j[t] = (unsigned char)j; o.q[t] = (unsigned char)q; ++t; } return o; }
constexpr SolveOps SOPS = make_solve_ops();
template <int T, int END> struct SolveStep {
    static __device__ __forceinline__ void run(f32x2 (&r)[32], f32x4 (&buf)[SOLVE_R], const LAS f32x4* Atv) {
        constexpr int TL = T + SOLVE_D;
        if constexpr (TL < END) buf[TL % SOLVE_R] = Atv[SOPS.j[TL] * 16 + SOPS.q[TL]];
        __builtin_amdgcn_sched_barrier(0);
        constexpr int j = SOPS.j[T], q = SOPS.q[T];
        const float xj = r[j >> 1][j & 1]; const f32x2 x2 = {xj, xj}; const f32x4 a = buf[T % SOLVE_R];
        r[2 * q] = r[2 * q] - (f32x2){a[0], a[1]} * x2; r[2 * q + 1] = r[2 * q + 1] - (f32x2){a[2], a[3]} * x2;
        __builtin_amdgcn_sched_barrier(0);
        SolveStep<T + 1, END>::run(r, buf, Atv);
    }
};
template <int END> struct SolveStep<END, END> { static __device__ __forceinline__ void run(f32x2 (&)[32], f32x4 (&)[SOLVE_R], const LAS f32x4*) {} };

__device__ __forceinline__ void delta_prep(const Params& P, LAS unsigned char* lds) {
    unsigned char* ws = P.ws;
    int tid = threadIdx.x; asm volatile("" : "+v"(tid));
    const int wave = __builtin_amdgcn_readfirstlane(tid >> 6), lane = tid & 63, sub = wave >> 2, tid_s = tid & 255, wv = wave & 3, fr = lane & 15, fq = lane >> 4;
    bf16_t* QA = (bf16_t*)P.out; bf16_t* KA = QA + (size_t)MROWS * 1024; bf16_t* VA = KA + (size_t)MROWS * 1024; bf16_t* WB = VA + (size_t)MROWS * 1024;
    const float* G = (const float*)(ws + WS_G); const float* BETA = (const float*)(ws + WS_BETA); bf16_t* QKM = (bf16_t*)(ws + WS_QKM); float* GL = (float*)(ws + WS_GL);
    LAS unsigned char* base = lds + sub * 61440;
    LAS bf16_t* Ks = (LAS bf16_t*)base; LAS bf16_t* Qs = (LAS bf16_t*)(base + 17408); LAS float* At = (LAS float*)(base + 34816);
    LAS float* gcs = (LAS float*)(base + 51200); LAS float* betas = (LAS float*)(base + 51456); LAS float* bes = (LAS float*)(base + 51712);
    LAS bf16_t* QKs = (LAS bf16_t*)(base + 51968);
    for (int unit = blockIdx.x; unit < 2048; unit += gridDim.x) {
        const int ch = unit * 2 + sub, n = ch & 31, bh = ch >> 5, h = bh & 7, b = bh >> 3, m0 = b * 2048 + n * 64;
#pragma unroll
        for (int i = 0; i < 4; ++i) { const int p = tid_s + 256 * i, row = p >> 4, c = p & 15; const size_t go = (size_t)(m0 + row) * 1024 + h * 128 + c * 8;
            *(LAS u32x4*)(Ks + row * 136 + c * 8) = *(const u32x4*)(KA + go); *(LAS u32x4*)(Qs + row * 136 + c * 8) = *(const u32x4*)(QA + go); }
        if (wv == 0) { float g = G[(size_t)(m0 + lane) * 8 + h] * LOG2E;
#pragma unroll
            for (int o = 1; o < 64; o <<= 1) { const float t = __shfl_up(g, o); if (lane >= o) g += t; }
            const float be = BETA[(size_t)(m0 + lane) * 8 + h];
            gcs[lane] = g; betas[lane] = be; bes[lane] = be * __builtin_amdgcn_exp2f(g); if (lane == 63) GL[ch] = __builtin_amdgcn_exp2f(g); }
        __syncthreads();
        { const int ti = wv; bf16x8 ak[4], aq[4];
#pragma unroll
          for (int ks = 0; ks < 4; ++ks) { ak[ks] = *(const LAS bf16x8*)(Ks + (16 * ti + fr) * 136 + 32 * ks + fq * 8); aq[ks] = *(const LAS bf16x8*)(Qs + (16 * ti + fr) * 136 + 32 * ks + fq * 8); }
          f32x4 gi, bi;
#pragma unroll
          for (int j = 0; j < 4; ++j) { gi[j] = gcs[16 * ti + fq * 4 + j]; bi[j] = betas[16 * ti + fq * 4 + j]; }
#pragma unroll
          for (int tj = 0; tj < 4; ++tj) {
              f32x4 ck = {0.f, 0.f, 0.f, 0.f}, cq = {0.f, 0.f, 0.f, 0.f};
              if (tj <= ti) {
#pragma unroll
                  for (int ks = 0; ks < 4; ++ks) { const bf16x8 bk = *(const LAS bf16x8*)(Ks + (16 * tj + fr) * 136 + 32 * ks + fq * 8);
                      ck = __builtin_amdgcn_mfma_f32_16x16x32_bf16(ak[ks], bk, ck, 0, 0, 0); cq = __builtin_amdgcn_mfma_f32_16x16x32_bf16(aq[ks], bk, cq, 0, 0, 0); } }
              const int jj = 16 * tj + fr; const float gj = gcs[jj]; f32x4 av; float qv[4];
#pragma unroll
              for (int j = 0; j < 4; ++j) { const int i = 16 * ti + fq * 4 + j; const float dec = (i >= jj) ? __builtin_amdgcn_exp2f(gi[j] - gj) : 0.f;
                  av[j] = (i > jj) ? bi[j] * ck[j] * dec : 0.f; qv[j] = cq[j] * dec; }
              *(LAS f32x4*)(At + jj * 64 + 16 * ti + fq * 4) = av;
#pragma unroll
              for (int j = 0; j < 4; ++j) QKs[(16 * ti + fq * 4 + j) * 72 + jj] = f2bf(qv[j]);
          } }
        u32x4 vreg[4];
        const float gl = gcs[63];
#pragma unroll
        for (int i = 0; i < 4; ++i) { const int p = tid_s + 256 * i, row = p >> 4, c = p & 15; const size_t go = (size_t)(m0 + row) * 1024 + h * 128 + c * 8;
            vreg[i] = *(const u32x4*)(VA + go);
            const u32x4 q = *(const LAS u32x4*)(Qs + row * 136 + c * 8); const float e = __builtin_amdgcn_exp2f(gcs[row]); u32x4 o;
            o.x = pk2(bflo(q.x) * e, bfhi(q.x) * e); o.y = pk2(bflo(q.y) * e, bfhi(q.y) * e); o.z = pk2(bflo(q.z) * e, bfhi(q.z) * e); o.w = pk2(bflo(q.w) * e, bfhi(q.w) * e);
            *(u32x4*)(QA + go) = o; }
#pragma unroll
        for (int i = 0; i < 4; ++i) { const int p = tid_s + 256 * i, dk = p & 127, j0 = (p >> 7) * 8; float v[8];
#pragma unroll
            for (int e = 0; e < 8; ++e) v[e] = bf2f(Ks[(j0 + e) * 136 + dk]) * __builtin_amdgcn_exp2f(gl - gcs[j0 + e]);
            u32x4 o; o.x = pk2(v[0], v[1]); o.y = pk2(v[2], v[3]); o.z = pk2(v[4], v[5]); o.w = pk2(v[6], v[7]);
            *(u32x4*)(KA + (size_t)(m0 + (dk >> 1)) * 1024 + h * 128 + (dk & 1) * 64 + j0) = o; }
        __syncthreads();
#pragma unroll
        for (int i = 0; i < 4; ++i) { const int p = tid_s + 256 * i, row = p >> 4, c = p & 15; *(LAS u32x4*)(Qs + row * 136 + c * 8) = vreg[i]; }
#pragma unroll
        for (int i = 0; i < 2; ++i) { const int p = tid_s + 256 * i, row = p >> 3, c8 = p & 7; *(u32x4*)(QKM + (size_t)ch * 4096 + row * 64 + c8 * 8) = *(const LAS u32x4*)(QKs + row * 72 + c8 * 8); }
        __syncthreads();
        { const int c = tid_s; LAS bf16_t* rp = Ks + (c >> 7) * 8704 + (c & 127); const LAS float* sp = (c >= 128) ? betas : bes;
          int zv = 0; asm volatile("" : "+v"(zv)); const LAS f32x4* Atv = (const LAS f32x4*)At + zv;
          f32x2 r[32];
#pragma unroll
          for (int i = 0; i < 64; ++i) r[i >> 1][i & 1] = bf2f(rp[i * 136]) * sp[i];
          f32x4 buf[SOLVE_R];
#pragma unroll
          for (int t = 0; t < SOLVE_D; ++t) buf[t] = Atv[SOPS.j[t] * 16 + SOPS.q[t]];
          SolveStep<0, SOLVE_NOPS>::run(r, buf, Atv);
#pragma unroll
          for (int i = 0; i < 64; ++i) rp[i * 136] = f2bf(r[i >> 1][i & 1]); }
        __syncthreads();
#pragma unroll
        for (int i = 0; i < 4; ++i) { const int p = tid_s + 256 * i, row = p >> 4, c = p & 15; const size_t go = (size_t)(m0 + row) * 1024 + h * 128 + c * 8;
            *(u32x4*)(WB + go) = *(const LAS u32x4*)(Ks + row * 136 + c * 8); *(u32x4*)(VA + go) = *(const LAS u32x4*)(Qs + row * 136 + c * 8); }
        __syncthreads();
    }
}

__device__ __forceinline__ void delta_scan(const Params& P, LAS unsigned char* lds) {
    unsigned char* ws = P.ws;
    int tid = threadIdx.x; asm volatile("" : "+v"(tid));
    const int wave = __builtin_amdgcn_readfirstlane(tid >> 6), lane = tid & 63, fr = lane & 15, fq = lane >> 4;
    const bf16_t* QA = (const bf16_t*)P.out; const bf16_t* KA = QA + (size_t)MROWS * 1024; const bf16_t* UA = KA + (size_t)MROWS * 1024; const bf16_t* WB = UA + (size_t)MROWS * 1024;
    const bf16_t* QKM = (const bf16_t*)(ws + WS_QKM); const float* GL = (const float*)(ws + WS_GL); bf16_t* proj = (bf16_t*)(ws + WS_PROJ);
    const float* ogain = (const float*)P.in[8];
    LAS bf16_t* Ws = (LAS bf16_t*)lds; LAS bf16_t* Qs = (LAS bf16_t*)(lds + 17408); LAS bf16_t* Kt = (LAS bf16_t*)(lds + 34816); LAS bf16_t* QKs = (LAS bf16_t*)(lds + 53248);
    LAS bf16_t* Us = (LAS bf16_t*)(lds + 62464); LAS bf16_t* St = (LAS bf16_t*)(lds + 79872); LAS bf16_t* VNt = (LAS bf16_t*)(lds + 114688); LAS float* SSQ = (LAS float*)(lds + 133120);
    const int it = wave >> 1, dvq = wave & 1;
    for (int unit = blockIdx.x; unit < 128; unit += gridDim.x) {
        const int bh = unit, h = bh & 7, b = bh >> 3;
        f32x4 sacc[8];
#pragma unroll
        for (int d = 0; d < 8; ++d) sacc[d] = (f32x4){0.f, 0.f, 0.f, 0.f};
        float og[4];
#pragma unroll
        for (int d = 0; d < 4; ++d) og[d] = ogain[16 * (4 * dvq + d) + fr];
        u32x4 rw[2], rq[2], rk[2], ru[2], rqk;
#define SCAN_LOAD(nn) do { const int m0_ = b * 2048 + (nn) * 64; const size_t ch_ = (size_t)bh * 32 + (nn); \
            _Pragma("unroll") for (int i = 0; i < 2; ++i) { const int p = tid + 512 * i, row = p >> 4, c = p & 15; const size_t go = (size_t)(m0_ + row) * 1024 + h * 128 + c * 8; rw[i] = *(const u32x4*)(WB + go); rq[i] = *(const u32x4*)(QA + go); ru[i] = *(const u32x4*)(UA + go); \
                const int dk = p >> 3, c8 = p & 7; rk[i] = *(const u32x4*)(KA + (size_t)(m0_ + (dk >> 1)) * 1024 + h * 128 + (dk & 1) * 64 + c8 * 8); } \
            { const int row = tid >> 3, c8 = tid & 7; rqk = *(const u32x4*)(QKM + ch_ * 4096 + row * 64 + c8 * 8); } } while (0)
#define SCAN_STORE() do { \
            _Pragma("unroll") for (int i = 0; i < 2; ++i) { const int p = tid + 512 * i, row = p >> 4, c = p & 15; *(LAS u32x4*)(Ws + row * 136 + c * 8) = rw[i]; *(LAS u32x4*)(Qs + row * 136 + c * 8) = rq[i]; *(LAS u32x4*)(Us + row * 136 + c * 8) = ru[i]; \
                const int dk = p >> 3, c8 = p & 7; *(LAS u32x4*)(Kt + dk * 72 + c8 * 8) = rk[i]; } \
            { const int row = tid >> 3, c8 = tid & 7; *(LAS u32x4*)(QKs + row * 72 + c8 * 8) = rqk; } } while (0)
        SCAN_LOAD(0);
        for (int n = 0; n < 32; ++n) {
            const int m0 = b * 2048 + n * 64;
            SCAN_STORE();
#pragma unroll
            for (int d = 0; d < 8; ++d) { u32x2 w; w.x = pk2(sacc[d][0], sacc[d][1]); w.y = pk2(sacc[d][2], sacc[d][3]); *(LAS u32x2*)(St + (16 * d + fr) * 136 + 16 * wave + fq * 4) = w; }
            const float gl = GL[bh * 32 + n];
            __syncthreads();
            if (n + 1 < 32) SCAN_LOAD(n + 1);
            bf16_t zr[4][4];
#pragma unroll
            for (int d = 0; d < 4; ++d)
#pragma unroll
                for (int j = 0; j < 4; ++j) zr[d][j] = proj[(size_t)(m0 + 16 * it + fq * 4 + j) * LDP + C_Z + h * 128 + 16 * (4 * dvq + d) + fr];
            f32x4 a1[4], a2[4];
#pragma unroll
            for (int d = 0; d < 4; ++d) { a1[d] = (f32x4){0.f, 0.f, 0.f, 0.f}; a2[d] = (f32x4){0.f, 0.f, 0.f, 0.f}; }
#pragma unroll
            for (int ks = 0; ks < 4; ++ks) { const bf16x8 wf = *(const LAS bf16x8*)(Ws + (16 * it + fr) * 136 + 32 * ks + fq * 8), qf = *(const LAS bf16x8*)(Qs + (16 * it + fr) * 136 + 32 * ks + fq * 8);
#pragma unroll
                for (int d = 0; d < 4; ++d) { const bf16x8 sf = *(const LAS bf16x8*)(St + (16 * (4 * dvq + d) + fr) * 136 + 32 * ks + fq * 8);
                    a1[d] = __builtin_amdgcn_mfma_f32_16x16x32_bf16(wf, sf, a1[d], 0, 0, 0); a2[d] = __builtin_amdgcn_mfma_f32_16x16x32_bf16(qf, sf, a2[d], 0, 0, 0); } }
#pragma unroll
            for (int d = 0; d < 4; ++d) { const int dv = 16 * (4 * dvq + d) + fr; float vn[4];
#pragma unroll
                for (int j = 0; j < 4; ++j) vn[j] = bf2f(Us[(16 * it + fq * 4 + j) * 136 + dv]) - a1[d][j];
                u32x2 w; w.x = pk2(vn[0], vn[1]); w.y = pk2(vn[2], vn[3]); *(LAS u32x2*)(VNt + dv * 72 + 16 * it + fq * 4) = w; }
            __syncthreads();
#pragma unroll
            for (int d = 0; d < 8; ++d) sacc[d] = sacc[d] * gl;
#pragma unroll
            for (int k2 = 0; k2 < 2; ++k2) { const bf16x8 qkf = *(const LAS bf16x8*)(QKs + (16 * it + fr) * 72 + 32 * k2 + fq * 8), kf = *(const LAS bf16x8*)(Kt + (16 * wave + fr) * 72 + 32 * k2 + fq * 8);
#pragma unroll
                for (int d = 0; d < 8; ++d) { const bf16x8 vf = *(const LAS bf16x8*)(VNt + (16 * d + fr) * 72 + 32 * k2 + fq * 8);
                    sacc[d] = __builtin_amdgcn_mfma_f32_16x16x32_bf16(kf, vf, sacc[d], 0, 0, 0);
                    if ((d >> 2) == dvq) a2[d & 3] = __builtin_amdgcn_mfma_f32_16x16x32_bf16(qkf, vf, a2[d & 3], 0, 0, 0); } }
            float ssq[4];
#pragma unroll
            for (int j = 0; j < 4; ++j) { float t = 0.f;
#pragma unroll
                for (int d = 0; d < 4; ++d) t += a2[d][j] * a2[d][j];
                t += __shfl_xor(t, 1); t += __shfl_xor(t, 2); t += __shfl_xor(t, 4); t += __shfl_xor(t, 8); ssq[j] = t; }
            if (fr == 0) {
#pragma unroll
                for (int j = 0; j < 4; ++j) SSQ[(16 * it + fq * 4 + j) * 2 + dvq] = ssq[j]; }
            __syncthreads();
#pragma unroll
            for (int j = 0; j < 4; ++j) { const int row = 16 * it + fq * 4 + j; const float rstd = rsqrtf((SSQ[row * 2] + SSQ[row * 2 + 1]) * (1.f / 128.f) + EPS);
#pragma unroll
                for (int d = 0; d < 4; ++d) proj[(size_t)(m0 + row) * LDP + C_Q + h * 128 + 16 * (4 * dvq + d) + fr] = f2bf(a2[d][j] * rstd * og[d] * silu_f(bf2f(zr[d][j]))); }
        }
        __syncthreads();
#undef SCAN_LOAD
#undef SCAN_STORE
    }
}

__device__ __forceinline__ void mla_attention(const Params& P, LAS unsigned char* lds) {
    unsigned char* ws = P.ws;
    int tid = threadIdx.x; asm volatile("" : "+v"(tid));
    const int wave = __builtin_amdgcn_readfirstlane(tid >> 6), lane = tid & 63, fr = lane & 15, fq = lane >> 4;
    bf16_t* proj = (bf16_t*)(ws + WS_PROJ); const bf16_t* KN = (const bf16_t*)(ws + WS_ACT); const bf16_t* VT = KN + (size_t)MROWS * 1024;
    const int kkey = tid >> 3, kseg = tid & 7, vdv = tid >> 2, vseg = tid & 3;
    unsigned* qctr = (unsigned*)(ws + WS_CTL + 128 * 1024);
    volatile LAS unsigned* qslot = (volatile LAS unsigned*)(lds + 139264);
    const bool stat = (gridDim.x == 256);
    for (int iter = 0;; ++iter) {
        int qi, bh;
        if (stat) { const bool sc = (int)blockIdx.x < 128; if (iter >= (sc ? 2 : 6)) break; bh = (int)blockIdx.x & 127;
            qi = sc ? (iter == 0 ? 7 : 4) : (iter == 0 ? 6 : iter == 1 ? 5 : iter == 2 ? 3 : iter == 3 ? 2 : iter == 4 ? 1 : 0); }
        else {
            if (tid == 0) qslot[0] = __hip_atomic_fetch_add(qctr, 1u, __ATOMIC_RELAXED, __HIP_MEMORY_SCOPE_AGENT);
            __syncthreads();
            const int L = (int)qslot[0];
            if (L >= 1024) break;
            qi = 7 - (L >> 7); bh = L & 127; }
        const int h = bh & 7, b = bh >> 3;
        const int q0 = qi * 256, ntiles = 4 * (qi + 1);
        bf16x8 qf[2][6];
#pragma unroll
        for (int m = 0; m < 2; ++m)
#pragma unroll
            for (int ks = 0; ks < 6; ++ks) qf[m][ks] = *(const bf16x8*)(proj + (size_t)(b * 2048 + q0 + 32 * wave + 16 * m + fr) * LDP + C_MQ + h * 192 + 32 * ks + fq * 8);
        f32x4 accO[2][8];
#pragma unroll
        for (int m = 0; m < 2; ++m)
#pragma unroll
            for (int d = 0; d < 8; ++d) accO[m][d] = (f32x4){0.f, 0.f, 0.f, 0.f};
        float mrow[2] = {-INFINITY, -INFINITY};
        f32x4 accL[2] = {(f32x4){0.f, 0.f, 0.f, 0.f}, (f32x4){0.f, 0.f, 0.f, 0.f}};
        const bf16x8 ones8 = {0x3F80, 0x3F80, 0x3F80, 0x3F80, 0x3F80, 0x3F80, 0x3F80, 0x3F80};
        u32x4 rk0, rk1, rkr, rv0, rv1;
#define ATT_LOAD(kt) do { const size_t krow = (size_t)(b * 2048 + (kt) * 64 + kkey); const bf16_t* kp = KN + krow * 1024 + h * 128 + 16 * kseg; rk0 = *(const u32x4*)kp; rk1 = *(const u32x4*)(kp + 8); \
            rkr = *(const u32x4*)(proj + krow * LDP + C_KR + 8 * kseg); const bf16_t* vp = VT + ((size_t)bh * 128 + vdv) * 2048 + (kt) * 64 + 16 * vseg; rv0 = *(const u32x4*)vp; rv1 = *(const u32x4*)(vp + 8); } while (0)
#define ATT_STORE(buf) do { LAS bf16_t* Kb = (LAS bf16_t*)(lds + (buf) * 25600); LAS bf16_t* Vb = (LAS bf16_t*)(lds + 51200 + (buf) * 18432); \
            float f[16]; f[0] = bflo(rk0.x); f[1] = bfhi(rk0.x); f[2] = bflo(rk0.y); f[3] = bfhi(rk0.y); f[4] = bflo(rk0.z); f[5] = bfhi(rk0.z); f[6] = bflo(rk0.w); f[7] = bfhi(rk0.w); \
            f[8] = bflo(rk1.x); f[9] = bfhi(rk1.x); f[10] = bflo(rk1.y); f[11] = bfhi(rk1.y); f[12] = bflo(rk1.z); f[13] = bfhi(rk1.z); f[14] = bflo(rk1.w); f[15] = bfhi(rk1.w); \
            float ss = 0.f; _Pragma("unroll") for (int e = 0; e < 16; ++e) ss += f[e] * f[e]; \
            ss += __shfl_xor(ss, 1); ss += __shfl_xor(ss, 2); ss += __shfl_xor(ss, 4); const float rs = rsqrtf(ss * (1.f / 128.f) + EPS); \
            u32x4 o0, o1; o0.x = pk2(f[0] * rs, f[1] * rs); o0.y = pk2(f[2] * rs, f[3] * rs); o0.z = pk2(f[4] * rs, f[5] * rs); o0.w = pk2(f[6] * rs, f[7] * rs); \
            o1.x = pk2(f[8] * rs, f[9] * rs); o1.y = pk2(f[10] * rs, f[11] * rs); o1.z = pk2(f[12] * rs, f[13] * rs); o1.w = pk2(f[14] * rs, f[15] * rs); \
            *(LAS u32x4*)(Kb + kkey * 200 + 16 * kseg) = o0; *(LAS u32x4*)(Kb + kkey * 200 + 16 * kseg + 8) = o1; *(LAS u32x4*)(Kb + kkey * 200 + 128 + 8 * kseg) = rkr; \
            *(LAS u32x4*)(Vb + vdv * 72 + 16 * vseg) = rv0; *(LAS u32x4*)(Vb + vdv * 72 + 16 * vseg + 8) = rv1; } while (0)
        ATT_LOAD(0); ATT_STORE(0);
        __syncthreads();
        for (int kt = 0; kt < ntiles; ++kt) {
            const bool more = (kt + 1 < ntiles);
            if (more) ATT_LOAD(kt + 1);
            const bool active = (kt < 4 * qi) || ((kt - 4 * qi) <= (wave >> 1));
            if (active) {
                const LAS bf16_t* Kb = (const LAS bf16_t*)(lds + (kt & 1) * 25600); const LAS bf16_t* Vb = (const LAS bf16_t*)(lds + 51200 + (kt & 1) * 18432);
                f32x4 accS[2][4];
#pragma unroll
                for (int m = 0; m < 2; ++m)
#pragma unroll
                    for (int n = 0; n < 4; ++n) accS[m][n] = (f32x4){0.f, 0.f, 0.f, 0.f};
                __builtin_amdgcn_s_setprio(1);
                {
                  const LAS bf16_t* kbase = Kb + fr * 200 + fq * 8; bf16x8 kring[4];
#pragma unroll
                  for (int s0 = 0; s0 < 3; ++s0) kring[s0] = *(const LAS bf16x8*)(kbase + (16 * (s0 & 3)) * 200 + 32 * (s0 >> 2));
#pragma unroll
                  for (int s0 = 0; s0 < 24; ++s0) {
                      if (s0 + 3 < 24) kring[(s0 + 3) & 3] = *(const LAS bf16x8*)(kbase + (16 * ((s0 + 3) & 3)) * 200 + 32 * ((s0 + 3) >> 2));
                      __builtin_amdgcn_sched_barrier(0);
                      const int ks = s0 >> 2, n = s0 & 3;
                      accS[0][n] = __builtin_amdgcn_mfma_f32_16x16x32_bf16(kring[s0 & 3], qf[0][ks], accS[0][n], 0, 0, 0); accS[1][n] = __builtin_amdgcn_mfma_f32_16x16x32_bf16(kring[s0 & 3], qf[1][ks], accS[1][n], 0, 0, 0);
                      __builtin_amdgcn_sched_barrier(0);
                  } }
                __builtin_amdgcn_s_setprio(0);
                bf16x8 pf[2][2];
#pragma unroll
                for (int m = 0; m < 2; ++m) {
                    float mx = accS[m][0][0];
#pragma unroll
                    for (int n = 0; n < 4; ++n)
#pragma unroll
                        for (int j = 0; j < 4; ++j) mx = fmaxf(mx, accS[m][n][j]);
                    mx = fmaxf(mx, __shfl_xor(mx, 16)); mx = fmaxf(mx, __shfl_xor(mx, 32));
                    const float mnew = fmaxf(mrow[m], mx), alpha = __builtin_amdgcn_exp2f(mrow[m] - mnew); mrow[m] = mnew;
                    float p[4][4];
#pragma unroll
                    for (int n = 0; n < 4; ++n)
#pragma unroll
                        for (int j = 0; j < 4; ++j) p[n][j] = __builtin_amdgcn_exp2f(accS[m][n][j] - mnew);
                    if (__any(alpha != 1.f)) {
                        accL[m] = accL[m] * alpha;
#pragma unroll
                        for (int d = 0; d < 8; ++d) accO[m][d] = accO[m][d] * alpha; }
#pragma unroll
                    for (int t = 0; t < 2; ++t) { u32x4 w; w.x = pk2(p[2 * t][0], p[2 * t][1]); w.y = pk2(p[2 * t][2], p[2 * t][3]); w.z = pk2(p[2 * t + 1][0], p[2 * t + 1][1]); w.w = pk2(p[2 * t + 1][2], p[2 * t + 1][3]);
                        pf[m][t] = __builtin_bit_cast(bf16x8, w); }
                }
                __builtin_amdgcn_s_setprio(1);
#pragma unroll
                for (int t = 0; t < 2; ++t) { accL[0] = __builtin_amdgcn_mfma_f32_16x16x32_bf16(ones8, pf[0][t], accL[0], 0, 0, 0); accL[1] = __builtin_amdgcn_mfma_f32_16x16x32_bf16(ones8, pf[1][t], accL[1], 0, 0, 0); }
                {
                  const LAS bf16_t* vbase = Vb + fr * 72 + fq * 4; u32x2 vlo[4], vhi[4];
#pragma unroll
                  for (int s0 = 0; s0 < 3; ++s0) { const LAS bf16_t* vp = vbase + (16 * (s0 & 7)) * 72 + 32 * (s0 >> 3); vlo[s0] = *(const LAS u32x2*)vp; vhi[s0] = *(const LAS u32x2*)(vp + 16); }
#pragma unroll
                  for (int s0 = 0; s0 < 16; ++s0) {
                      if (s0 + 3 < 16) { const LAS bf16_t* vp = vbase + (16 * ((s0 + 3) & 7)) * 72 + 32 * ((s0 + 3) >> 3); vlo[(s0 + 3) & 3] = *(const LAS u32x2*)vp; vhi[(s0 + 3) & 3] = *(const LAS u32x2*)(vp + 16); }
                      __builtin_amdgcn_sched_barrier(0);
                      const int t = s0 >> 3, d = s0 & 7; u32x4 w; w.x = vlo[s0 & 3].x; w.y = vlo[s0 & 3].y; w.z = vhi[s0 & 3].x; w.w = vhi[s0 & 3].y; const bf16x8 vf = __builtin_bit_cast(bf16x8, w);
                      accO[0][d] = __builtin_amdgcn_mfma_f32_16x16x32_bf16(vf, pf[0][t], accO[0][d], 0, 0, 0); accO[1][d] = __builtin_amdgcn_mfma_f32_16x16x32_bf16(vf, pf[1][t], accO[1][d], 0, 0, 0);
                      __builtin_amdgcn_sched_barrier(0);
                  } }
                __builtin_amdgcn_s_setprio(0);
            }
            if (more) ATT_STORE((kt + 1) & 1);
            __syncthreads();
        }
#undef ATT_LOAD
#undef ATT_STORE
#pragma unroll
        for (int m = 0; m < 2; ++m) { const float il = 1.f / accL[m][0];
            bf16_t* op = proj + (size_t)(b * 2048 + q0 + 32 * wave + 16 * m + fr) * LDP + C_K + h * 128 + fq * 4;
#pragma unroll
            for (int d = 0; d < 8; ++d) { u32x2 w; w.x = pk2(accO[m][d][0] * il, accO[m][d][1] * il); w.y = pk2(accO[m][d][2] * il, accO[m][d][3] * il); *(u32x2*)(op + 16 * d) = w; } }
    }
}

__device__ __forceinline__ void oa_finalize(const Params& P, int gw, int NGW, int lane) {
    bf16_t* proj = (bf16_t*)(P.ws + WS_PROJ); const float* gain = (const float*)P.in[8];
    const int h = lane >> 3, seg = lane & 7;
    float g[16];
#pragma unroll
    for (int e = 0; e < 16; ++e) g[e] = gain[16 * seg + e];
    for (int m = gw; m < MROWS; m += NGW) { bf16_t* op = proj + (size_t)m * LDP + C_Q + h * 128 + 16 * seg; const bf16_t* zp = proj + (size_t)m * LDP + C_Z + h * 128 + 16 * seg;
        const u32x4 o0 = *(const u32x4*)op, o1 = *(const u32x4*)(op + 8), z0 = *(const u32x4*)zp, z1 = *(const u32x4*)(zp + 8);
        float a[8], b[8], za[8], zb[8]; unpack8(o0, a); unpack8(o1, b); unpack8(z0, za); unpack8(z1, zb);
        float ss = 0.f;
#pragma unroll
        for (int e = 0; e < 8; ++e) ss += a[e] * a[e] + b[e] * b[e];
        ss += __shfl_xor(ss, 1); ss += __shfl_xor(ss, 2); ss += __shfl_xor(ss, 4);
        const float rstd = rsqrtf(ss * (1.f / 128.f) + EPS);
#pragma unroll
        for (int e = 0; e < 8; ++e) { a[e] = a[e] * rstd * g[e] * silu_f(za[e]); b[e] = b[e] * rstd * g[8 + e] * silu_f(zb[e]); }
        *(u32x4*)op = pack8(a); *(u32x4*)(op + 8) = pack8(b); }
}


#define XB_TMO      128
#define XB_XCNT(j)  (256  + 64 * (j))
#define XB_XSUB(j)  (1280 + 64 * (j))
#define XB_XGEN(j)  (2304 + 64 * (j))
#define XB_TOP      3328
#define XB_TOPGEN   3392
#define XCD_BAR_WORDS 3456
#define XB_SPIN_CAP (1u << 18)
__device__ __forceinline__ unsigned xb_ld(unsigned* p)              { return __hip_atomic_load(p, __ATOMIC_RELAXED, __HIP_MEMORY_SCOPE_AGENT); }
__device__ __forceinline__ unsigned xb_add(unsigned* p, unsigned v) { return __hip_atomic_fetch_add(p, v, __ATOMIC_RELAXED, __HIP_MEMORY_SCOPE_AGENT); }
__device__ __forceinline__ unsigned xb_xcc_id() { return (unsigned)__builtin_amdgcn_s_getreg((3 << 11) | 20) & 0xFu; }
#define XB_SPIN(cond, bar) do { unsigned _sp = 0; while (cond) { __builtin_amdgcn_s_sleep(1); \
    if ((++_sp & 255u) == 0u) { if (xb_ld(&(bar)[XB_TMO])) break; if (_sp > XB_SPIN_CAP) { atomicAdd(&(bar)[XB_TMO], 1u); break; } } } } while (0)
struct XcdBarrier { unsigned* bar; unsigned x; volatile LAS unsigned* st; };
__device__ __forceinline__ XcdBarrier xcd_barrier_post(unsigned* bar, volatile LAS unsigned* st) {
    XcdBarrier b; b.bar = bar; b.x = xb_xcc_id(); b.st = st;
    if (threadIdx.x == 0) (void)xb_add(&bar[XB_XCNT(b.x)], 1u);
    return b;
}
__device__ __forceinline__ void xcd_barrier_complete(unsigned* bar, unsigned x, unsigned& nloc, unsigned& nx) {
    const unsigned G = gridDim.x * gridDim.y * gridDim.z;
    unsigned sum, cnt, mine, sp = 0u;
    for (;;) {
        sum = 0u; cnt = 0u; mine = 0u;
#pragma unroll
        for (unsigned j = 0; j < 16; ++j) { const unsigned c = xb_ld(&bar[XB_XCNT(j)]); sum += c; cnt += (c > 0u) ? 1u : 0u; mine = (j == x) ? c : mine; }
        if (sum == G) break;
        __builtin_amdgcn_s_sleep(1);
        if ((++sp & 255u) == 0u) { if (xb_ld(&bar[XB_TMO])) break; if (sp > XB_SPIN_CAP) { atomicAdd(&bar[XB_TMO], 1u); break; } }
    }
    nloc = mine > 0u ? mine : 1u; nx = cnt > 0u ? cnt : 1u;
}
__device__ __forceinline__ void xcd_barrier(const XcdBarrier& b) {
    asm volatile("s_waitcnt vmcnt(0)" ::: "memory");
    __syncthreads();
    if (threadIdx.x == 0) {
        unsigned* bar = b.bar;
        __builtin_amdgcn_s_waitcnt(0);
        unsigned nloc = b.st[0], nx = b.st[1];
        if (nloc == 0u) { xcd_barrier_complete(bar, b.x, nloc, nx); b.st[0] = nloc; b.st[1] = nx; }
        const unsigned old = xb_add(&bar[XB_XSUB(b.x)], 1u);
        const unsigned gen = old / nloc;
        if (old + 1u == (gen + 1u) * nloc) {
            __builtin_amdgcn_fence(__ATOMIC_RELEASE, "agent");
            asm volatile("s_waitcnt vmcnt(0)" ::: "memory");
            const unsigned og = xb_add(&bar[XB_TOP], 1u);
            const unsigned tg = og / nx;
            if (og + 1u == (tg + 1u) * nx) xb_add(&bar[XB_TOPGEN], 1u);
            else XB_SPIN(xb_ld(&bar[XB_TOPGEN]) == tg, bar);
            __builtin_amdgcn_fence(__ATOMIC_ACQUIRE, "agent");
            xb_add(&bar[XB_XGEN(b.x)], 1u);
            asm volatile("s_waitcnt vmcnt(0)" ::: "memory");
        } else {
            XB_SPIN(xb_ld(&bar[XB_XGEN(b.x)]) == gen, bar);
            __builtin_amdgcn_fence(__ATOMIC_ACQUIRE, "agent");
            asm volatile("s_waitcnt vmcnt(0)" ::: "memory");
        }
    }
    __syncthreads();
}

__global__ void __launch_bounds__(512) fwd_megakernel(Params P) {
    extern __shared__ __attribute__((aligned(16))) unsigned char lds_raw[];
    LAS unsigned char* lds = (LAS unsigned char*)lds_raw;
    cg::grid_group grid = cg::this_grid();
    const int G = gridDim.x, NGW = G * 8;
#define PHASE_IDS() int tid_ = threadIdx.x; asm volatile("" : "+v"(tid_)); const int lane = tid_ & 63, wave = __builtin_amdgcn_readfirstlane(tid_ >> 6), gw = blockIdx.x * 8 + wave
    unsigned char* ws = P.ws;
    bf16_t* ACT = (bf16_t*)(ws + WS_ACT); bf16_t* PROJ = (bf16_t*)(ws + WS_PROJ);
    pg8::StaticOrder S;
    unsigned long long pt_acc = 0, pt_last = 0;
    volatile LAS unsigned* MISC = (volatile LAS unsigned*)(lds + 139264);
    if (threadIdx.x < 16) MISC[threadIdx.x] = 0u;
    __syncthreads();
    const XcdBarrier xbar = xcd_barrier_post((unsigned*)(ws + WS_CTL), MISC + 8);
#define GRID_BAR() xcd_barrier(xbar)

    PT_B(0);
    { PHASE_IDS(); p0_prologue(P, lds, gw, NGW, wave, lane); }
    if (P.ws == nullptr) grid.sync();
    GRID_BAR();
    PT_E(0);
    PT_B(1);
    { pg8::Gemm g{ACT, (const bf16_t*)(ws + WS_WIN), MROWS, LDP, 2048, 2048}; S.init(MROWS, LDP, G, blockIdx.x);
      Epi<EP_BF16> E{PROJ, nullptr, LDP, nullptr, nullptr, nullptr, nullptr}; pg8::gemm_phase(lds, g, S, E); }
    {
      const int nwg = (MROWS / 256) * (LDP / 256), rem = nwg % G; const bool is_short = (rem == 0) || ((int)blockIdx.x >= rem);
      const int nshort = (rem == 0) ? G : G - rem, sidx = (rem == 0) ? (int)blockIdx.x : (int)blockIdx.x - rem;
      if (is_short) { PHASE_IDS(); (void)gw; transpose_range(P, (LAS float*)(lds + wave * 16384), TR_IN_ITEMS, TR_ALL_ITEMS, sidx * 8 + wave, nshort * 8, lane); } }
    GRID_BAR();
    PT_E(1);
    PT_B(2);
    { PHASE_IDS(); p2_prep(P, gw, NGW, lane); }
    GRID_BAR();
    PT_E(2);
    PT_B(3);
    { pg8::Gemm g{PROJ + C_CKV, (const bf16_t*)(ws + WS_WKV), MROWS, 2048, 512, LDP}; S.init(MROWS, 2048, G, blockIdx.x);
      Epi<EP_KV> E{ACT, nullptr, 1024, nullptr, nullptr, ACT + (size_t)MROWS * 1024, nullptr}; pg8::gemm_phase(lds, g, S, E); }
    __syncthreads();
    PT_E(3);
    PT_B(4);
    delta_prep(P, lds);
    GRID_BAR();
    PT_E(4);
    PT_B(5);
    delta_scan(P, lds);
    __syncthreads();
    PT_E(5);
    PT_B(6);
    mla_attention(P, lds);
    GRID_BAR();
    PT_E(6);
    PT_B(8);
    { pg8::Gemm g{PROJ + C_Q, (const bf16_t*)(ws + WS_WA), MROWS, 2048, 2048, LDP}; S.init(MROWS, 2048, G, blockIdx.x);
      Epi<EP_YAB> E{ACT, nullptr, DM, PROJ, nullptr, nullptr, nullptr}; pg8::gemm_phase(lds, g, S, E); }
    GRID_BAR();
    PT_E(8);
    PT_B(9);
    { pg8::Gemm g{ACT, (const bf16_t*)(ws + WS_WOUT), MROWS, 2048, 2048, 2048}; S.init(MROWS, 2048, G, blockIdx.x);
      Epi<EP_X1> E{(bf16_t*)(ws + WS_XB), nullptr, DM, nullptr, (const float*)P.in[0], nullptr, (float*)(ws + WS_SSQ1)}; pg8::gemm_phase(lds, g, S, E); }
    GRID_BAR();
    PT_E(9);
    PT_B(11);
    { pg8::Gemm g{(const bf16_t*)(ws + WS_XB), (const bf16_t*)(ws + WS_WUP), MROWS, DFF, 2048, 2048}; S.init(MROWS, DFF, G, blockIdx.x);
      Epi<EP_RELU2> E{PROJ, nullptr, DFF, nullptr, nullptr, nullptr, (float*)(ws + WS_SSQ1)}; pg8::gemm_phase(lds, g, S, E); }
    { pg8::Gemm g{(const bf16_t*)(ws + WS_PBF), (const bf16_t*)(ws + WS_WPLE), MROWS, 2048, 256, 256}; S.init(MROWS, 2048, G, blockIdx.x);
      Epi<EP_BF16> E{ACT, nullptr, DM, nullptr, nullptr, nullptr, nullptr}; pg8::gemm_phase(lds, g, S, E); }
    GRID_BAR();
    PT_E(11);
    PT_B(12);
    { pg8::Gemm g{PROJ, (const bf16_t*)(ws + WS_WDN), MROWS, 2048, DFF, DFF}; S.init(MROWS, 2048, G, blockIdx.x);
      Epi<EP_ACC> E{(bf16_t*)(ws + WS_XB), nullptr, DM, nullptr, nullptr, nullptr, (float*)(ws + WS_SSQ2)}; pg8::gemm_phase(lds, g, S, E); }
    GRID_BAR();
    PT_E(12);
    PT_B(14);
    { pg8::Gemm g{(const bf16_t*)(ws + WS_XB), (const bf16_t*)(ws + WS_WPG), MROWS, 2048, 2048, 2048}; S.init(MROWS, 2048, G, blockIdx.x);
      Epi<EP_PLE> E{nullptr, P.out, DM, ACT, nullptr, (bf16_t*)(ws + WS_XB), (float*)(ws + WS_SSQ2)}; pg8::gemm_phase(lds, g, S, E); }
    PT_E(14);
    if (PROBE_MASK != 0u && blockIdx.x == 0) { const unsigned long long t_end = __builtin_amdgcn_s_memrealtime() + (unsigned long long)PROBE_MULT * pt_acc;
        while (__builtin_amdgcn_s_memrealtime() < t_end) __builtin_amdgcn_s_sleep(8); }
}

extern "C" void kernel_launch(void* const* d_in, const int* in_sizes, int n_in, void* d_out, int out_size, void* d_ws, size_t ws_size, hipStream_t stream) {
    static int grid = 0;
    if (grid == 0) {
        if (n_in != 24 || out_size != MROWS * DM || ws_size < WS_END) { fprintf(stderr, "kernel_launch: unexpected shapes: n_in %d out %d ws %zu (need %zu)\n", n_in, out_size, ws_size, (size_t)WS_END); grid = -1; return; }
        int dev = 0, cus = 0, per_cu = 0;
        if (hipGetDevice(&dev) != hipSuccess || hipDeviceGetAttribute(&cus, hipDeviceAttributeMultiprocessorCount, dev) != hipSuccess) { grid = -1; return; }
        if (hipFuncSetAttribute((const void*)fwd_megakernel, hipFuncAttributeMaxDynamicSharedMemorySize, LDS_BYTES) != hipSuccess) { fprintf(stderr, "kernel_launch: hipFuncSetAttribute failed\n"); grid = -1; return; }
        if (hipOccupancyMaxActiveBlocksPerMultiprocessor(&per_cu, (const void*)fwd_megakernel, 512, LDS_BYTES) != hipSuccess || per_cu < 1) { fprintf(stderr, "kernel_launch: occupancy query gave %d\n", per_cu); per_cu = 1; }
        (void)hipGetLastError();
        grid = cus * per_cu;
        fprintf(stderr, "kernel_launch: grid %d (cus %d x %d), ws %zu\n", grid, cus, per_cu, ws_size);
    }
    if (grid < 0) return;
    Params p{};
    for (int i = 0; i < 24; ++i) p.in[i] = d_in[i];
    p.out = (float*)d_out; p.ws = (unsigned char*)d_ws;
    for (int i = 0; i < 32; ++i) p.ropeinv[i] = (float)pow(10000.0, -(double)i / 32.0);
    if (hipMemsetAsync((char*)d_ws + WS_CTL, 0, CTL_BYTES, stream) != hipSuccess) { fprintf(stderr, "kernel_launch: hipMemsetAsync failed\n"); return; }
    void* args[] = {&p};
    hipError_t e = hipLaunchCooperativeKernel((const void*)fwd_megakernel, dim3(grid), dim3(512), args, LDS_BYTES, stream);
    if (e != hipSuccess) fprintf(stderr, "kernel_launch: cooperative launch failed: %s (grid %d)\n", hipGetErrorString(e), grid);
}
```
